# Optimizing an MI355X kernel written in HIP

```python
import math
import jax, jax.numpy as jnp
from jax import lax
import numpy as np

D_MODEL = 1024
BATCH = 16
SEQ = 4096
DEPTH = 1
DEC_BATCH = 4
DEC_SEQ = 4096
PAST_LEN = 128

MEM_LEN = 256
MLA_HEADS = 8
Q_LORA = 384
KV_LORA = 256
QK_NOPE = 64
QK_ROPE = 32
V_HEAD = 64
ROPE_THETA = 10000.0
Q_BLOCK = 128
RWKV_HEADS = 8
RWKV_HEAD = 64
RWKV_DIM = RWKV_HEADS * RWKV_HEAD
DECAY_LORA = 64
AAA_LORA = 64
GATE_LORA = 128
X_HEADS = 4
X_HEAD = 128
D_FF = 2816
N_BRANCH = 2
LN_EPS = 1e-5
RMS_EPS = 1e-6
GN_EPS = 64e-5
ALPHA = (2 * DEPTH) ** 0.25
BETA = (8 * DEPTH) ** -0.25

SEG_Q = Q_LORA
SEG_KV = KV_LORA + QK_ROPE
SEG_RWKV = 3 * RWKV_DIM + 2 * DECAY_LORA + AAA_LORA + GATE_LORA
SEG_GATE = N_BRANCH * D_MODEL
D_IN = SEG_Q + SEG_KV + SEG_RWKV + SEG_GATE
OFF_KV = SEG_Q
OFF_RWKV = OFF_KV + SEG_KV
OFF_GATE = OFF_RWKV + SEG_RWKV
R_WD = 3 * RWKV_DIM
R_AD = R_WD + 2 * DECAY_LORA
R_GD = R_AD + AAA_LORA

kernel_name = 'hybrid_mla_rwkv7_macaron_deepnorm_encoder'


def _layernorm(x, g, b):
    xf = x.astype(jnp.float32)
    mu = jnp.mean(xf, -1, keepdims=True)
    var = jnp.mean(jnp.square(xf - mu), -1, keepdims=True)
    return ((xf - mu) * lax.rsqrt(var + LN_EPS) * g + b).astype(x.dtype)


def _rmsnorm(x, g):
    xf = x.astype(jnp.float32)
    return (xf * lax.rsqrt(jnp.mean(jnp.square(xf), -1, keepdims=True) + RMS_EPS) * g).astype(x.dtype)


def _swiglu(x, w_gu, w_down):
    gate, up = jnp.split(x @ w_gu, 2, axis=-1)
    return (jax.nn.silu(gate) * up) @ w_down


def _rope_tables(seq):
    inv = 1.0 / (ROPE_THETA ** (jnp.arange(0, QK_ROPE, 2, dtype=jnp.float32) / QK_ROPE))
    ang = jnp.arange(seq, dtype=jnp.float32)[:, None] * inv[None, :]
    return jnp.cos(ang), jnp.sin(ang)


def _rope(x, cos, sin):
    x1, x2 = jnp.split(x.astype(jnp.float32), 2, axis=-1)
    return jnp.concatenate([x1 * cos - x2 * sin, x1 * sin + x2 * cos], -1).astype(x.dtype)


def _mla(h_q, h_kv, q_norm_g, w_uq, kv_norm_g, w_ukv):
    b, s, _ = h_q.shape
    cos, sin = _rope_tables(s)
    q = (_rmsnorm(h_q, q_norm_g) @ w_uq).reshape(b, s, MLA_HEADS, QK_NOPE + QK_ROPE)
    q_nope = q[..., :QK_NOPE]
    q_rope = _rope(q[..., QK_NOPE:], cos[:, None, :], sin[:, None, :])
    c_kv = _rmsnorm(h_kv[..., :KV_LORA], kv_norm_g)
    k_rope = _rope(h_kv[..., KV_LORA:], cos, sin)
    kv = (c_kv @ w_ukv).reshape(b, s, MLA_HEADS, QK_NOPE + V_HEAD)
    k_nope, v = kv[..., :QK_NOPE], kv[..., QK_NOPE:]
    scale = (QK_NOPE + QK_ROPE) ** -0.5
    nblk = s // Q_BLOCK
    qn_b = q_nope.reshape(b, nblk, Q_BLOCK, MLA_HEADS, QK_NOPE).transpose(1, 0, 2, 3, 4)
    qr_b = q_rope.reshape(b, nblk, Q_BLOCK, MLA_HEADS, QK_ROPE).transpose(1, 0, 2, 3, 4)

    def block(args):
        qn, qr = args
        sc = (jnp.einsum('bqhd,bkhd->bhqk', qn, k_nope, preferred_element_type=jnp.float32)
              + jnp.einsum('bqhd,bkd->bhqk', qr, k_rope, preferred_element_type=jnp.float32))
        pr = jax.nn.softmax(sc * scale, axis=-1)
        return jnp.einsum('bhqk,bkhd->bqhd', pr.astype(v.dtype), v)

    o = lax.map(block, (qn_b, qr_b))
    return o.transpose(1, 0, 2, 3, 4).reshape(b, s, MLA_HEADS * V_HEAD)


def _centred_shift(h, mu_prev, mu_next):
    prev = jnp.pad(h[:, :-1], ((0, 0), (1, 0), (0, 0)))
    nxt = jnp.pad(h[:, 1:], ((0, 0), (0, 1), (0, 0)))
    return h + mu_prev * (prev - h) + mu_next * (nxt - h)


def _rwkv_scan(r, w, k, v, a, bb, reverse):
    _, bsz, nh, n = r.shape

    def step(S, inp):
        rt, wt, kt, vt, at, bt = inp
        Sa = jnp.einsum('bhij,bhj->bhi', S, at)
        S = S * wt[:, :, None, :] + Sa[..., None] * bt[:, :, None, :] + vt[..., None] * kt[:, :, None, :]
        return S, jnp.einsum('bhij,bhj->bhi', S, rt)

    S0 = jnp.zeros((bsz, nh, n, n), jnp.float32)
    _, y = lax.scan(step, S0, (r, w, k, v, a, bb), reverse=reverse)
    return y


def _rwkv7(h, mu_prev, mu_next, w0, w_up, a0, a_up, g_up, k_k, k_a, r_k, lnx_g, lnx_b):
    b, s, _ = h.shape
    f32 = jnp.float32
    h = _centred_shift(h, mu_prev, mu_next).astype(f32)
    r = h[..., :RWKV_DIM]
    k = h[..., RWKV_DIM:2 * RWKV_DIM]
    v = h[..., 2 * RWKV_DIM:3 * RWKV_DIM]
    wd = h[..., R_WD:R_AD].reshape(b, s, 2, DECAY_LORA)
    ad = h[..., R_AD:R_GD]
    gd = h[..., R_GD:SEG_RWKV]
    w_log = -jax.nn.softplus(-(w0 + jnp.einsum('bsdl,dlc->bsdc', jnp.tanh(wd), w_up))) - 0.5
    decay = jnp.exp(-jnp.exp(w_log.astype(f32))).reshape(b, s, 2, RWKV_HEADS, RWKV_HEAD)
    a = jax.nn.sigmoid(a0 + ad @ a_up)
    g = jax.nn.sigmoid(gd) @ g_up
    kk = (k * k_k).reshape(b, s, RWKV_HEADS, RWKV_HEAD)
    kk = kk / jnp.maximum(jnp.sqrt(jnp.sum(kk * kk, -1, keepdims=True)), 1e-12)
    k = k * (1.0 + (a - 1.0) * k_a)
    hs = lambda t: t.reshape(b, s, RWKV_HEADS, RWKV_HEAD)
    r, k, v, a = hs(r), hs(k), hs(v), hs(a)
    tm = lambda t: t.transpose(1, 0, 2, 3)
    rt, kt, vt = tm(r), tm(k), tm(v)
    a_vec, b_vec = tm(-kk), tm(kk * a)
    y = (_rwkv_scan(rt, tm(decay[:, :, 0]), kt, vt, a_vec, b_vec, False)
         + _rwkv_scan(rt, tm(decay[:, :, 1]), kt, vt, a_vec, b_vec, True))
    y = tm(y)
    mu = jnp.mean(y, -1, keepdims=True)
    var = jnp.mean(jnp.square(y - mu), -1, keepdims=True)
    yn = ((y - mu) * lax.rsqrt(var + GN_EPS)).reshape(b, s, RWKV_DIM) * lnx_g + lnx_b
    bonus = (jnp.sum(r * k * r_k, -1, keepdims=True) * v).reshape(b, s, RWKV_DIM)
    return (yn + bonus) * g


def _cross(x, mem, mem_g, mem_b, w_cq, w_ckv, w_co):
    b, s, _ = x.shape
    m = _layernorm(mem, mem_g, mem_b)
    q = (x @ w_cq).reshape(b, s, X_HEADS, X_HEAD)
    kv = (m @ w_ckv).reshape(b, mem.shape[1], 2, X_HEADS, X_HEAD)
    sc = jnp.einsum('bqhd,bkhd->bhqk', q, kv[:, :, 0], preferred_element_type=jnp.float32) * (X_HEAD ** -0.5)
    pr = jax.nn.softmax(sc, axis=-1)
    o = jnp.einsum('bhqk,bkhd->bqhd', pr.astype(x.dtype), kv[:, :, 1]).reshape(b, s, X_HEADS * X_HEAD)
    return o @ w_co


def _layer(x, mem, p):
    b, s, _ = x.shape
    x = _layernorm(ALPHA * x + 0.5 * _swiglu(x, p['ffn1_wgu'], p['ffn1_wd']), p['ln1_g'], p['ln1_b'])
    h = x @ p['w_in']
    br_a = _mla(h[..., :OFF_KV], h[..., OFF_KV:OFF_RWKV], p['q_norm_g'], p['w_uq'],
                p['kv_norm_g'], p['w_ukv']) @ p['p_mla']
    br_b = _rwkv7(h[..., OFF_RWKV:OFF_GATE], p['mu_prev'], p['mu_next'], p['w0'], p['w_up'],
                  p['a0'], p['a_up'], p['g_up'], p['k_k'], p['k_a'], p['r_k'],
                  p['lnx_g'], p['lnx_b']).astype(x.dtype) @ p['p_rwkv']
    gates = jax.nn.sigmoid(h[..., OFF_GATE:] + p['b_gate']).reshape(b, s, N_BRANCH, D_MODEL)
    mix = (gates[:, :, 0] * br_a + gates[:, :, 1] * br_b) @ p['w_o']
    x = _layernorm(ALPHA * x + mix, p['ln2_g'], p['ln2_b'])
    x = _layernorm(ALPHA * x + _cross(x, mem, p['mem_g'], p['mem_b'], p['w_cq'], p['w_ckv'], p['w_co']),
                   p['ln3_g'], p['ln3_b'])
    x = _layernorm(ALPHA * x + 0.5 * _swiglu(x, p['ffn2_wgu'], p['ffn2_wd']), p['ln4_g'], p['ln4_b'])
    return x


def setup_inputs(seed: int = 0) -> dict:
    key = jax.random.key(seed)
    ks = iter(jax.random.split(key, 64))

    def nrm(shape, scale):
        return scale * jax.random.normal(next(ks), shape, jnp.float32)

    L, D = DEPTH, D_MODEL
    mla_out = MLA_HEADS * V_HEAD
    x_out = X_HEADS * X_HEAD
    w0_base = jnp.linspace(-6.0, -1.0, RWKV_DIM, dtype=jnp.float32) + 0.5
    return {
        'x_prompt': nrm((BATCH, SEQ, D), 1.0),
        'x_sample': nrm((DEC_BATCH, DEC_SEQ, D), 1.0),
        'mem_prompt': nrm((BATCH, MEM_LEN, D), 1.0),
        'mem_sample': nrm((DEC_BATCH, MEM_LEN, D), 1.0),
        'ln1_g': 1.0 + nrm((L, D), 0.02), 'ln1_b': nrm((L, D), 0.02),
        'ffn1_wgu': nrm((L, D, 2 * D_FF), D ** -0.5),
        'ffn1_wd': nrm((L, D_FF, D), BETA * D_FF ** -0.5),
        'w_in': nrm((L, D, D_IN), D ** -0.5),
        'b_gate': nrm((L, SEG_GATE), 0.02),
        'q_norm_g': 1.0 + nrm((L, Q_LORA), 0.02),
        'w_uq': nrm((L, Q_LORA, MLA_HEADS * (QK_NOPE + QK_ROPE)), Q_LORA ** -0.5),
        'kv_norm_g': 1.0 + nrm((L, KV_LORA), 0.02),
        'w_ukv': nrm((L, KV_LORA, MLA_HEADS * (QK_NOPE + V_HEAD)), KV_LORA ** -0.5),
        'p_mla': nrm((L, mla_out, D), mla_out ** -0.5),
        'mu_prev': jax.random.uniform(next(ks), (L, SEG_RWKV), jnp.float32, 0.1, 0.6),
        'mu_next': jax.random.uniform(next(ks), (L, SEG_RWKV), jnp.float32, 0.1, 0.6),
        'w0': w0_base + nrm((L, 2, RWKV_DIM), 0.3),
        'w_up': nrm((L, 2, DECAY_LORA, RWKV_DIM), 0.1 * DECAY_LORA ** -0.5),
        'a0': nrm((L, RWKV_DIM), 0.1),
        'a_up': nrm((L, AAA_LORA, RWKV_DIM), 0.5 * AAA_LORA ** -0.5),
        'g_up': nrm((L, GATE_LORA, RWKV_DIM), GATE_LORA ** -0.5),
        'k_k': 0.85 + nrm((L, RWKV_DIM), 0.05),
        'k_a': 1.0 + nrm((L, RWKV_DIM), 0.05),
        'r_k': nrm((L, RWKV_HEADS, RWKV_HEAD), 0.1),
        'lnx_g': 1.0 + nrm((L, RWKV_DIM), 0.02), 'lnx_b': nrm((L, RWKV_DIM), 0.02),
        'p_rwkv': nrm((L, RWKV_DIM, D), RWKV_DIM ** -0.5),
        'w_o': nrm((L, D, D), BETA * D ** -0.5),
        'ln2_g': 1.0 + nrm((L, D), 0.02), 'ln2_b': nrm((L, D), 0.02),
        'mem_g': 1.0 + nrm((L, D), 0.02), 'mem_b': nrm((L, D), 0.02),
        'w_cq': nrm((L, D, x_out), D ** -0.5),
        'w_ckv': nrm((L, D, 2 * x_out), D ** -0.5),
        'w_co': nrm((L, x_out, D), BETA * x_out ** -0.5),
        'ln3_g': 1.0 + nrm((L, D), 0.02), 'ln3_b': nrm((L, D), 0.02),
        'ffn2_wgu': nrm((L, D, 2 * D_FF), D ** -0.5),
        'ffn2_wd': nrm((L, D_FF, D), BETA * D_FF ** -0.5),
        'ln4_g': 1.0 + nrm((L, D), 0.02), 'ln4_b': nrm((L, D), 0.02),
    }


def reference(x_prompt, x_sample, mem_prompt, mem_sample, ln1_g, ln1_b, ffn1_wgu, ffn1_wd, w_in, b_gate,
              q_norm_g, w_uq, kv_norm_g, w_ukv, p_mla, mu_prev, mu_next, w0, w_up, a0, a_up, g_up,
              k_k, k_a, r_k, lnx_g, lnx_b, p_rwkv, w_o, ln2_g, ln2_b, mem_g, mem_b, w_cq, w_ckv, w_co,
              ln3_g, ln3_b, ffn2_wgu, ffn2_wd, ln4_g, ln4_b):
    y_prompt, y_sample = x_prompt, x_sample
    for l in range(DEPTH):
        p = dict(ln1_g=ln1_g[l], ln1_b=ln1_b[l], ffn1_wgu=ffn1_wgu[l], ffn1_wd=ffn1_wd[l],
                 w_in=w_in[l], b_gate=b_gate[l], q_norm_g=q_norm_g[l], w_uq=w_uq[l],
                 kv_norm_g=kv_norm_g[l], w_ukv=w_ukv[l], p_mla=p_mla[l], mu_prev=mu_prev[l],
                 mu_next=mu_next[l], w0=w0[l], w_up=w_up[l], a0=a0[l], a_up=a_up[l], g_up=g_up[l],
                 k_k=k_k[l], k_a=k_a[l], r_k=r_k[l], lnx_g=lnx_g[l], lnx_b=lnx_b[l], p_rwkv=p_rwkv[l],
                 w_o=w_o[l], ln2_g=ln2_g[l], ln2_b=ln2_b[l], mem_g=mem_g[l], mem_b=mem_b[l],
                 w_cq=w_cq[l], w_ckv=w_ckv[l], w_co=w_co[l], ln3_g=ln3_g[l], ln3_b=ln3_b[l],
                 ffn2_wgu=ffn2_wgu[l], ffn2_wd=ffn2_wd[l], ln4_g=ln4_g[l], ln4_b=ln4_b[l])
        y_prompt = _layer(y_prompt, mem_prompt, p)
        y_sample = _layer(y_sample, mem_sample, p)
    return (y_prompt, y_sample)
```

```cpp
#include <hip/hip_runtime.h>
#include <hip/hip_cooperative_groups.h>
#include <cstdio>
namespace cg = cooperative_groups;

#define LAS __attribute__((address_space(3)))
#define GAS __attribute__((address_space(1)))
#define ASSUME_GLOBAL(p) do { (p) = (unsigned char*)(__attribute__((address_space(1))) unsigned char*)(p); } while (0)
typedef unsigned short bf16_t;
typedef short bf16x8 __attribute__((ext_vector_type(8)));
typedef float f32x4 __attribute__((ext_vector_type(4)));
typedef float f32x2 __attribute__((ext_vector_type(2)));
typedef unsigned u32x4 __attribute__((ext_vector_type(4)));
typedef unsigned u32x2 __attribute__((ext_vector_type(2)));

constexpr int T = 81920, SEQ = 4096, NBATCH = 20, DM = 1024, DFF = 2816;
constexpr float ALPHA = 1.189207115002721f;
constexpr float LOG2E = 1.4426950408889634f;
constexpr float QSCALE = 0.10206207261596577f * LOG2E;
constexpr float CQSCALE = 0.08838834764831845f * LOG2E;
constexpr int LDS_BYTES = 142 * 1024;
#ifndef EN
#define EN 255
#endif
#ifndef LNX
#define LNX 0
#endif

constexpr size_t al256(size_t x) { return (x + 255) & ~(size_t)255; }
constexpr size_t O_WGU1 = 0;
constexpr size_t O_WD1 = O_WGU1 + 5632ull * 1024 * 2;
constexpr size_t O_WGU2 = O_WD1 + 1024ull * 2816 * 2;
constexpr size_t O_WD2 = O_WGU2 + 5632ull * 1024 * 2;
constexpr size_t O_WINQ = O_WD2 + 1024ull * 2816 * 2;
constexpr size_t O_WINR = O_WINQ + 768ull * 1024 * 2;
constexpr size_t O_WING = O_WINR + 2048ull * 1024 * 2;
constexpr size_t O_WUQ = O_WING + 2048ull * 1024 * 2;
constexpr size_t O_WUKV = O_WUQ + 768ull * 384 * 2;
constexpr size_t O_PMLA = O_WUKV + 1024ull * 256 * 2;
constexpr size_t O_PRWKV = O_PMLA + 1024ull * 512 * 2;
constexpr size_t O_WO = O_PRWKV + 1024ull * 512 * 2;
constexpr size_t O_WLORA = O_WO + 1024ull * 1024 * 2;
constexpr size_t O_WCQ = O_WLORA + 2048ull * 384 * 2;
constexpr size_t O_WCKV = O_WCQ + 512ull * 1024 * 2;
constexpr size_t O_WCO = O_WCKV + 1024ull * 1024 * 2;
constexpr size_t O_ROPE = O_WCO + 1024ull * 512 * 2;
constexpr size_t O_RSTD = O_ROPE + 4096ull * 32 * 4;
constexpr size_t O_MEMLN = O_RSTD + (size_t)T * 2 * 4;
constexpr size_t O_KC = O_MEMLN + 5120ull * 1024 * 2;
constexpr size_t O_VCT = O_KC + 5120ull * 512 * 2;
constexpr size_t O_PTAB = O_VCT + 5120ull * 512 * 2;
constexpr size_t O_XCH = O_PTAB + 1024;
constexpr size_t O_CNT = O_XCH + (size_t)T * 4 * 8;
constexpr size_t O_XB = O_CNT + 4ull * 320 * 256;
constexpr size_t O_ARENA = O_XB + (size_t)T * 1024 * 2;
constexpr size_t O_HR = O_ARENA;
constexpr size_t O_LOUT = O_HR + (size_t)T * 1856 * 2;
constexpr size_t O_LIN = O_LOUT + (size_t)T * 2048 * 2;
constexpr size_t O_Y = O_LIN + (size_t)T * 384 * 2;
constexpr size_t O_BOUT = O_Y + 2ull * T * 512 * 2;
constexpr size_t O_HQKV = O_BOUT + (size_t)T * 512 * 2;
constexpr size_t O_END = O_HQKV + (size_t)T * 768 * 2;
static_assert(O_END <= 1342177280ull, "workspace");
constexpr size_t O_GATES = O_ARENA;
constexpr size_t O_Q = O_GATES + (size_t)T * 2048 * 2;
constexpr size_t O_K = O_Q + (size_t)T * 768 * 2;
constexpr size_t O_VT = O_K + (size_t)T * 768 * 2;
constexpr size_t O_AOUT = O_VT + (size_t)T * 512 * 2;
static_assert(O_AOUT + (size_t)T * 512 * 2 <= O_BOUT, "overlap");
constexpr size_t O_MIX = O_Q;
static_assert(O_MIX + (size_t)T * 1024 * 2 <= O_AOUT, "overlap");
constexpr size_t O_CQ = O_ARENA;
constexpr size_t O_CO = O_CQ + (size_t)T * 512 * 2;
constexpr size_t O_HFF = O_ARENA;

struct Params {
  const float *x_p, *x_s, *mem_p, *mem_s;
  const float *ln1_g, *ln1_b, *ffn1_wgu, *ffn1_wd, *w_in, *b_gate, *q_norm_g, *w_uq, *kv_norm_g, *w_ukv, *p_mla, *mu_prev, *mu_next, *w0, *w_up, *a0, *a_up, *g_up,
      *k_k, *k_a, *r_k, *lnx_g, *lnx_b, *p_rwkv, *w_o, *ln2_g, *ln2_b, *mem_g, *mem_b, *w_cq, *w_ckv, *w_co, *ln3_g, *ln3_b, *ffn2_wgu, *ffn2_wd, *ln4_g, *ln4_b;
  float* out; unsigned char* ws;
};

enum { I_x_p, I_x_s, I_mem_p, I_mem_s, I_ln1_g, I_ln1_b, I_ffn1_wgu, I_ffn1_wd, I_w_in, I_b_gate, I_q_norm_g, I_w_uq, I_kv_norm_g, I_w_ukv, I_p_mla, I_mu_prev, I_mu_next, I_w0, I_w_up, I_a0, I_a_up, I_g_up, I_k_k, I_k_a, I_r_k, I_lnx_g, I_lnx_b, I_p_rwkv, I_w_o, I_ln2_g, I_ln2_b, I_mem_g, I_mem_b, I_w_cq, I_w_ckv, I_w_co, I_ln3_g, I_ln3_b, I_ffn2_wgu, I_ffn2_wd, I_ln4_g, I_ln4_b, I_out };
#define PT(name) (ptab[I_##name])
typedef const float* const* PTab;
__device__ __forceinline__ float bf2f(bf16_t b) { return __uint_as_float(((unsigned)b) << 16); }
__device__ __forceinline__ unsigned cvt_pk_bf16(float lo, float hi) { unsigned r; asm("v_cvt_pk_bf16_f32 %0, %1, %2" : "=v"(r) : "v"(lo), "v"(hi)); return r; }
__device__ __forceinline__ bf16_t f2bf(float f) { return (bf16_t)(cvt_pk_bf16(f, 0.f) & 0xffffu); }
__device__ __forceinline__ void unpack8(const u32x4 w, float* f) {
#pragma unroll
  for (int i = 0; i < 4; ++i) { f[2 * i] = __uint_as_float(w[i] << 16); f[2 * i + 1] = __uint_as_float(w[i] & 0xffff0000u); }
}
__device__ __forceinline__ u32x4 pack8(const float* f) { u32x4 w; w.x = cvt_pk_bf16(f[0], f[1]); w.y = cvt_pk_bf16(f[2], f[3]); w.z = cvt_pk_bf16(f[4], f[5]); w.w = cvt_pk_bf16(f[6], f[7]); return w; }
__device__ __forceinline__ float sigmoidf_(float x) { return 1.0f / (1.0f + __expf(-x)); }
template <int CTRL> __device__ __forceinline__ float dpp_f(float x) { return __builtin_bit_cast(float, __builtin_amdgcn_update_dpp(0, __builtin_bit_cast(int, x), CTRL, 0xf, 0xf, true)); }
__device__ __forceinline__ float quad_sum(float v) { v += dpp_f<0xB1>(v); v += dpp_f<0x4E>(v); return v; }
__device__ __forceinline__ float oct_sum(float v) { v += dpp_f<0xB1>(v); v += dpp_f<0x4E>(v); v += dpp_f<0x141>(v); return v; }
__device__ __forceinline__ float row16_sum(float v) { v = oct_sum(v); v += dpp_f<0x140>(v); return v; }

__device__ __forceinline__ float xrow16_max(float x) {
  auto s = __builtin_amdgcn_permlane16_swap(__float_as_uint(x), __float_as_uint(x), false, false);
  x = fmaxf(__uint_as_float(s[0]), __uint_as_float(s[1]));
  auto t = __builtin_amdgcn_permlane32_swap(__float_as_uint(x), __float_as_uint(x), false, false);
  return fmaxf(__uint_as_float(t[0]), __uint_as_float(t[1]));
}
__device__ __forceinline__ float xrow16_sum(float x) {
  auto s = __builtin_amdgcn_permlane16_swap(__float_as_uint(x), __float_as_uint(x), false, false);
  x = __uint_as_float(s[0]) + __uint_as_float(s[1]);
  auto t = __builtin_amdgcn_permlane32_swap(__float_as_uint(x), __float_as_uint(x), false, false);
  return __uint_as_float(t[0]) + __uint_as_float(t[1]);
}
__device__ __forceinline__ float wave_sum(float v) { return xrow16_sum(row16_sum(v)); }
constexpr int BM = 256, BK = 64, HALF = 128, HTB = HALF * BK * 2, STAGE_BYTES = 8 * HTB, NXCD = 8, WGM = 8;
__device__ __forceinline__ int lds_byte(int r, int c) { const int st = (r >> 4) * 2 + (c >> 5), rr = r & 15, cc = c & 31, ob = rr * 64 + cc * 2; return st * 1024 + (ob ^ (((ob >> 9) & 1) << 5)); }
__device__ __forceinline__ void stage_rc(int b, int& R, int& C) { const int st = b / 1024, sb = b % 1024, swz = sb ^ (((sb >> 9) & 1) << 5); R = (st >> 1) * 16 + swz / 64; C = (st & 1) * 32 + (swz % 64) / 2; }
__device__ __forceinline__ int perm32(int rho) { const int n = rho >> 4, i = rho & 15; return 8 * (i >> 2) + 4 * n + (i & 3); }
struct Unit { int pm, pn; };
struct Gemm { const bf16_t* A; const bf16_t* Bt; int M, N, K, lda, ldb; };
struct StaticOrder {
  int nM, nN, nwg, G, c;
  __device__ void init(int M, int N, int G_, int c_) { nM = M / BM; nN = N / BM; nwg = nM * nN; G = G_; c = c_; }
  __device__ bool next(int i, Unit& u) const {
    const long L = (long)i * G + c; if (L >= nwg) return false;
    int wgid = (int)L; { const int q = nwg / NXCD, r = nwg % NXCD, xcd = wgid % NXCD, off = wgid / NXCD; wgid = (xcd < r ? xcd * (q + 1) : r * (q + 1) + (xcd - r) * q) + off; }
    const int nig = WGM * nN, gid = wgid / nig, fm = gid * WGM, gsz = (nM - fm) < WGM ? (nM - fm) : WGM;
    u.pm = fm + ((wgid % nig) % gsz); u.pn = (wgid % nig) / gsz; return true;
  }
};

typedef f32x4 Acc[2][2][4][2];

struct EpiSwiglu {
  static constexpr bool PERM = true;
  bf16_t* H;
  __device__ __forceinline__ void operator()(const Acc& acc, const Unit& u, int wr, int wc, int fr, int fq) const {
    const int col0 = u.pn * 128 + wc * 32 + 8 * fq;
#pragma unroll
    for (int ai = 0; ai < 2; ++ai)
#pragma unroll
      for (int m = 0; m < 4; ++m) {
        const int row = u.pm * BM + ai * HALF + wr * 64 + m * 16 + fr;
        float o[8];
#pragma unroll
        for (int n = 0; n < 2; ++n)
#pragma unroll
          for (int j = 0; j < 4; ++j) { const float gte = acc[ai][0][m][n][j], up = acc[ai][1][m][n][j]; o[n * 4 + j] = gte * up / (1.0f + __expf(-gte)); }
        *(GAS u32x4*)(H + (size_t)row * DFF + col0) = pack8(o);
      }
  }
};

__device__ __forceinline__ f32x4 sig4(f32x4 v) { f32x4 o; o[0] = sigmoidf_(v[0]); o[1] = sigmoidf_(v[1]); o[2] = sigmoidf_(v[2]); o[3] = sigmoidf_(v[3]); return o; }
__device__ __forceinline__ float dec1(float x) { return -(0.6065306597126334f * LOG2E) / (1.0f + __expf(-x)); }
__device__ __forceinline__ f32x4 dec4(f32x4 v) { f32x4 o; o[0] = dec1(v[0]); o[1] = dec1(v[1]); o[2] = dec1(v[2]); o[3] = dec1(v[3]); return o; }
template <int ACT>
struct EpiBf16 {
  static constexpr bool PERM = true;
  bf16_t* O; int ldc; int ncols; float scale; const float* bias; const float* w0; const float* a0;
  __device__ __forceinline__ void operator()(const Acc& acc, const Unit& u, int wr, int wc, int fr, int fq) const {
#pragma unroll
    for (int bj = 0; bj < 2; ++bj) {
      const int c0 = u.pn * BM + bj * HALF + wc * 32 + 8 * fq;
      const bool active = c0 < ncols;
      f32x4 b0 = (f32x4){0.f, 0.f, 0.f, 0.f}, b1 = (f32x4){0.f, 0.f, 0.f, 0.f};
      if (ACT == 1) { b0 = *(const GAS f32x4*)(bias + c0); b1 = *(const GAS f32x4*)(bias + c0 + 4); }
      if (ACT == 2) { if (u.pn < 6) { const float* src = (u.pn < 4) ? (w0 + c0) : (a0 + (c0 - 1024)); b0 = *(const GAS f32x4*)(src); b1 = *(const GAS f32x4*)(src + 4); } }
#pragma unroll
      for (int ai = 0; ai < 2; ++ai)
#pragma unroll
        for (int m = 0; m < 4; ++m) {
          const int row = u.pm * BM + ai * HALF + wr * 64 + m * 16 + fr;
          f32x4 v0 = acc[ai][bj][m][0], v1 = acc[ai][bj][m][1];
          if (ACT == 0) { v0 *= scale; v1 *= scale; }
          if (ACT == 1) { v0 = sig4(v0 + b0); v1 = sig4(v1 + b1); }
          if (ACT == 2) { if (u.pn < 4) { v0 = dec4(v0 + b0); v1 = dec4(v1 + b1); } else if (u.pn < 6) { v0 = sig4(v0 + b0); v1 = sig4(v1 + b1); } }
          u32x4 w; w.x = cvt_pk_bf16(v0[0], v0[1]); w.y = cvt_pk_bf16(v0[2], v0[3]); w.z = cvt_pk_bf16(v1[0], v1[1]); w.w = cvt_pk_bf16(v1[2], v1[3]);
          if (active) *(GAS u32x4*)(O + (size_t)row * ldc + c0) = w;
        }
    }
  }
};

struct EpiTrunk {
  static constexpr bool PERM = false;
  const float* base_p; const float* base_s; float* out; float scale;
  __device__ __forceinline__ void operator()(const Acc& acc, const Unit& u, int wr, int wc, int fr, int fq) const {
    const int col0 = u.pn * BM + wc * 32 + 4 * fq;
#pragma unroll
    for (int ai = 0; ai < 2; ++ai)
#pragma unroll
      for (int m = 0; m < 4; ++m) {
        const int row = u.pm * BM + ai * HALF + wr * 64 + m * 16 + fr;
        const float* bp = (base_s && row >= 65536) ? base_s + (size_t)(row - 65536) * DM : base_p + (size_t)row * DM;
        float* op = out + (size_t)row * DM;
#pragma unroll
        for (int bj = 0; bj < 2; ++bj)
#pragma unroll
          for (int n = 0; n < 2; ++n) { const int c = col0 + bj * HALF + n * 16; const f32x4 bs = *(const GAS f32x4*)(bp + c); *(GAS f32x4*)(op + c) = bs * ALPHA + acc[ai][bj][m][n] * scale; }
        asm volatile("" ::: "memory");
      }
  }
};

struct EpiTrunkLN {
  const float* base_p; const float* base_s; float* out; bf16_t* xb; const float* lg; const float* lb; unsigned long long* X; unsigned* cnt; float scale; LAS unsigned char* lds;
  __device__ __forceinline__ void operator()(const Acc& acc, const Unit& u, int wr, int wc, int fr, int fq) const {
    LAS f32x2* P = (LAS f32x2*)(lds + 131072);
    LAS f32x2* St = (LAS f32x2*)(lds + 131072 + 8192);
    const int col0 = u.pn * BM + wc * 32 + 8 * fq; const int wid = wr * 4 + wc, lane = fq * 16 + fr;
    const float* ubase = (base_s && u.pm >= 256) ? base_s + (size_t)(u.pm - 256) * BM * DM : base_p + (size_t)u.pm * BM * DM;
    float* uout = out + (size_t)u.pm * BM * DM; bf16_t* uxb = xb ? xb + (size_t)u.pm * BM * DM : nullptr;
#define LN_LOADB(dst, aim_) do { _Pragma("unroll") for (int mm = 0; mm < 2; ++mm) _Pragma("unroll") for (int bj = 0; bj < 2; ++bj) _Pragma("unroll") for (int n = 0; n < 2; ++n) \
      dst[mm][bj][n] = *(const GAS f32x4*)(ubase + ((((aim_) >> 1) * HALF + wr * 64 + ((((aim_) & 1) * 2) + mm) * 16 + fr) * DM + col0 + bj * HALF + n * 4)); } while (0)
#define LN_SUMB(src, aim_) do { _Pragma("unroll") for (int mm = 0; mm < 2; ++mm) { const int ai = (aim_) >> 1, m = ((aim_) & 1) * 2 + mm; const int rl = ai * HALF + wr * 64 + m * 16 + fr; float sm = 0.f, sq = 0.f; \
      _Pragma("unroll") for (int bj = 0; bj < 2; ++bj) _Pragma("unroll") for (int n = 0; n < 2; ++n) { const f32x4 v = src[mm][bj][n] * ALPHA + acc[ai][bj][m][n] * scale; \
        sm += (v[0] + v[1]) + (v[2] + v[3]); sq += (v[0] * v[0] + v[1] * v[1]) + (v[2] * v[2] + v[3] * v[3]); } \
      sm = xrow16_sum(sm); sq = xrow16_sum(sq); if (fq == 0) P[rl * 4 + wc] = (f32x2){sm, sq}; } } while (0)
    {
      f32x4 bA[2][2][2], bB[2][2][2];
      LN_LOADB(bA, 0); LN_LOADB(bB, 1); asm volatile("" ::: "memory");
      LN_SUMB(bA, 0); LN_SUMB(bB, 1); asm volatile("" ::: "memory");
      LN_LOADB(bA, 2); LN_LOADB(bB, 3); asm volatile("" ::: "memory");
      LN_SUMB(bA, 2); LN_SUMB(bB, 3);
    }
    asm volatile("s_waitcnt lgkmcnt(0)" ::: "memory"); __builtin_amdgcn_s_barrier(); __builtin_amdgcn_s_barrier(); asm volatile("" ::: "memory");
#if !(LNX & 1)
    const int rl2 = wid * 32 + (lane & 31);
    if (lane < 32) {
      const f32x2 a = P[rl2 * 4 + 0], b = P[rl2 * 4 + 1], c = P[rl2 * 4 + 2], d = P[rl2 * 4 + 3];
      const float s4 = (a.x + b.x) + (c.x + d.x), q4 = (a.y + b.y) + (c.y + d.y);
      __hip_atomic_store(X + ((size_t)(u.pm * BM + rl2) * 4 + u.pn), ((unsigned long long)__float_as_uint(q4) << 32) | __float_as_uint(s4), __ATOMIC_RELAXED, __HIP_MEMORY_SCOPE_AGENT);
    }
    asm volatile("s_waitcnt vmcnt(0)" ::: "memory");
    if (lane == 0) __hip_atomic_fetch_add(cnt + 64 * u.pm, 1u, __ATOMIC_RELAXED, __HIP_MEMORY_SCOPE_AGENT);
    __builtin_amdgcn_s_barrier();
    while ((unsigned)__builtin_amdgcn_readfirstlane((int)__hip_atomic_load(cnt + 64 * u.pm, __ATOMIC_RELAXED, __HIP_MEMORY_SCOPE_AGENT)) < 32u) __builtin_amdgcn_s_sleep(1);
    __builtin_amdgcn_fence(__ATOMIC_ACQUIRE, "agent");
    if (lane < 32) {
      const unsigned long long* sl = X + (size_t)(u.pm * BM + rl2) * 4; float S = 0.f, Q = 0.f;
#pragma unroll
      for (int t = 0; t < 4; ++t) { const unsigned long long w = __hip_atomic_load(sl + t, __ATOMIC_RELAXED, __HIP_MEMORY_SCOPE_AGENT); S += __uint_as_float((unsigned)w); Q += __uint_as_float((unsigned)(w >> 32)); }
      const float mean = S * (1.0f / 1024.0f); const float var = fmaxf(Q * (1.0f / 1024.0f) - mean * mean, 0.f);
      St[rl2] = (f32x2){mean, 1.0f / sqrtf(var + 1e-5f)};
    }
    asm volatile("s_waitcnt vmcnt(0) lgkmcnt(0)" ::: "memory"); __builtin_amdgcn_s_barrier(); __builtin_amdgcn_s_barrier(); asm volatile("" ::: "memory");
#endif
#if !(LNX & 2)
    float scale2 = scale; asm volatile("" : "+s"(scale2));
#define LN_APPLYB(src, aim_) do { _Pragma("unroll") for (int mm = 0; mm < 2; ++mm) { const int ai = (aim_) >> 1, m = ((aim_) & 1) * 2 + mm; const int rl = ai * HALF + wr * 64 + m * 16 + fr; const int off = rl * DM + col0; const f32x2 sr = St[rl]; \
      _Pragma("unroll") for (int bj = 0; bj < 2; ++bj) { f32x4 o2[2]; \
        _Pragma("unroll") for (int n = 0; n < 2; ++n) { const f32x4 v = src[mm][bj][n] * ALPHA + acc[ai][bj][m][n] * scale2; o2[n] = (v - sr.x) * sr.y * *(const GAS f32x4*)(lg + col0 + bj * HALF + n * 4) + *(const GAS f32x4*)(lb + col0 + bj * HALF + n * 4); \
          *(GAS f32x4*)(uout + (off + bj * HALF + n * 4)) = o2[n]; } \
        if (uxb) { u32x4 w; w.x = cvt_pk_bf16(o2[0][0], o2[0][1]); w.y = cvt_pk_bf16(o2[0][2], o2[0][3]); w.z = cvt_pk_bf16(o2[1][0], o2[1][1]); w.w = cvt_pk_bf16(o2[1][2], o2[1][3]); *(GAS u32x4*)(uxb + (off + bj * HALF)) = w; } } } } while (0)
    {
      f32x4 bA[2][2][2], bB[2][2][2];
      LN_LOADB(bA, 0); LN_LOADB(bB, 1); asm volatile("" ::: "memory");
      LN_APPLYB(bA, 0); LN_APPLYB(bB, 1); asm volatile("" ::: "memory");
      LN_LOADB(bA, 2); LN_LOADB(bB, 3); asm volatile("" ::: "memory");
      LN_APPLYB(bA, 2); LN_APPLYB(bB, 3);
    }
#undef LN_LOADB
#undef LN_SUMB
#undef LN_APPLYB
#endif
  }
};

struct EpiQ {
  static constexpr bool PERM = true;
  bf16_t* Q; const float* rstd; const float* rope;
  __device__ __forceinline__ void operator()(const Acc& acc, const Unit& u, int wr, int wc, int fr, int fq) const {
    float rsv[2][4];
#pragma unroll
    for (int ai = 0; ai < 2; ++ai)
#pragma unroll
      for (int m = 0; m < 4; ++m) rsv[ai][m] = ((const GAS float*)rstd)[(size_t)(u.pm * BM + ai * HALF + wr * 64 + m * 16 + fr) * 2];
#pragma unroll
    for (int ai = 0; ai < 2; ++ai)
#pragma unroll
      for (int m = 0; m < 4; ++m) {
        const int row = u.pm * BM + ai * HALF + wr * 64 + m * 16 + fr; const int b = row >> 12, s = row & 4095;
        const float rs = rsv[ai][m] * QSCALE;
#pragma unroll
        for (int bj = 0; bj < 2; ++bj) {
          const int G = 8 * u.pn + 4 * bj + wc; const int h = G / 3, part = G - 3 * h;
          f32x4 v0 = acc[ai][bj][m][0] * rs, v1 = acc[ai][bj][m][1] * rs;
          if (part == 2) { const f32x4 c = *(const GAS f32x4*)(rope + s * 32 + 4 * fq), sn = *(const GAS f32x4*)(rope + s * 32 + 16 + 4 * fq);
            const f32x4 o0 = v0 * c - v1 * sn, o1 = v0 * sn + v1 * c; v0 = o0; v1 = o1; }
          u32x4 w; w.x = cvt_pk_bf16(v0[0], v0[1]); w.y = cvt_pk_bf16(v0[2], v0[3]); w.z = cvt_pk_bf16(v1[0], v1[1]); w.w = cvt_pk_bf16(v1[2], v1[3]);
          *(GAS u32x4*)(Q + ((size_t)(b * 8 + h) * SEQ + s) * 96 + part * 32 + 8 * fq) = w;
        }
      }
  }
};

struct EpiKV {
  static constexpr bool PERM = true;
  bf16_t* K; bf16_t* Vt; const float* rstd;
  __device__ __forceinline__ void operator()(const Acc& acc, const Unit& u, int wr, int wc, int fr, int fq) const {
    float rsv[2][4];
#pragma unroll
    for (int ai = 0; ai < 2; ++ai)
#pragma unroll
      for (int m = 0; m < 4; ++m) rsv[ai][m] = ((const GAS float*)rstd)[(size_t)(u.pm * BM + ai * HALF + wr * 64 + m * 16 + fr) * 2 + 1];
#pragma unroll
    for (int ai = 0; ai < 2; ++ai)
#pragma unroll
      for (int m = 0; m < 4; ++m) {
        const int row = u.pm * BM + ai * HALF + wr * 64 + m * 16 + fr; const int b = row >> 12, s = row & 4095;
        const float rs = rsv[ai][m];
#pragma unroll
        for (int bj = 0; bj < 2; ++bj) {
          const int G = 8 * u.pn + 4 * bj + wc; const int h = G >> 2, part = G & 3;
          const f32x4 v0 = acc[ai][bj][m][0] * rs, v1 = acc[ai][bj][m][1] * rs;
          if (part < 2) { u32x4 w; w.x = cvt_pk_bf16(v0[0], v0[1]); w.y = cvt_pk_bf16(v0[2], v0[3]); w.z = cvt_pk_bf16(v1[0], v1[1]); w.w = cvt_pk_bf16(v1[2], v1[3]);
            *(GAS u32x4*)(K + ((size_t)(b * 8 + h) * SEQ + s) * 96 + part * 32 + 8 * fq) = w; }
          else { GAS bf16_t* vp = (GAS bf16_t*)Vt + ((size_t)(b * 8 + h) * 64 + (part - 2) * 32 + 8 * fq) * SEQ + s;
#pragma unroll
            for (int j = 0; j < 4; ++j) { vp[(size_t)j * SEQ] = f2bf(v0[j]); vp[(size_t)(4 + j) * SEQ] = f2bf(v1[j]); } }
        }
      }
  }
};

struct EpiCKV {
  static constexpr bool PERM = true;
  bf16_t* Kc; bf16_t* VcT;
  __device__ __forceinline__ void operator()(const Acc& acc, const Unit& u, int wr, int wc, int fr, int fq) const {
#pragma unroll
    for (int ai = 0; ai < 2; ++ai)
#pragma unroll
      for (int m = 0; m < 4; ++m) {
        const int row = u.pm * BM + ai * HALF + wr * 64 + m * 16 + fr; const int b = row >> 8, key = row & 255;
#pragma unroll
        for (int bj = 0; bj < 2; ++bj) {
          const int c0 = u.pn * BM + bj * HALF + wc * 32 + 8 * fq;
          const f32x4 v0 = acc[ai][bj][m][0], v1 = acc[ai][bj][m][1];
          if (c0 < 512) { u32x4 w; w.x = cvt_pk_bf16(v0[0], v0[1]); w.y = cvt_pk_bf16(v0[2], v0[3]); w.z = cvt_pk_bf16(v1[0], v1[1]); w.w = cvt_pk_bf16(v1[2], v1[3]);
            *(GAS u32x4*)(Kc + (size_t)row * 512 + c0) = w; }
          else { const int cc = c0 - 512; GAS bf16_t* vp = (GAS bf16_t*)VcT + ((size_t)(b * 4 + (cc >> 7)) * 128 + (cc & 127)) * 256 + key;
#pragma unroll
            for (int j = 0; j < 4; ++j) { vp[j * 256] = f2bf(v0[j]); vp[(4 + j) * 256] = f2bf(v1[j]); } }
        }
      }
  }
};

template <int SECOND>
struct EpiMix {
  static constexpr bool PERM = true;
  bf16_t* mix; const bf16_t* gates; int goff;
  __device__ __forceinline__ void operator()(const Acc& acc, const Unit& u, int wr, int wc, int fr, int fq) const {
#pragma unroll
    for (int ai = 0; ai < 2; ++ai) {
      u32x4 gw[4][2], mw[4][2];
#pragma unroll
      for (int m = 0; m < 4; ++m)
#pragma unroll
        for (int bj = 0; bj < 2; ++bj) {
          const int row = u.pm * BM + ai * HALF + wr * 64 + m * 16 + fr; const int c0 = u.pn * BM + bj * HALF + wc * 32 + 8 * fq;
          gw[m][bj] = *(const GAS u32x4*)(gates + (size_t)row * 2048 + goff + c0);
          if (SECOND) mw[m][bj] = *(const GAS u32x4*)(mix + (size_t)row * DM + c0);
        }
#pragma unroll
      for (int m = 0; m < 4; ++m)
#pragma unroll
        for (int bj = 0; bj < 2; ++bj) {
          const int row = u.pm * BM + ai * HALF + wr * 64 + m * 16 + fr; const int c0 = u.pn * BM + bj * HALF + wc * 32 + 8 * fq;
          float gt[8], o[8]; unpack8(gw[m][bj], gt);
          if (SECOND) unpack8(mw[m][bj], o);
#pragma unroll
          for (int n = 0; n < 2; ++n)
#pragma unroll
            for (int j = 0; j < 4; ++j) { const float v = gt[n * 4 + j] * acc[ai][bj][m][n][j]; o[n * 4 + j] = SECOND ? o[n * 4 + j] + v : v; }
          *(GAS u32x4*)(mix + (size_t)row * DM + c0) = pack8(o);
        }
      asm volatile("" ::: "memory");
    }
  }
};

struct Epi {
  int mode; bf16_t* O; bf16_t* O2; const bf16_t* bfp; const float* f0; const float* f1; float* outf; int ldc, ncols, goff; float scale; const float* g0; const float* g1; unsigned char* wsx; LAS unsigned char* lds;
  __device__ __forceinline__ bool perm() const { return mode != 4; }
  __device__ __forceinline__ void operator()(Acc& acc, const Unit& u, int wr, int wc, int fr, int fq) const {
    switch (mode) {
      case 0: EpiBf16<0>{O, ldc, ncols, scale, nullptr, nullptr, nullptr}(acc, u, wr, wc, fr, fq); break;
      case 1: EpiBf16<1>{O, ldc, ncols, 1.0f, f0, nullptr, nullptr}(acc, u, wr, wc, fr, fq); break;
      case 2: EpiBf16<2>{O, ldc, ncols, 1.0f, nullptr, f0, f1}(acc, u, wr, wc, fr, fq); break;
      case 3: EpiSwiglu{O}(acc, u, wr, wc, fr, fq); break;
      case 4: EpiTrunkLN{f0, f1, outf, O, g0, g1, (unsigned long long*)(wsx + O_XCH), (unsigned*)(wsx + O_CNT) + (size_t)ldc * 320 * 64, scale, lds}(acc, u, wr, wc, fr, fq); break;
      case 5: EpiQ{O, f0, f1}(acc, u, wr, wc, fr, fq); break;
      case 6: EpiKV{O, O2, f0}(acc, u, wr, wc, fr, fq); break;
      case 7: EpiCKV{O, O2}(acc, u, wr, wc, fr, fq); break;
      case 8: EpiMix<0>{O, bfp, goff}(acc, u, wr, wc, fr, fq); break;
      default: EpiMix<1>{O, bfp, goff}(acc, u, wr, wc, fr, fq); break;
    }
  }
};

__device__ __forceinline__ Gemm get_gemm(int step, PTab ptab, unsigned char* ws) {
  const bf16_t* xb = (const bf16_t*)(ws + O_XB);
  switch (step) {
    case 1: return Gemm{xb, (const bf16_t*)(ws + O_WGU1), T, 5632, 1024, 1024, 1024};
    case 2: return Gemm{(const bf16_t*)(ws + O_MEMLN), (const bf16_t*)(ws + O_WCKV), 5120, 1024, 1024, 1024, 1024};
    case 3: return Gemm{(const bf16_t*)(ws + O_HFF), (const bf16_t*)(ws + O_WD1), T, 1024, 2816, 2816, 2816};
    case 5: return Gemm{xb, (const bf16_t*)(ws + O_WINR), T, 2048, 1024, 1024, 1024};
    case 6: return Gemm{xb, (const bf16_t*)(ws + O_WINQ), T, 768, 1024, 1024, 1024};
    case 8: return Gemm{(const bf16_t*)(ws + O_LIN), (const bf16_t*)(ws + O_WLORA), T, 2048, 384, 384, 384};
    case 11: return Gemm{xb, (const bf16_t*)(ws + O_WING), T, 2048, 1024, 1024, 1024};
    case 12: return Gemm{(const bf16_t*)(ws + O_HQKV), (const bf16_t*)(ws + O_WUQ), T, 768, 384, 768, 384};
    case 13: return Gemm{(const bf16_t*)(ws + O_HQKV) + 384, (const bf16_t*)(ws + O_WUKV), T, 1024, 256, 768, 256};
    case 15: return Gemm{(const bf16_t*)(ws + O_AOUT), (const bf16_t*)(ws + O_PMLA), T, 1024, 512, 512, 512};
    case 16: return Gemm{(const bf16_t*)(ws + O_BOUT), (const bf16_t*)(ws + O_PRWKV), T, 1024, 512, 512, 512};
    case 17: return Gemm{(const bf16_t*)(ws + O_MIX), (const bf16_t*)(ws + O_WO), T, 1024, 1024, 1024, 1024};
    case 19: return Gemm{xb, (const bf16_t*)(ws + O_WCQ), T, 512, 1024, 1024, 1024};
    case 21: return Gemm{(const bf16_t*)(ws + O_CO), (const bf16_t*)(ws + O_WCO), T, 1024, 512, 512, 512};
    case 23: return Gemm{xb, (const bf16_t*)(ws + O_WGU2), T, 5632, 1024, 1024, 1024};
    case 24: return Gemm{(const bf16_t*)(ws + O_HFF), (const bf16_t*)(ws + O_WD2), T, 1024, 2816, 2816, 2816};
    default: return Gemm{nullptr, nullptr, 0, 0, 0, 0, 0};
  }
}
__device__ __forceinline__ Epi get_epi(int step, PTab ptab, unsigned char* ws, LAS unsigned char* lds) {
  const float* rope = (const float*)(ws + O_ROPE); const float* rstd = (const float*)(ws + O_RSTD);
  switch (step) {
    case 1: return Epi{3, (bf16_t*)(ws + O_HFF), nullptr, nullptr, nullptr, nullptr, nullptr, 0, 0, 0, 1.0f};
    case 2: return Epi{7, (bf16_t*)(ws + O_KC), (bf16_t*)(ws + O_VCT), nullptr, nullptr, nullptr, nullptr, 0, 0, 0, 1.0f};
    case 3: return Epi{4, (bf16_t*)(ws + O_XB), nullptr, nullptr, PT(x_p), PT(x_s), ((float*)PT(out)), 0, 0, 0, 0.5f, PT(ln1_g), PT(ln1_b), ws, lds};
    case 5: return Epi{0, (bf16_t*)(ws + O_HR), nullptr, nullptr, nullptr, nullptr, nullptr, 1856, 1856, 0, 1.0f};
    case 6: return Epi{0, (bf16_t*)(ws + O_HQKV), nullptr, nullptr, nullptr, nullptr, nullptr, 768, 768, 0, 1.0f};
    case 8: return Epi{2, (bf16_t*)(ws + O_LOUT), nullptr, nullptr, PT(w0), PT(a0), nullptr, 2048, 2048, 0, 1.0f};
    case 11: return Epi{1, (bf16_t*)(ws + O_GATES), nullptr, nullptr, PT(b_gate), nullptr, nullptr, 2048, 2048, 0, 1.0f};
    case 12: return Epi{5, (bf16_t*)(ws + O_Q), nullptr, nullptr, rstd, rope, nullptr, 0, 0, 0, 1.0f};
    case 13: return Epi{6, (bf16_t*)(ws + O_K), (bf16_t*)(ws + O_VT), nullptr, rstd, nullptr, nullptr, 0, 0, 0, 1.0f};
    case 15: return Epi{8, (bf16_t*)(ws + O_MIX), nullptr, (const bf16_t*)(ws + O_GATES), nullptr, nullptr, nullptr, 0, 0, 0, 1.0f};
    case 16: return Epi{9, (bf16_t*)(ws + O_MIX), nullptr, (const bf16_t*)(ws + O_GATES), nullptr, nullptr, nullptr, 0, 0, 1024, 1.0f};
    case 17: return Epi{4, (bf16_t*)(ws + O_XB), nullptr, nullptr, ((float*)PT(out)), nullptr, ((float*)PT(out)), 1, 0, 0, 1.0f, PT(ln2_g), PT(ln2_b), ws, lds};
    case 19: return Epi{0, (bf16_t*)(ws + O_CQ), nullptr, nullptr, nullptr, nullptr, nullptr, 512, 512, 0, CQSCALE};
    case 21: return Epi{4, (bf16_t*)(ws + O_XB), nullptr, nullptr, ((float*)PT(out)), nullptr, ((float*)PT(out)), 2, 0, 0, 1.0f, PT(ln3_g), PT(ln3_b), ws, lds};
    case 23: return Epi{3, (bf16_t*)(ws + O_HFF), nullptr, nullptr, nullptr, nullptr, nullptr, 0, 0, 0, 1.0f};
    case 24: return Epi{4, nullptr, nullptr, nullptr, ((float*)PT(out)), nullptr, ((float*)PT(out)), 3, 0, 0, 0.5f, PT(ln4_g), PT(ln4_b), ws, lds};
    default: return Epi{0, nullptr, nullptr, nullptr, nullptr, nullptr, nullptr, 0, 0, 0, 1.0f};
  }
}

__device__ __forceinline__ void gemm_phase(LAS unsigned char* lds, const int step, PTab ptab, unsigned char* ws, const int tid) {
  const Gemm g = get_gemm(step, ptab, ws); const bool permB = true;
  StaticOrder S; S.init(g.M, g.N, (int)gridDim.x, (int)blockIdx.x);
  const int wid = __builtin_amdgcn_readfirstlane(tid >> 6), lane = tid & 63, wr = wid >> 2, wc = wid & 3, fr = lane & 15, fq = lane >> 4;
  const int K = g.K, nt = K / BK;
  unsigned voffA[2], voffB[2]; int aoff, boff;
#define PG8_LANE_SETUP() do { int tid_l = tid; asm volatile("" : "+v"(tid_l)); const int lane_l = tid_l & 63, fr_l = lane_l & 15, fq_l = lane_l >> 4; \
    _Pragma("unroll") for (int i = 0; i < 2; ++i) { int R, C; stage_rc(tid_l * 16 + i * 8192, R, C); const int Rb = permB ? ((R & ~31) + perm32(R & 31)) : R; \
      voffA[i] = (unsigned)(R * g.lda + C) * 2u; voffB[i] = (unsigned)(Rb * g.ldb + C) * 2u; } \
    aoff = lds_byte(wr * 64 + fr_l, fq_l * 8); boff = lds_byte(wc * 32 + fr_l, fq_l * 8); } while (0)
  PG8_LANE_SETUP();
  const size_t kstep = (size_t)(BK * 2);
  const size_t hstepA = (size_t)HALF * g.lda * 2, hstepB = (size_t)HALF * g.ldb * 2;
  const size_t tstepA = 2 * hstepA, tstepB = 2 * hstepB;
  const unsigned ldsw = (unsigned)wid * 1024u;
#define PG8_SA(b, h) (((b) * 2 + (h)) * HTB)
#define PG8_SB(b, h) ((4 + (b) * 2 + (h)) * HTB)
#define PG8_STAGE(bufoff, gbase, voff) do { _Pragma("unroll") for (int _i = 0; _i < 2; ++_i) \
    __builtin_amdgcn_global_load_lds((const unsigned*)((const char*)(gbase) + (voff)[_i]), (LAS unsigned*)(lds + (bufoff) + ldsw + _i * 8192), 16, 0, 0); } while (0)
#define PG8_LDA(dst, b, h) do { _Pragma("unroll") for (int m = 0; m < 4; ++m) _Pragma("unroll") for (int k = 0; k < 2; ++k) dst[m][k] = *(const LAS bf16x8*)(lds + PG8_SA(b, h) + aoff + m * 2048 + k * 1024); } while (0)
#define PG8_LDB(dst, b, h) do { _Pragma("unroll") for (int n = 0; n < 2; ++n) _Pragma("unroll") for (int k = 0; k < 2; ++k) dst[n][k] = *(const LAS bf16x8*)(lds + PG8_SB(b, h) + boff + n * 2048 + k * 1024); } while (0)
#define PG8_MMA(ai, bj, At, Bt) do { __builtin_amdgcn_s_setprio(1); _Pragma("unroll") for (int m = 0; m < 4; ++m) _Pragma("unroll") for (int n = 0; n < 2; ++n) _Pragma("unroll") for (int k = 0; k < 2; ++k) \
    acc[ai][bj][m][n] = __builtin_amdgcn_mfma_f32_16x16x32_bf16(Bt[n][k], At[m][k], acc[ai][bj][m][n], 0, 0, 0); __builtin_amdgcn_s_setprio(0); } while (0)
#define PG8_WAIT_V(n) asm volatile("s_waitcnt vmcnt(" #n ")" ::: "memory")
#define PG8_WAIT_L(n) asm volatile("s_waitcnt lgkmcnt(" #n ")" ::: "memory")
#define PG8_BAR __builtin_amdgcn_s_barrier()
#define PG8_SCHED __builtin_amdgcn_sched_barrier(0)
  Unit cur, nxt; int ui = 0;
  if (!S.next(0, cur)) return;
  f32x4 acc[2][2][4][2];
#pragma unroll
  for (int a = 0; a < 2; ++a)
#pragma unroll
    for (int b = 0; b < 2; ++b)
#pragma unroll
      for (int m = 0; m < 4; ++m)
#pragma unroll
        for (int n = 0; n < 2; ++n) acc[a][b][m][n] = (f32x4){0.f, 0.f, 0.f, 0.f};
  bf16x8 At[4][2], B0[2][2], B1[2][2];
  const char* cA = (const char*)g.A + (size_t)cur.pm * tstepA; const char* cB = (const char*)g.Bt + (size_t)cur.pn * tstepB;
  PG8_STAGE(PG8_SB(0, 0), cB, voffB); PG8_STAGE(PG8_SA(0, 0), cA, voffA); PG8_STAGE(PG8_SB(0, 1), cB + hstepB, voffB); PG8_STAGE(PG8_SA(0, 1), cA + hstepA, voffA);
  if (wr == 1) PG8_BAR;
  PG8_WAIT_V(4); PG8_BAR;
  PG8_STAGE(PG8_SB(1, 0), cB + kstep, voffB); PG8_STAGE(PG8_SA(1, 0), cA + kstep, voffA); PG8_STAGE(PG8_SB(1, 1), cB + hstepB + kstep, voffB);
  PG8_WAIT_V(6); PG8_BAR;
  for (;;) {
    const bool has_next = S.next(ui + 1, nxt);
    const char* nA = has_next ? (const char*)g.A + (size_t)nxt.pm * tstepA : cA; const char* nB = has_next ? (const char*)g.Bt + (size_t)nxt.pn * tstepB : cB;
    for (int t = 0; t < nt; t += 2) {
      const bool last = (t == nt - 2);
      const char* a1 = cA + (size_t)(t + 1) * kstep;
      const char* a2 = last ? nA : cA + (size_t)(t + 2) * kstep; const char* b2 = last ? nB : cB + (size_t)(t + 2) * kstep;
      const char* a3 = a2 + kstep; const char* b3 = b2 + kstep;
      PG8_LDB(B0, 0, 0); PG8_SCHED; PG8_LDA(At, 0, 0); PG8_STAGE(PG8_SA(1, 1), a1 + hstepA, voffA);
      PG8_WAIT_L(8); PG8_BAR; PG8_WAIT_L(0); PG8_MMA(0, 0, At, B0); PG8_BAR; PG8_SCHED;
      PG8_LDB(B1, 0, 1); PG8_STAGE(PG8_SB(0, 0), b2, voffB);
      PG8_BAR; PG8_WAIT_L(0); PG8_MMA(0, 1, At, B1); PG8_BAR;
      PG8_LDA(At, 0, 1); PG8_STAGE(PG8_SA(0, 0), a2, voffA);
      PG8_BAR; PG8_WAIT_L(0); PG8_MMA(1, 0, At, B0); PG8_BAR; PG8_SCHED;
      PG8_STAGE(PG8_SB(0, 1), b2 + hstepB, voffB);
      PG8_WAIT_V(6); PG8_BAR; PG8_MMA(1, 1, At, B1); PG8_BAR;
      PG8_LDB(B0, 1, 0); PG8_SCHED; PG8_LDA(At, 1, 0); PG8_STAGE(PG8_SA(0, 1), a2 + hstepA, voffA);
      PG8_WAIT_L(8); PG8_BAR; PG8_WAIT_L(0); PG8_MMA(0, 0, At, B0); PG8_BAR; PG8_SCHED;
      PG8_LDB(B1, 1, 1); PG8_STAGE(PG8_SB(1, 0), b3, voffB);
      PG8_BAR; PG8_WAIT_L(0); PG8_MMA(0, 1, At, B1); PG8_BAR;
      PG8_LDA(At, 1, 1); PG8_STAGE(PG8_SA(1, 0), a3, voffA);
      PG8_BAR; PG8_WAIT_L(0); PG8_MMA(1, 0, At, B0); PG8_BAR; PG8_SCHED;
      PG8_STAGE(PG8_SB(1, 1), b3 + hstepB, voffB);
      PG8_WAIT_V(6); PG8_BAR; PG8_MMA(1, 1, At, B1); PG8_BAR;
    }
    { int st2 = step; asm volatile("" : "+s"(st2)); int wr2 = wr, wc2 = wc, fr2 = fr, fq2 = fq; asm volatile("" : "+s"(wr2), "+s"(wc2)); asm volatile("" : "+v"(fr2), "+v"(fq2));
      unsigned char* ws2 = ws; asm volatile("" : "+s"(ws2)); const Epi E = get_epi(st2, (PTab)(ws2 + O_PTAB), ws2, lds); E(acc, cur, wr2, wc2, fr2, fq2); }
    if (!has_next) break;
#pragma unroll
    for (int a = 0; a < 2; ++a)
#pragma unroll
      for (int b = 0; b < 2; ++b)
#pragma unroll
        for (int m = 0; m < 4; ++m)
#pragma unroll
          for (int n = 0; n < 2; ++n) acc[a][b][m][n] = (f32x4){0.f, 0.f, 0.f, 0.f};
    cur = nxt; cA = nA; cB = nB; ++ui;
    PG8_LANE_SETUP();
  }
  PG8_WAIT_V(0);
  if (wr == 0) PG8_BAR;
  PG8_BAR;
#undef PG8_LANE_SETUP
#undef PG8_SA
#undef PG8_SB
#undef PG8_STAGE
#undef PG8_LDA
#undef PG8_LDB
#undef PG8_MMA
#undef PG8_WAIT_V
#undef PG8_WAIT_L
#undef PG8_BAR
#undef PG8_SCHED
}


template <int DQK, int DV, bool PF>
__device__ __forceinline__ void attn_unit(const bf16_t* q, int ldq, const bf16_t* k, int ldk, const bf16_t* vt, int ldv, int nkeys, bf16_t* o, int ldo, LAS unsigned char* lds, const int tid) {
  constexpr int KS = DQK / 32, DVB = DV / 16, KROW = DQK * 2 + 16, VROW = 144, KT_B = 64 * KROW, VT_B = DV * VROW, BUF_B = KT_B + VT_B;
  constexpr int KCPR = DQK / 8, KCH = 64 * KCPR, VCH = DV * 8, KPT = (KCH + 511) / 512, VPT = (VCH + 511) / 512;
  const int wid = tid >> 6, lane = tid & 63, l15 = lane & 15, quad = lane >> 4;
  bf16x8 qf[2][KS];
#pragma unroll
  for (int qb = 0; qb < 2; ++qb)
#pragma unroll
    for (int ks = 0; ks < KS; ++ks) qf[qb][ks] = *(const GAS bf16x8*)(q + (size_t)(wid * 32 + qb * 16 + l15) * ldq + ks * 32 + quad * 8);
  f32x4 oacc[DVB][2];
#pragma unroll
  for (int d = 0; d < DVB; ++d) { oacc[d][0] = (f32x4){0.f, 0.f, 0.f, 0.f}; oacc[d][1] = (f32x4){0.f, 0.f, 0.f, 0.f}; }
  float mrun[2] = {-INFINITY, -INFINITY}, lrun[2] = {0.f, 0.f};
  u32x4 kst[KPT], vst[VPT];
#define ATT_GLOAD(tile) do { _Pragma("unroll") for (int i = 0; i < KPT; ++i) { const int ch = tid + i * 512; if (ch < KCH) { const int r = ch / KCPR, c = ch - r * KCPR; kst[i] = *(const GAS u32x4*)(k + (size_t)((tile) * 64 + r) * ldk + c * 8); } } \
    _Pragma("unroll") for (int i = 0; i < VPT; ++i) { const int ch = tid + i * 512; if (ch < VCH) { const int r = ch >> 3, c = ch & 7; vst[i] = *(const GAS u32x4*)(vt + (size_t)r * ldv + (tile) * 64 + c * 8); } } } while (0)
#define ATT_LSTORE(buf) do { _Pragma("unroll") for (int i = 0; i < KPT; ++i) { const int ch = tid + i * 512; if (ch < KCH) { const int r = ch / KCPR, c = ch - r * KCPR; *(LAS u32x4*)(lds + (buf) * BUF_B + r * KROW + c * 16) = kst[i]; } } \
    _Pragma("unroll") for (int i = 0; i < VPT; ++i) { const int ch = tid + i * 512; if (ch < VCH) { const int r = ch >> 3, c = ch & 7; *(LAS u32x4*)(lds + (buf) * BUF_B + KT_B + r * VROW + c * 16) = vst[i]; } } } while (0)
  const int ntiles = nkeys / 64;
  if (PF) { ATT_GLOAD(0); ATT_LSTORE(0); __syncthreads(); }
  for (int t = 0; t < ntiles; ++t) {
    const int buf = PF ? (t & 1) : 0;
    if (PF) { if (t + 1 < ntiles) ATT_GLOAD(t + 1); } else { ATT_GLOAD(t); ATT_LSTORE(0); __syncthreads(); }
    f32x4 sacc[4][2];
#pragma unroll
    for (int kb = 0; kb < 4; ++kb) { sacc[kb][0] = (f32x4){0.f, 0.f, 0.f, 0.f}; sacc[kb][1] = (f32x4){0.f, 0.f, 0.f, 0.f}; }
#pragma unroll
    for (int ks = 0; ks < KS; ++ks) {
      bf16x8 kf[4];
#pragma unroll
      for (int kb = 0; kb < 4; ++kb) kf[kb] = *(const LAS bf16x8*)(lds + buf * BUF_B + (kb * 16 + l15) * KROW + ks * 64 + quad * 16);
#pragma unroll
      for (int kb = 0; kb < 4; ++kb)
#pragma unroll
        for (int qb = 0; qb < 2; ++qb) sacc[kb][qb] = __builtin_amdgcn_mfma_f32_16x16x32_bf16(kf[kb], qf[qb][ks], sacc[kb][qb], 0, 0, 0);
    }
    bf16x8 pf[2][2];
#pragma unroll
    for (int qb = 0; qb < 2; ++qb) {
      float mx = sacc[0][qb][0];
#pragma unroll
      for (int kb = 0; kb < 4; ++kb)
#pragma unroll
        for (int j = 0; j < 4; ++j) mx = fmaxf(mx, sacc[kb][qb][j]);
      mx = xrow16_max(mx);
      const float mnew = fmaxf(mrun[qb], mx); const float alpha = __builtin_amdgcn_exp2f(mrun[qb] - mnew); mrun[qb] = mnew;
      float ps = 0.f;
#pragma unroll
      for (int kb = 0; kb < 4; ++kb)
#pragma unroll
        for (int j = 0; j < 4; ++j) { const float pv = __builtin_amdgcn_exp2f(sacc[kb][qb][j] - mnew); sacc[kb][qb][j] = pv; ps += pv; }
      ps = xrow16_sum(ps);
      lrun[qb] = lrun[qb] * alpha + ps;
#pragma unroll
      for (int d = 0; d < DVB; ++d) oacc[d][qb] *= alpha;
#pragma unroll
      for (int ks2 = 0; ks2 < 2; ++ks2) { u32x4 w; w.x = cvt_pk_bf16(sacc[2 * ks2][qb][0], sacc[2 * ks2][qb][1]); w.y = cvt_pk_bf16(sacc[2 * ks2][qb][2], sacc[2 * ks2][qb][3]);
        w.z = cvt_pk_bf16(sacc[2 * ks2 + 1][qb][0], sacc[2 * ks2 + 1][qb][1]); w.w = cvt_pk_bf16(sacc[2 * ks2 + 1][qb][2], sacc[2 * ks2 + 1][qb][3]); pf[qb][ks2] = __builtin_bit_cast(bf16x8, w); }
    }
#pragma unroll
    for (int ks2 = 0; ks2 < 2; ++ks2)
#pragma unroll
      for (int d = 0; d < DVB; ++d) {
        const LAS unsigned char* vp = lds + buf * BUF_B + KT_B + (d * 16 + l15) * VROW + ks2 * 64 + quad * 8;
        const u32x2 lo = *(const LAS u32x2*)vp, hi = *(const LAS u32x2*)(vp + 32);
        u32x4 w; w.x = lo.x; w.y = lo.y; w.z = hi.x; w.w = hi.y; const bf16x8 vf = __builtin_bit_cast(bf16x8, w);
#pragma unroll
        for (int qb = 0; qb < 2; ++qb) oacc[d][qb] = __builtin_amdgcn_mfma_f32_16x16x32_bf16(vf, pf[qb][ks2], oacc[d][qb], 0, 0, 0);
      }
    if (PF) { if (t + 1 < ntiles) ATT_LSTORE(buf ^ 1); }
    __syncthreads();
  }
#undef ATT_GLOAD
#undef ATT_LSTORE
#pragma unroll
  for (int qb = 0; qb < 2; ++qb) {
    const float inv = 1.0f / lrun[qb]; const int row = wid * 32 + qb * 16 + l15;
#pragma unroll
    for (int d = 0; d < DVB; ++d) { const f32x4 v = oacc[d][qb] * inv; u32x2 w; w.x = cvt_pk_bf16(v[0], v[1]); w.y = cvt_pk_bf16(v[2], v[3]); *(GAS u32x2*)(o + (size_t)row * ldo + d * 16 + quad * 4) = w; }
  }
}

template <int DQK, int DV>
__device__ __forceinline__ void attn_unit_pp(const bf16_t* q, int ldq, const bf16_t* k, int ldk, const bf16_t* vt, int ldv, int nkeys, bf16_t* o, int ldo, LAS unsigned char* lds, const int tid) {
  constexpr int KS = DQK / 32, DVB = DV / 16, KROW = DQK * 2 + 16, VROW = 144, KT_B = 64 * KROW, VT_B = DV * VROW, BUF_B = KT_B + VT_B;
  constexpr int KCPR = DQK / 8, KCH = 64 * KCPR, VCH = DV * 8, KPT = (KCH + 511) / 512, VPT = (VCH + 511) / 512;
  const int wid = tid >> 6, lane = tid & 63, l15 = lane & 15, quad = lane >> 4; const int grp = __builtin_amdgcn_readfirstlane(wid >> 2);
  bf16x8 qf[2][KS];
#pragma unroll
  for (int qb = 0; qb < 2; ++qb)
#pragma unroll
    for (int ks = 0; ks < KS; ++ks) qf[qb][ks] = *(const GAS bf16x8*)(q + (size_t)(wid * 32 + qb * 16 + l15) * ldq + ks * 32 + quad * 8);
  f32x4 oacc[DVB][2];
#pragma unroll
  for (int d = 0; d < DVB; ++d) { oacc[d][0] = (f32x4){0.f, 0.f, 0.f, 0.f}; oacc[d][1] = (f32x4){0.f, 0.f, 0.f, 0.f}; }
  float mref[2] = {0.f, 0.f};
  f32x4 lacc[2] = {(f32x4){0.f, 0.f, 0.f, 0.f}, (f32x4){0.f, 0.f, 0.f, 0.f}};
  const bf16x8 vones = (l15 == 0) ? (bf16x8){0x3F80, 0x3F80, 0x3F80, 0x3F80, 0x3F80, 0x3F80, 0x3F80, 0x3F80} : (bf16x8){0, 0, 0, 0, 0, 0, 0, 0};
  u32x4 kstA[KPT], vstA[VPT], kstB[KPT], vstB[VPT];
#define ATT_GLOAD(kst, vst, tile) do { _Pragma("unroll") for (int i = 0; i < KPT; ++i) { const int ch = tid + i * 512; if (ch < KCH) { const int r = ch / KCPR, c = ch - r * KCPR; kst[i] = *(const GAS u32x4*)(k + (size_t)((tile) * 64 + r) * ldk + c * 8); } } \
    _Pragma("unroll") for (int i = 0; i < VPT; ++i) { const int ch = tid + i * 512; if (ch < VCH) { const int r = ch >> 3, c = ch & 7; vst[i] = *(const GAS u32x4*)(vt + (size_t)r * ldv + (tile) * 64 + c * 8); } } } while (0)
#define ATT_LSTORE(kst, vst, bufoff) do { _Pragma("unroll") for (int i = 0; i < KPT; ++i) { const int ch = tid + i * 512; if (ch < KCH) { const int r = ch / KCPR, c = ch - r * KCPR; *(LAS u32x4*)(lds + (bufoff) + r * KROW + c * 16) = kst[i]; } } \
    _Pragma("unroll") for (int i = 0; i < VPT; ++i) { const int ch = tid + i * 512; if (ch < VCH) { const int r = ch >> 3, c = ch & 7; *(LAS u32x4*)(lds + (bufoff) + KT_B + r * VROW + c * 16) = vst[i]; } } } while (0)
#define ATT_PV(bufoff) do { _Pragma("unroll") for (int ks2 = 0; ks2 < 2; ++ks2) _Pragma("unroll") for (int d = 0; d < DVB; ++d) { \
      const LAS unsigned char* vp = lds + (bufoff) + KT_B + (d * 16 + l15) * VROW + ks2 * 64 + quad * 8; const u32x2 lo = *(const LAS u32x2*)vp, hi = *(const LAS u32x2*)(vp + 32); \
      u32x4 w; w.x = lo.x; w.y = lo.y; w.z = hi.x; w.w = hi.y; const bf16x8 vf = __builtin_bit_cast(bf16x8, w); \
      _Pragma("unroll") for (int qb = 0; qb < 2; ++qb) oacc[d][qb] = __builtin_amdgcn_mfma_f32_16x16x32_bf16(vf, pf[qb][ks2], oacc[d][qb], 0, 0, 0); } \
    _Pragma("unroll") for (int ks2 = 0; ks2 < 2; ++ks2) _Pragma("unroll") for (int qb = 0; qb < 2; ++qb) lacc[qb] = __builtin_amdgcn_mfma_f32_16x16x32_bf16(vones, pf[qb][ks2], lacc[qb], 0, 0, 0); } while (0)
#define ATT_BAR() do { asm volatile("s_waitcnt lgkmcnt(0)" ::: "memory"); __builtin_amdgcn_s_barrier(); asm volatile("" ::: "memory"); } while (0)
  const int ntiles = nkeys / 64;
  ATT_GLOAD(kstA, vstA, 0); ATT_LSTORE(kstA, vstA, 0); __syncthreads();
  ATT_GLOAD(kstB, vstB, 1); ATT_GLOAD(kstA, vstA, 2);
  if (grp == 1) ATT_BAR();
  bf16x8 pf[2][2];
#pragma unroll
  for (int qb = 0; qb < 2; ++qb) { pf[qb][0] = (bf16x8){0, 0, 0, 0, 0, 0, 0, 0}; pf[qb][1] = (bf16x8){0, 0, 0, 0, 0, 0, 0, 0}; }
  int bcur = 0, bprev = 2 * BUF_B, bnext = BUF_B;
  for (int t0 = 0; t0 < ntiles; t0 += 2) {
    { const int t = t0;
    f32x4 sacc[4][2];
#pragma unroll
    for (int kb = 0; kb < 4; ++kb) { sacc[kb][0] = (f32x4){-mref[0], -mref[0], -mref[0], -mref[0]}; sacc[kb][1] = (f32x4){-mref[1], -mref[1], -mref[1], -mref[1]}; }
#pragma unroll
    for (int ks = 0; ks < KS; ++ks) {
      bf16x8 kf[4];
#pragma unroll
      for (int kb = 0; kb < 4; ++kb) kf[kb] = *(const LAS bf16x8*)(lds + bcur + (kb * 16 + l15) * KROW + ks * 64 + quad * 16);
#pragma unroll
      for (int kb = 0; kb < 4; ++kb)
#pragma unroll
        for (int qb = 0; qb < 2; ++qb) sacc[kb][qb] = __builtin_amdgcn_mfma_f32_16x16x32_bf16(kf[kb], qf[qb][ks], sacc[kb][qb], 0, 0, 0);
    }
    if (t > 0) ATT_PV(bprev);
    if (t + 1 < ntiles) ATT_LSTORE(kstB, vstB, bnext);
    ATT_BAR();
    if (t + 3 < ntiles) ATT_GLOAD(kstB, vstB, t + 3);
    float mxq[2];
#pragma unroll
    for (int qb = 0; qb < 2; ++qb) {
      float mx = sacc[0][qb][0];
#pragma unroll
      for (int kb = 0; kb < 4; ++kb)
#pragma unroll
        for (int j = 0; j < 4; ++j) mx = fmaxf(mx, sacc[kb][qb][j]);
      mxq[qb] = xrow16_max(mx);
    }
    if (t == 0 || __any(fmaxf(mxq[0], mxq[1]) > 8.0f)) {
#pragma unroll
      for (int qb = 0; qb < 2; ++qb) {
        const float shift = (t == 0) ? mxq[qb] : fmaxf(mxq[qb], 0.f); const float alpha = (t == 0) ? 0.f : __builtin_amdgcn_exp2f(-shift);
        mref[qb] += shift;
#pragma unroll
        for (int kb = 0; kb < 4; ++kb)
#pragma unroll
          for (int j = 0; j < 4; ++j) sacc[kb][qb][j] -= shift;
#pragma unroll
        for (int d = 0; d < DVB; ++d) oacc[d][qb] *= alpha;
        lacc[qb] *= alpha;
      }
    }
#pragma unroll
    for (int qb = 0; qb < 2; ++qb) {
#pragma unroll
      for (int kb = 0; kb < 4; ++kb)
#pragma unroll
        for (int j = 0; j < 4; ++j) sacc[kb][qb][j] = __builtin_amdgcn_exp2f(sacc[kb][qb][j]);
#pragma unroll
      for (int ks2 = 0; ks2 < 2; ++ks2) { u32x4 w; w.x = cvt_pk_bf16(sacc[2 * ks2][qb][0], sacc[2 * ks2][qb][1]); w.y = cvt_pk_bf16(sacc[2 * ks2][qb][2], sacc[2 * ks2][qb][3]);
        w.z = cvt_pk_bf16(sacc[2 * ks2 + 1][qb][0], sacc[2 * ks2 + 1][qb][1]); w.w = cvt_pk_bf16(sacc[2 * ks2 + 1][qb][2], sacc[2 * ks2 + 1][qb][3]); pf[qb][ks2] = __builtin_bit_cast(bf16x8, w); }
    }
    ATT_BAR();
    { const int tmp = bprev; bprev = bcur; bcur = bnext; bnext = tmp; }
    }
    { const int t = t0 + 1;
    f32x4 sacc[4][2];
#pragma unroll
    for (int kb = 0; kb < 4; ++kb) { sacc[kb][0] = (f32x4){-mref[0], -mref[0], -mref[0], -mref[0]}; sacc[kb][1] = (f32x4){-mref[1], -mref[1], -mref[1], -mref[1]}; }
#pragma unroll
    for (int ks = 0; ks < KS; ++ks) {
      bf16x8 kf[4];
#pragma unroll
      for (int kb = 0; kb < 4; ++kb) kf[kb] = *(const LAS bf16x8*)(lds + bcur + (kb * 16 + l15) * KROW + ks * 64 + quad * 16);
#pragma unroll
      for (int kb = 0; kb < 4; ++kb)
#pragma unroll
        for (int qb = 0; qb < 2; ++qb) sacc[kb][qb] = __builtin_amdgcn_mfma_f32_16x16x32_bf16(kf[kb], qf[qb][ks], sacc[kb][qb], 0, 0, 0);
    }
    if (t > 0) ATT_PV(bprev);
    if (t + 1 < ntiles) ATT_LSTORE(kstA, vstA, bnext);
    ATT_BAR();
    if (t + 3 < ntiles) ATT_GLOAD(kstA, vstA, t + 3);
    float mxq[2];
#pragma unroll
    for (int qb = 0; qb < 2; ++qb) {
      float mx = sacc[0][qb][0];
#pragma unroll
      for (int kb = 0; kb < 4; ++kb)
#pragma unroll
        for (int j = 0; j < 4; ++j) mx = fmaxf(mx, sacc[kb][qb][j]);
      mxq[qb] = xrow16_max(mx);
    }
    if (t == 0 || __any(fmaxf(mxq[0], mxq[1]) > 8.0f)) {
#pragma unroll
      for (int qb = 0; qb < 2; ++qb) {
        const float shift = (t == 0) ? mxq[qb] : fmaxf(mxq[qb], 0.f); const float alpha = (t == 0) ? 0.f : __builtin_amdgcn_exp2f(-shift);
        mref[qb] += shift;
#pragma unroll
        for (int kb = 0; kb < 4; ++kb)
#pragma unroll
          for (int j = 0; j < 4; ++j) sacc[kb][qb][j] -= shift;
#pragma unroll
        for (int d = 0; d < DVB; ++d) oacc[d][qb] *= alpha;
        lacc[qb] *= alpha;
      }
    }
#pragma unroll
    for (int qb = 0; qb < 2; ++qb) {
#pragma unroll
      for (int kb = 0; kb < 4; ++kb)
#pragma unroll
        for (int j = 0; j < 4; ++j) sacc[kb][qb][j] = __builtin_amdgcn_exp2f(sacc[kb][qb][j]);
#pragma unroll
      for (int ks2 = 0; ks2 < 2; ++ks2) { u32x4 w; w.x = cvt_pk_bf16(sacc[2 * ks2][qb][0], sacc[2 * ks2][qb][1]); w.y = cvt_pk_bf16(sacc[2 * ks2][qb][2], sacc[2 * ks2][qb][3]);
        w.z = cvt_pk_bf16(sacc[2 * ks2 + 1][qb][0], sacc[2 * ks2 + 1][qb][1]); w.w = cvt_pk_bf16(sacc[2 * ks2 + 1][qb][2], sacc[2 * ks2 + 1][qb][3]); pf[qb][ks2] = __builtin_bit_cast(bf16x8, w); }
    }
    ATT_BAR();
    { const int tmp = bprev; bprev = bcur; bcur = bnext; bnext = tmp; }
    }
  }
  ATT_PV(bprev);
  if (grp == 0) ATT_BAR();
  __syncthreads();
#undef ATT_GLOAD
#undef ATT_LSTORE
#undef ATT_PV
#undef ATT_BAR
#pragma unroll
  for (int qb = 0; qb < 2; ++qb) {
    const float inv = 1.0f / __builtin_bit_cast(float, __builtin_amdgcn_ds_bpermute(l15 * 4, __builtin_bit_cast(int, lacc[qb][0]))); const int row = wid * 32 + qb * 16 + l15;
#pragma unroll
    for (int d = 0; d < DVB; ++d) { const f32x4 v = oacc[d][qb] * inv; u32x2 w; w.x = cvt_pk_bf16(v[0], v[1]); w.y = cvt_pk_bf16(v[2], v[3]); *(GAS u32x2*)(o + (size_t)row * ldo + d * 16 + quad * 4) = w; }
  }
}

struct WDesc { const float* src; bf16_t* dst; const float* ks; int K, N, ld, mode; };
__device__ __forceinline__ int w_cmap(int mode, int n) {
  switch (mode) {
    case 1: { const int pn = n >> 8, i = n & 255; return i < 128 ? pn * 128 + i : DFF + pn * 128 + (i - 128); }
    case 2: return n < 672 ? n : -1;
    case 3: return n < 1856 ? 672 + n : -1;
    case 4: return 2528 + n;
    case 5: { const int h = n / 96, pp = n - h * 96; if (pp < 64) return n; const int p = pp - 64; return h * 96 + 64 + (p & 3) + 4 * (p >> 3) + 16 * ((p >> 2) & 1); }
    default: return n;
  }
}
__device__ __forceinline__ void prep_tile(const WDesc& d, int tk, int tn, const Params& p, LAS float* tl) {
  const int tid = threadIdx.x; const int k0 = tk * 64, n0 = tn * 64;
  {
    const int nn = tid & 63, kq = tid >> 6; const int n = n0 + nn;
#pragma unroll
    for (int i = 0; i < 8; ++i) {
      const int k = k0 + kq * 8 + i; float v = 0.f;
      if (d.mode == 7) {
        const int blk = n >> 9, nl = n & 511;
        if (blk == 0) { if (k < 64) v = p.w_up[(size_t)k * 512 + nl]; }
        else if (blk == 1) { if (k >= 64 && k < 128) v = p.w_up[(size_t)(64 + (k - 64)) * 512 + nl]; }
        else if (blk == 2) { if (k >= 128 && k < 192) v = p.a_up[(size_t)(k - 128) * 512 + nl]; }
        else { if (k >= 192 && k < 320) v = p.g_up[(size_t)(k - 192) * 512 + nl]; }
      } else {
        const int c = w_cmap(d.mode, n);
        if (c >= 0) { v = d.src[(size_t)k * d.ld + c]; if (d.ks) v *= d.ks[k]; }
      }
      tl[(kq * 8 + i) * 65 + nn] = v;
    }
  }
  __syncthreads();
  {
    const int n = tid >> 3, kc = (tid & 7) * 8; float f[8];
#pragma unroll
    for (int i = 0; i < 8; ++i) f[i] = tl[(kc + i) * 65 + n];
    *(u32x4*)(d.dst + (size_t)(n0 + n) * d.K + k0 + kc) = pack8(f);
  }
  __syncthreads();
}

__device__ __forceinline__ void ln_phase(float* trunk, const float* g, const float* b, bf16_t* xb, bool write_f32, const int tid) {
  const int lane = tid & 63, wid = tid >> 6;
  f32x4 gv[4], bv[4];
#pragma unroll
  for (int i = 0; i < 4; ++i) { gv[i] = *(const f32x4*)(g + i * 256 + lane * 4); bv[i] = *(const f32x4*)(b + i * 256 + lane * 4); }
  for (int row = blockIdx.x * 8 + wid; row < T; row += gridDim.x * 8) {
    float* rp = trunk + (size_t)row * DM; f32x4 v[4]; float s = 0.f;
#pragma unroll
    for (int i = 0; i < 4; ++i) { v[i] = *(const f32x4*)(rp + i * 256 + lane * 4); s += (v[i][0] + v[i][1]) + (v[i][2] + v[i][3]); }
    const float mean = wave_sum(s) * (1.0f / 1024.0f); float q = 0.f;
#pragma unroll
    for (int i = 0; i < 4; ++i) { v[i] -= mean; q += (v[i][0] * v[i][0] + v[i][1] * v[i][1]) + (v[i][2] * v[i][2] + v[i][3] * v[i][3]); }
    const float rstd = 1.0f / sqrtf(wave_sum(q) * (1.0f / 1024.0f) + 1e-5f);
#pragma unroll
    for (int i = 0; i < 4; ++i) { const f32x4 o = v[i] * rstd * gv[i] + bv[i];
      if (write_f32) *(f32x4*)(rp + i * 256 + lane * 4) = o;
      if (xb) { u32x2 w; w.x = cvt_pk_bf16(o[0], o[1]); w.y = cvt_pk_bf16(o[2], o[3]); *(u32x2*)(xb + (size_t)row * DM + i * 256 + lane * 4) = w; } }
  }
}

__device__ __forceinline__ void fast_barrier(unsigned* bar, unsigned target, int tid) {
  asm volatile("s_waitcnt vmcnt(0)" ::: "memory");
  __syncthreads();
  if (tid == 0) {
    __builtin_amdgcn_fence(__ATOMIC_RELEASE, "agent");
    asm volatile("s_waitcnt vmcnt(0)" ::: "memory");
    __hip_atomic_fetch_add(bar, 1u, __ATOMIC_RELAXED, __HIP_MEMORY_SCOPE_AGENT);
    while (__hip_atomic_load(bar, __ATOMIC_RELAXED, __HIP_MEMORY_SCOPE_AGENT) < target) __builtin_amdgcn_s_sleep(1);
    __builtin_amdgcn_fence(__ATOMIC_ACQUIRE, "agent");
    asm volatile("s_waitcnt vmcnt(0)" ::: "memory");
  }
  __syncthreads();
}

__global__ void __launch_bounds__(512, 2) fwd_mega(Params p) {
  extern __shared__ __attribute__((aligned(16))) unsigned char smem[];
  LAS unsigned char* lds = (LAS unsigned char*)smem;
  cg::grid_group grid = cg::this_grid();
  if (blockIdx.x == 0 && threadIdx.x == 64) __hip_atomic_store((unsigned*)(p.ws + O_PTAB + 512), 0u, __ATOMIC_RELAXED, __HIP_MEMORY_SCOPE_AGENT);
  for (int i = blockIdx.x * 512 + threadIdx.x; i < 4 * 320 * 64; i += gridDim.x * 512) ((unsigned*)(p.ws + O_CNT))[i] = 0u;
  const int wave_s = __builtin_amdgcn_readfirstlane((int)(threadIdx.x >> 6));
  unsigned nbar = 0;
  if (blockIdx.x == 0 && threadIdx.x < 43) {
    const float* v = (const float*)p.out;
    switch (threadIdx.x) {
      case 0: v = p.x_p; break;
      case 1: v = p.x_s; break;
      case 2: v = p.mem_p; break;
      case 3: v = p.mem_s; break;
      case 4: v = p.ln1_g; break;
      case 5: v = p.ln1_b; break;
      case 6: v = p.ffn1_wgu; break;
      case 7: v = p.ffn1_wd; break;
      case 8: v = p.w_in; break;
      case 9: v = p.b_gate; break;
      case 10: v = p.q_norm_g; break;
      case 11: v = p.w_uq; break;
      case 12: v = p.kv_norm_g; break;
      case 13: v = p.w_ukv; break;
      case 14: v = p.p_mla; break;
      case 15: v = p.mu_prev; break;
      case 16: v = p.mu_next; break;
      case 17: v = p.w0; break;
      case 18: v = p.w_up; break;
      case 19: v = p.a0; break;
      case 20: v = p.a_up; break;
      case 21: v = p.g_up; break;
      case 22: v = p.k_k; break;
      case 23: v = p.k_a; break;
      case 24: v = p.r_k; break;
      case 25: v = p.lnx_g; break;
      case 26: v = p.lnx_b; break;
      case 27: v = p.p_rwkv; break;
      case 28: v = p.w_o; break;
      case 29: v = p.ln2_g; break;
      case 30: v = p.ln2_b; break;
      case 31: v = p.mem_g; break;
      case 32: v = p.mem_b; break;
      case 33: v = p.w_cq; break;
      case 34: v = p.w_ckv; break;
      case 35: v = p.w_co; break;
      case 36: v = p.ln3_g; break;
      case 37: v = p.ln3_b; break;
      case 38: v = p.ffn2_wgu; break;
      case 39: v = p.ffn2_wd; break;
      case 40: v = p.ln4_g; break;
      case 41: v = p.ln4_b; break;
      default: break;
    }
    ((const float**)(p.ws + O_PTAB))[threadIdx.x] = v;
  }
  if (EN & 4) {
    unsigned char* ws = p.ws; const int tid = threadIdx.x, lane = tid & 63, wid = tid >> 6; const int gwave = blockIdx.x * 8 + wid, nwave = gridDim.x * 8;
    bf16_t* xb = (bf16_t*)(ws + O_XB); float* rope = (float*)(ws + O_ROPE);
  {
    int base = 0;
#define PREP_W(SRC, OFF, KS, KK, NN, LD, MODE) do { const WDesc d{SRC, (bf16_t*)(ws + OFF), KS, KK, NN, LD, MODE}; const int ntk = (KK) / 64, ntile = ntk * ((NN) / 64); \
      int first = ((int)blockIdx.x - base) % (int)gridDim.x; if (first < 0) first += gridDim.x; \
      for (int t = first; t < ntile; t += gridDim.x) prep_tile(d, t % ntk, t / ntk, p, (LAS float*)lds); \
      base = (base + ntile) % (int)gridDim.x; } while (0)
    PREP_W(p.ffn1_wgu, O_WGU1, nullptr, 1024, 5632, 5632, 1);
    PREP_W(p.ffn1_wd, O_WD1, nullptr, 2816, 1024, 1024, 0);
    PREP_W(p.ffn2_wgu, O_WGU2, nullptr, 1024, 5632, 5632, 1);
    PREP_W(p.ffn2_wd, O_WD2, nullptr, 2816, 1024, 1024, 0);
    PREP_W(p.w_in, O_WINQ, nullptr, 1024, 768, 4576, 2);
    PREP_W(p.w_in, O_WINR, nullptr, 1024, 2048, 4576, 3);
    PREP_W(p.w_in, O_WING, nullptr, 1024, 2048, 4576, 4);
    PREP_W(p.w_uq, O_WUQ, p.q_norm_g, 384, 768, 768, 5);
    PREP_W(p.w_ukv, O_WUKV, p.kv_norm_g, 256, 1024, 1024, 0);
    PREP_W(p.p_mla, O_PMLA, nullptr, 512, 1024, 1024, 0);
    PREP_W(p.p_rwkv, O_PRWKV, nullptr, 512, 1024, 1024, 0);
    PREP_W(p.w_o, O_WO, nullptr, 1024, 1024, 1024, 0);
    PREP_W(nullptr, O_WLORA, nullptr, 384, 2048, 0, 7);
    PREP_W(p.w_cq, O_WCQ, nullptr, 1024, 512, 512, 0);
    PREP_W(p.w_ckv, O_WCKV, nullptr, 1024, 1024, 1024, 0);
    PREP_W(p.w_co, O_WCO, nullptr, 512, 1024, 1024, 0);
#undef PREP_W
    for (size_t i = (size_t)blockIdx.x * 512 + tid; i < (size_t)T * DM / 8; i += (size_t)gridDim.x * 512) {
      const size_t e = i * 8; const float* src = (e < 65536ull * DM) ? p.x_p + e : p.x_s + (e - 65536ull * DM);
      const f32x4 a = *(const f32x4*)src, b = *(const f32x4*)(src + 4); const float f[8] = {a[0], a[1], a[2], a[3], b[0], b[1], b[2], b[3]};
      *(u32x4*)(xb + e) = pack8(f);
    }
    {
      bf16_t* memln = (bf16_t*)(ws + O_MEMLN);
      for (int row = gwave; row < 5120; row += nwave) {
        const float* rp = (row < 4096) ? p.mem_p + (size_t)row * DM : p.mem_s + (size_t)(row - 4096) * DM; f32x4 v[4]; float s = 0.f;
#pragma unroll
        for (int i = 0; i < 4; ++i) { v[i] = *(const f32x4*)(rp + i * 256 + lane * 4); s += (v[i][0] + v[i][1]) + (v[i][2] + v[i][3]); }
        const float mean = wave_sum(s) * (1.0f / 1024.0f); float q = 0.f;
#pragma unroll
        for (int i = 0; i < 4; ++i) { v[i] -= mean; q += (v[i][0] * v[i][0] + v[i][1] * v[i][1]) + (v[i][2] * v[i][2] + v[i][3] * v[i][3]); }
        const float rs = 1.0f / sqrtf(wave_sum(q) * (1.0f / 1024.0f) + 1e-5f);
#pragma unroll
        for (int i = 0; i < 4; ++i) { const f32x4 o = v[i] * rs * *(const f32x4*)(p.mem_g + i * 256 + lane * 4) + *(const f32x4*)(p.mem_b + i * 256 + lane * 4);
          u32x2 w; w.x = cvt_pk_bf16(o[0], o[1]); w.y = cvt_pk_bf16(o[2], o[3]); *(u32x2*)(memln + (size_t)row * DM + i * 256 + lane * 4) = w; }
      }
    }
    for (int i = blockIdx.x * 512 + tid; i < 4096 * 16; i += gridDim.x * 512) {
      const int s = i >> 4, j = i & 15; const float inv = 1.0f / powf(10000.0f, (float)(2 * j) / 32.0f); const float ang = (float)s * inv;
      rope[s * 32 + j] = cosf(ang); rope[s * 32 + 16 + j] = sinf(ang);
    }
  }
  }
  grid.sync();
#pragma nounroll
  for (int step = 1; step < 26; ++step) {
    unsigned char* ws = p.ws; asm volatile("" : "+s"(ws));
    unsigned zero_l = 0u; asm volatile("" : "+s"(zero_l));
    int tid = wave_s * 64 + (int)__builtin_amdgcn_mbcnt_hi(~0u, __builtin_amdgcn_mbcnt_lo(~0u, zero_l)); asm volatile("" : "+v"(tid));
    const int lane = tid & 63, wid = tid >> 6;
    const int gwave = blockIdx.x * 8 + wid, nwave = gridDim.x * 8;
    bf16_t* xb = (bf16_t*)(ws + O_XB);
    float* rope = (float*)(ws + O_ROPE);
    float* rstd = (float*)(ws + O_RSTD);
    PTab ptab = (PTab)(ws + O_PTAB);
    int kind = 0; bool sync = true; const float* lng = nullptr; const float* lnb = nullptr; bf16_t* lnxb = xb;
    switch (step) {
      case 1: kind = 1; sync = false; break;
      case 2: kind = 1; break;
      case 3: kind = 1; break;
      case 4: kind = 0; sync = false; break;
      case 5: kind = 1; sync = false; break;
      case 6: kind = 1; break;
      case 7: kind = 4; break;
      case 8: kind = 1; break;
      case 9: kind = 5; break;
      case 10: kind = 6; break;
      case 11: kind = 1; sync = false; break;
      case 12: kind = 1; sync = false; break;
      case 13: kind = 1; break;
      case 14: kind = 7; break;
      case 15: kind = 1; sync = false; break;
      case 16: kind = 1; break;
      case 17: kind = 1; break;
      case 18: kind = 0; sync = false; break;
      case 19: kind = 1; break;
      case 20: kind = 8; break;
      case 21: kind = 1; break;
      case 22: kind = 0; sync = false; break;
      case 23: kind = 1; break;
      case 24: kind = 1; break;
      default: kind = 0; sync = false; break;
    }
    if (step == 11 && (EN & 8)) {
      const bf16_t* __restrict__ hqkv = (const bf16_t*)(ws + O_HQKV); bf16_t* __restrict__ Kb = (bf16_t*)(ws + O_K);
      for (int it = blockIdx.x * 512 + tid; it < T * 4; it += gridDim.x * 512) {
        const int t = it >> 2, q = it & 3, s = t & 4095, b = t >> 12;
        const u32x2 w1 = *(const GAS u32x2*)(hqkv + (size_t)t * 768 + 640 + 4 * q), w2 = *(const GAS u32x2*)(hqkv + (size_t)t * 768 + 656 + 4 * q);
        const f32x4 c = *(const GAS f32x4*)(rope + s * 32 + 4 * q), sn = *(const GAS f32x4*)(rope + s * 32 + 16 + 4 * q);
        const f32x4 x1 = (f32x4){__uint_as_float(w1.x << 16), __uint_as_float(w1.x & 0xffff0000u), __uint_as_float(w1.y << 16), __uint_as_float(w1.y & 0xffff0000u)};
        const f32x4 x2 = (f32x4){__uint_as_float(w2.x << 16), __uint_as_float(w2.x & 0xffff0000u), __uint_as_float(w2.y << 16), __uint_as_float(w2.y & 0xffff0000u)};
        const f32x4 o1 = x1 * c - x2 * sn, o2 = x1 * sn + x2 * c;
        u32x4 w; w.x = cvt_pk_bf16(o1[0], o1[1]); w.y = cvt_pk_bf16(o1[2], o1[3]); w.z = cvt_pk_bf16(o2[0], o2[1]); w.w = cvt_pk_bf16(o2[2], o2[3]);
#pragma unroll
        for (int h = 0; h < 8; ++h) *(GAS u32x4*)(Kb + ((size_t)(b * 8 + h) * SEQ + s) * 96 + 64 + 8 * q) = w;
      }
    }
    if (kind == 1) { if (EN & 1) gemm_phase(lds, step, ptab, ws, tid); }
    else if (kind == 2) { if (EN & 2) ln_phase(((float*)PT(out)), lng, lnb, lnxb, true, tid); }
    else if (kind == 4 && (EN & 8)) {
  {
    const bf16_t* __restrict__ hr = (const bf16_t*)(ws + O_HR); const bf16_t* __restrict__ hqkv = (const bf16_t*)(ws + O_HQKV); bf16_t* __restrict__ lin = (bf16_t*)(ws + O_LIN);
    const float* __restrict__ mup = PT(mu_prev) + 1536; const float* __restrict__ mun = PT(mu_next) + 1536;
#pragma unroll 2
    for (int it = blockIdx.x * 512 + tid; it < T * 48; it += gridDim.x * 512) {
      const int t = it / 48, g = it - t * 48; u32x4 ow = (u32x4){0u, 0u, 0u, 0u};
      if (g < 40) {
        const int s = t & 4095; const bf16_t* hp = hr + (size_t)t * 1856 + 1536 + g * 8;
        float c[8], pv[8], nv[8], o[8]; unpack8(*(const u32x4*)hp, c);
        unpack8((s > 0) ? *(const GAS u32x4*)(hp - 1856) : (u32x4){0u, 0u, 0u, 0u}, pv); unpack8((s < 4095) ? *(const GAS u32x4*)(hp + 1856) : (u32x4){0u, 0u, 0u, 0u}, nv);
        const f32x4 mp0 = *(const GAS f32x4*)(mup + g * 8), mp1 = *(const GAS f32x4*)(mup + g * 8 + 4), mn0 = *(const GAS f32x4*)(mun + g * 8), mn1 = *(const GAS f32x4*)(mun + g * 8 + 4);
#pragma unroll
        for (int i = 0; i < 8; ++i) { const float m1 = i < 4 ? mp0[i & 3] : mp1[i & 3], m2 = i < 4 ? mn0[i & 3] : mn1[i & 3]; float v = c[i] + m1 * (pv[i] - c[i]) + m2 * (nv[i] - c[i]);
          if (g < 16) v = 1.0f - 2.0f / (1.0f + __expf(2.0f * v)); else if (g >= 24) v = sigmoidf_(v);
          o[i] = v; }
        ow = pack8(o);
      }
      *(GAS u32x4*)(lin + (size_t)t * 384 + g * 8) = ow;
    }
    for (int t4 = gwave; t4 < T / 4; t4 += nwave) {
      const int t = t4 * 4 + (lane >> 4), l16 = lane & 15; float sq = 0.f, skv = 0.f;
#pragma unroll
      for (int j = 0; j < 5; ++j) { const int k = j * 16 + l16; float f[8]; unpack8(*(const GAS u32x4*)(hqkv + (size_t)t * 768 + k * 8), f); float ss = 0.f;
#pragma unroll
        for (int i = 0; i < 8; ++i) ss += f[i] * f[i];
        if (k < 48) sq += ss; else skv += ss; }
      sq = row16_sum(sq); skv = row16_sum(skv);
      if (l16 == 0) { rstd[(size_t)t * 2] = 1.0f / sqrtf(sq * (1.0f / 384.0f) + 1e-6f); rstd[(size_t)t * 2 + 1] = 1.0f / sqrtf(skv * (1.0f / 256.0f) + 1e-6f); }
    }
  }
    } else if (kind == 5 && (EN & 16)) {
  {
    const bf16_t* hr = (const bf16_t*)(ws + O_HR); const bf16_t* lo = (const bf16_t*)(ws + O_LOUT); bf16_t* yb = (bf16_t*)(ws + O_Y);
    const int dir = tid >> 8, td = tid & 255;
    LAS float* Wl = (LAS float*)(lds + dir * 57344); LAS float* Al = Wl + 2048; LAS float* Bl = Wl + 4096; LAS float* Kl = Wl + 6144; LAS float* Rl = Wl + 8192; LAS float* Vl = Wl + 10240; LAS float* Yl = Wl + 12288;
    const int ptt = td >> 3, pc8 = td & 7;
    const int rq = td >> 3, cgp = td & 7;
    LAS float* Cst = (LAS float*)(lds + 2 * 57344 + 12288);
    LAS float* ybase = (cgp == 0) ? (Yl + 2 * rq) : ((LAS float*)(lds + 2 * 57344) + 2 * tid);
    for (int unit = blockIdx.x; unit < NBATCH * 8; unit += gridDim.x) {
      const int b = unit >> 3, h = unit & 7;
      {
        const int arr = tid >> 6, c = tid & 63;
        const float* src = arr < 3 ? PT(mu_prev) + arr * 512 + h * 64 + c : arr < 6 ? PT(mu_next) + (arr - 3) * 512 + h * 64 + c : arr == 6 ? PT(k_k) + h * 64 + c : PT(k_a) + h * 64 + c;
        Cst[arr * 64 + c] = *src;
      }
      __syncthreads();
      const bf16_t* hrb = hr + (size_t)b * SEQ * 1856 + h * 64 + pc8 * 8; const bf16_t* lob = lo + (size_t)b * SEQ * 2048 + h * 64 + pc8 * 8;
      f32x2 S[2][4];
#pragma unroll
      for (int r = 0; r < 2; ++r)
#pragma unroll
        for (int j = 0; j < 4; ++j) S[r][j] = (f32x2){0.f, 0.f};
      u32x4 ld_c[3], ld_p[3], ld_n[3], ld_w, ld_a;
#define SCAN_LOAD(nch) do { const int t0_ = dir ? SEQ - 32 * ((nch) + 1) : 32 * (nch); const int t_ = t0_ + ptt; const bf16_t* rp_ = hrb + (size_t)t_ * 1856; \
        _Pragma("unroll") for (int a_ = 0; a_ < 3; ++a_) { ld_c[a_] = *(const GAS u32x4*)(rp_ + a_ * 512); ld_p[a_] = (t_ > 0) ? *(const GAS u32x4*)(rp_ + a_ * 512 - 1856) : (u32x4){0u, 0u, 0u, 0u}; ld_n[a_] = (t_ < SEQ - 1) ? *(const GAS u32x4*)(rp_ + a_ * 512 + 1856) : (u32x4){0u, 0u, 0u, 0u}; } \
        ld_w = *(const GAS u32x4*)(lob + (size_t)t_ * 2048 + dir * 512); ld_a = *(const GAS u32x4*)(lob + (size_t)t_ * 2048 + 1024); } while (0)
      SCAN_LOAD(0);
      for (int nch = 0; nch < SEQ / 32; ++nch) {
        {
          float sh[3][8];
#pragma unroll
          for (int a = 0; a < 3; ++a) {
            float c[8], pv[8], nv[8]; unpack8(ld_c[a], c); unpack8(ld_p[a], pv); unpack8(ld_n[a], nv);
            const LAS float* mpp = Cst + a * 64 + pc8 * 8; const LAS float* mnp = Cst + (3 + a) * 64 + pc8 * 8;
#pragma unroll
            for (int i = 0; i < 8; ++i) sh[a][i] = c[i] + mpp[i] * (pv[i] - c[i]) + mnp[i] * (nv[i] - c[i]);
          }
          float lw[8], av[8]; unpack8(ld_w, lw); unpack8(ld_a, av);
          float kk[8], ss = 0.f;
#pragma unroll
          for (int i = 0; i < 8; ++i) { kk[i] = sh[1][i] * Cst[6 * 64 + pc8 * 8 + i]; ss += kk[i] * kk[i]; }
          ss = oct_sum(ss);
          const float inrm = 1.0f / fmaxf(sqrtf(ss), 1e-12f);
          float ow[8], oa[8], ob[8], ok[8];
#pragma unroll
          for (int i = 0; i < 8; ++i) { const float kn = kk[i] * inrm; ow[i] = __builtin_amdgcn_exp2f(lw[i]); oa[i] = -kn; ob[i] = kn * av[i]; ok[i] = sh[1][i] * (1.0f + (av[i] - 1.0f) * Cst[7 * 64 + pc8 * 8 + i]); }
          const int o = (dir ? 31 - ptt : ptt) * 64 + pc8 * 8;
          *(LAS f32x4*)(Wl + o) = (f32x4){ow[0], ow[1], ow[2], ow[3]}; *(LAS f32x4*)(Wl + o + 4) = (f32x4){ow[4], ow[5], ow[6], ow[7]};
          *(LAS f32x4*)(Al + o) = (f32x4){oa[0], oa[1], oa[2], oa[3]}; *(LAS f32x4*)(Al + o + 4) = (f32x4){oa[4], oa[5], oa[6], oa[7]};
          *(LAS f32x4*)(Bl + o) = (f32x4){ob[0], ob[1], ob[2], ob[3]}; *(LAS f32x4*)(Bl + o + 4) = (f32x4){ob[4], ob[5], ob[6], ob[7]};
          *(LAS f32x4*)(Kl + o) = (f32x4){ok[0], ok[1], ok[2], ok[3]}; *(LAS f32x4*)(Kl + o + 4) = (f32x4){ok[4], ok[5], ok[6], ok[7]};
          *(LAS f32x4*)(Rl + o) = (f32x4){sh[0][0], sh[0][1], sh[0][2], sh[0][3]}; *(LAS f32x4*)(Rl + o + 4) = (f32x4){sh[0][4], sh[0][5], sh[0][6], sh[0][7]};
          *(LAS f32x4*)(Vl + o) = (f32x4){sh[2][0], sh[2][1], sh[2][2], sh[2][3]}; *(LAS f32x4*)(Vl + o + 4) = (f32x4){sh[2][4], sh[2][5], sh[2][6], sh[2][7]};
        }
        __syncthreads();
        if (nch + 1 < SEQ / 32) SCAN_LOAD(nch + 1);
        {
          f32x4 opA[11], opB[11];
#define SC_LOAD(dst, st_) do { const int tt_ = (st_); const int o_ = tt_ * 64 + cgp * 8; \
            dst[0] = *(const LAS f32x4*)(Wl + o_); dst[1] = *(const LAS f32x4*)(Wl + o_ + 4); dst[2] = *(const LAS f32x4*)(Al + o_); dst[3] = *(const LAS f32x4*)(Al + o_ + 4); \
            dst[4] = *(const LAS f32x4*)(Bl + o_); dst[5] = *(const LAS f32x4*)(Bl + o_ + 4); dst[6] = *(const LAS f32x4*)(Kl + o_); dst[7] = *(const LAS f32x4*)(Kl + o_ + 4); \
            dst[8] = *(const LAS f32x4*)(Rl + o_); dst[9] = *(const LAS f32x4*)(Rl + o_ + 4); { const f32x2 v2_ = *(const LAS f32x2*)(Vl + tt_ * 64 + 2 * rq); dst[10] = (f32x4){v2_.x, v2_.y, 0.f, 0.f}; } } while (0)
#define SC_STEP(op, st_) do { const int tt_ = (st_); \
            f32x2 wv[4], av[4], bv[4], kv[4], rv[4]; \
            _Pragma("unroll") for (int i = 0; i < 2; ++i) { wv[2 * i] = (f32x2){op[i][0], op[i][1]}; wv[2 * i + 1] = (f32x2){op[i][2], op[i][3]}; av[2 * i] = (f32x2){op[2 + i][0], op[2 + i][1]}; av[2 * i + 1] = (f32x2){op[2 + i][2], op[2 + i][3]}; \
              bv[2 * i] = (f32x2){op[4 + i][0], op[4 + i][1]}; bv[2 * i + 1] = (f32x2){op[4 + i][2], op[4 + i][3]}; kv[2 * i] = (f32x2){op[6 + i][0], op[6 + i][1]}; kv[2 * i + 1] = (f32x2){op[6 + i][2], op[6 + i][3]}; \
              rv[2 * i] = (f32x2){op[8 + i][0], op[8 + i][1]}; rv[2 * i + 1] = (f32x2){op[8 + i][2], op[8 + i][3]}; } \
            float yo[2]; \
            _Pragma("unroll") for (int r = 0; r < 2; ++r) { \
              f32x2 c = S[r][0] * av[0]; c += S[r][1] * av[1]; c += S[r][2] * av[2]; c += S[r][3] * av[3]; \
              float sa = c.x + c.y; sa += dpp_f<0xB1>(sa); sa += dpp_f<0x4E>(sa); sa += dpp_f<0x141>(sa); \
              const f32x2 sav = (f32x2){sa, sa}, vv = (f32x2){op[10][r], op[10][r]}; \
              f32x2 y = (f32x2){0.f, 0.f}; \
              _Pragma("unroll") for (int j = 0; j < 4; ++j) { const f32x2 n = S[r][j] * wv[j] + (bv[j] * sav + kv[j] * vv); S[r][j] = n; y += n * rv[j]; } \
              float ys = y.x + y.y; ys += dpp_f<0xB1>(ys); ys += dpp_f<0x4E>(ys); ys += dpp_f<0x141>(ys); yo[r] = ys; } \
            *(LAS f32x2*)(ybase + tt_ * 64) = (f32x2){yo[0], yo[1]}; } while (0)
          SC_LOAD(opA, 0);
#pragma unroll 1
          for (int st = 0; st < 32; st += 8) {
#pragma unroll
            for (int u = 0; u < 8; u += 2) {
              asm volatile("" :: "v"(opA[10][0])); __builtin_amdgcn_sched_barrier(0);
              SC_LOAD(opB, st + u + 1); __builtin_amdgcn_sched_barrier(0);
              SC_STEP(opA, st + u); __builtin_amdgcn_sched_barrier(0);
              asm volatile("" :: "v"(opB[10][0])); __builtin_amdgcn_sched_barrier(0);
              SC_LOAD(opA, (st + u + 2) & 31); __builtin_amdgcn_sched_barrier(0);
              SC_STEP(opB, st + u + 1); __builtin_amdgcn_sched_barrier(0);
            }
          }
#undef SC_LOAD
#undef SC_STEP
        }
        __syncthreads();
        {
          const int t0 = dir ? SEQ - 32 * (nch + 1) : 32 * nch; const int ys = (dir ? 31 - ptt : ptt) * 64 + pc8 * 8; const f32x4 y0 = *(const LAS f32x4*)(Yl + ys), y1 = *(const LAS f32x4*)(Yl + ys + 4);
          const float f[8] = {y0[0], y0[1], y0[2], y0[3], y1[0], y1[1], y1[2], y1[3]};
          *(GAS u32x4*)(yb + ((size_t)dir * T + (size_t)b * SEQ + t0 + ptt) * 512 + h * 64 + pc8 * 8) = pack8(f);
        }
      }
#undef SCAN_LOAD
      __syncthreads();
    }
  }
    } else if (kind == 6 && (EN & 32)) {
  {
    const bf16_t* __restrict__ hr = (const bf16_t*)(ws + O_HR); const bf16_t* __restrict__ lo = (const bf16_t*)(ws + O_LOUT); const bf16_t* __restrict__ yb = (const bf16_t*)(ws + O_Y); bf16_t* __restrict__ bout = (bf16_t*)(ws + O_BOUT);
    const int c0 = lane * 8;
    float mpv[3][8], mnv[3][8], kav[8], rkv[8], lgv[8], lbv[8];
#pragma unroll
    for (int i = 0; i < 8; ++i) {
#pragma unroll
      for (int a = 0; a < 3; ++a) { mpv[a][i] = PT(mu_prev)[a * 512 + c0 + i]; mnv[a][i] = PT(mu_next)[a * 512 + c0 + i]; }
      kav[i] = PT(k_a)[c0 + i]; rkv[i] = PT(r_k)[c0 + i]; lgv[i] = PT(lnx_g)[c0 + i]; lbv[i] = PT(lnx_b)[c0 + i]; }
#pragma unroll 2
    for (int t = gwave; t < T; t += nwave) {
      const int s = t & 4095;
      float sh[3][8];
#pragma unroll
      for (int a = 0; a < 3; ++a) {
        const bf16_t* rp = hr + (size_t)t * 1856 + a * 512 + c0; float c[8], pv[8], nv[8]; unpack8(*(const u32x4*)rp, c);
        if (s > 0) unpack8(*(const GAS u32x4*)(rp - 1856), pv); else {
#pragma unroll
          for (int i = 0; i < 8; ++i) pv[i] = 0.f; }
        if (s < 4095) unpack8(*(const GAS u32x4*)(rp + 1856), nv); else {
#pragma unroll
          for (int i = 0; i < 8; ++i) nv[i] = 0.f; }
#pragma unroll
        for (int i = 0; i < 8; ++i) sh[a][i] = c[i] + mpv[a][i] * (pv[i] - c[i]) + mnv[a][i] * (nv[i] - c[i]);
      }
      float av[8], gv[8], yf[8], ybk[8];
      unpack8(*(const GAS u32x4*)(lo + (size_t)t * 2048 + 1024 + c0), av); unpack8(*(const GAS u32x4*)(lo + (size_t)t * 2048 + 1536 + c0), gv);
      unpack8(*(const GAS u32x4*)(yb + (size_t)t * 512 + c0), yf); unpack8(*(const GAS u32x4*)(yb + ((size_t)T + t) * 512 + c0), ybk);
      float y[8], sy = 0.f, sb = 0.f;
#pragma unroll
      for (int i = 0; i < 8; ++i) { y[i] = yf[i] + ybk[i]; sy += y[i]; const float km = sh[1][i] * (1.0f + (av[i] - 1.0f) * kav[i]); sb += sh[0][i] * km * rkv[i]; }
      sy = oct_sum(sy); sb = oct_sum(sb);
      const float mu = sy * (1.0f / 64.0f); float sv = 0.f;
#pragma unroll
      for (int i = 0; i < 8; ++i) { y[i] -= mu; sv += y[i] * y[i]; }
      sv = oct_sum(sv);
      const float rs = 1.0f / sqrtf(sv * (1.0f / 64.0f) + 64e-5f);
      float o[8];
#pragma unroll
      for (int i = 0; i < 8; ++i) o[i] = ((y[i] * rs) * lgv[i] + lbv[i] + sb * sh[2][i]) * gv[i];
      *(GAS u32x4*)(bout + (size_t)t * 512 + c0) = pack8(o);
    }
  }
    } else if (kind == 7 && (EN & 64)) {
  {
    const bf16_t* Q = (const bf16_t*)(ws + O_Q); const bf16_t* K = (const bf16_t*)(ws + O_K); const bf16_t* Vt = (const bf16_t*)(ws + O_VT); bf16_t* ao = (bf16_t*)(ws + O_AOUT);
    for (int unit = blockIdx.x; unit < NBATCH * 8 * 16; unit += gridDim.x) {
      const int qb = unit & 15, bh = unit >> 4, b = bh >> 3, h = bh & 7;
      attn_unit_pp<96, 64>(Q + ((size_t)bh * SEQ + qb * 256) * 96, 96, K + (size_t)bh * SEQ * 96, 96, Vt + (size_t)bh * 64 * SEQ, SEQ, SEQ, ao + ((size_t)b * SEQ + qb * 256) * 512 + h * 64, 512, lds, tid);
    }
  }
    } else if (kind == 8 && (EN & 128)) {
  {
    const bf16_t* cq = (const bf16_t*)(ws + O_CQ); const bf16_t* Kc = (const bf16_t*)(ws + O_KC); const bf16_t* VcT = (const bf16_t*)(ws + O_VCT); bf16_t* co = (bf16_t*)(ws + O_CO);
    for (int unit = blockIdx.x; unit < (T / 256) * 4; unit += gridDim.x) {
      const int h = unit & 3, rb = unit >> 2, b = rb >> 4;
      attn_unit<128, 128, false>(cq + (size_t)rb * 256 * 512 + h * 128, 512, Kc + (size_t)b * 256 * 512 + h * 128, 512, VcT + (size_t)(b * 4 + h) * 128 * 256, 256, 256, co + (size_t)rb * 256 * 512 + h * 128, 512, lds, tid);
    }
  }
    }
    if (sync && step != 25) { ++nbar; fast_barrier((unsigned*)(p.ws + O_PTAB + 512), nbar * gridDim.x, tid); }
  }
}

extern "C" void kernel_launch(void* const* d_in, const int* in_sizes, int n_in, void* d_out, int out_size, void* d_ws, size_t ws_size, hipStream_t stream) {
  static int grid_blocks = 0;
  if (!grid_blocks) {
    int dev = 0, cus = 0, per_cu = 0;
    (void)hipGetDevice(&dev);
    (void)hipDeviceGetAttribute(&cus, hipDeviceAttributeMultiprocessorCount, dev);
    (void)hipFuncSetAttribute((const void*)fwd_mega, hipFuncAttributeMaxDynamicSharedMemorySize, LDS_BYTES);
    (void)hipOccupancyMaxActiveBlocksPerMultiprocessor(&per_cu, fwd_mega, 512, LDS_BYTES);
    if (per_cu < 1) per_cu = 1;
    grid_blocks = cus * per_cu;
    if (grid_blocks > 256) grid_blocks = 256;
  }
  Params p{};
  const float** pp = (const float**)&p;
  for (int i = 0; i < 42; ++i) pp[i] = (const float*)d_in[i];
  p.out = (float*)d_out; p.ws = (unsigned char*)d_ws;
  void* args[] = {&p};
  hipError_t e = hipLaunchCooperativeKernel((void*)fwd_mega, dim3(grid_blocks), dim3(512), args, LDS_BYTES, stream);
  if (e != hipSuccess) fprintf(stderr, "cooperative launch failed: %s (grid %d)\n", hipGetErrorString(e), grid_blocks);
}
```

```cpp
#include <hip/hip_runtime.h>
#include <hip/hip_cooperative_groups.h>
#include <cstdio>
namespace cg = cooperative_groups;

#define LAS __attribute__((address_space(3)))
#define GAS __attribute__((address_space(1)))
#define ASSUME_GLOBAL(p) do { (p) = (unsigned char*)(__attribute__((address_space(1))) unsigned char*)(p); } while (0)
typedef unsigned short bf16_t;
typedef short bf16x8 __attribute__((ext_vector_type(8)));
typedef float f32x4 __attribute__((ext_vector_type(4)));
typedef float f32x2 __attribute__((ext_vector_type(2)));
typedef unsigned u32x4 __attribute__((ext_vector_type(4)));
typedef unsigned u32x2 __attribute__((ext_vector_type(2)));

constexpr int T = 81920, SEQ = 4096, NBATCH = 20, DM = 1024, DFF = 2816;
constexpr float ALPHA = 1.189207115002721f;
constexpr float LOG2E = 1.4426950408889634f;
constexpr float QSCALE = 0.10206207261596577f * LOG2E;
constexpr float CQSCALE = 0.08838834764831845f * LOG2E;
constexpr int LDS_BYTES = 142 * 1024;
#ifndef EN
#define EN 255
#endif
#ifndef LNX
#define LNX 0
#endif

constexpr size_t al256(size_t x) { return (x + 255) & ~(size_t)255; }
constexpr size_t O_WGU1 = 0;
constexpr size_t O_WD1 = O_WGU1 + 5632ull * 1024 * 2;
constexpr size_t O_WGU2 = O_WD1 + 1024ull * 2816 * 2;
constexpr size_t O_WD2 = O_WGU2 + 5632ull * 1024 * 2;
constexpr size_t O_WINQ = O_WD2 + 1024ull * 2816 * 2;
constexpr size_t O_WINR = O_WINQ + 768ull * 1024 * 2;
constexpr size_t O_WING = O_WINR + 2048ull * 1024 * 2;
constexpr size_t O_WUQ = O_WING + 2048ull * 1024 * 2;
constexpr size_t O_WUKV = O_WUQ + 768ull * 384 * 2;
constexpr size_t O_PMLA = O_WUKV + 1024ull * 256 * 2;
constexpr size_t O_PRWKV = O_PMLA + 1024ull * 512 * 2;
constexpr size_t O_WO = O_PRWKV + 1024ull * 512 * 2;
constexpr size_t O_WLORA = O_WO + 1024ull * 1024 * 2;
constexpr size_t O_WCQ = O_WLORA + 2048ull * 384 * 2;
constexpr size_t O_WCKV = O_WCQ + 512ull * 1024 * 2;
constexpr size_t O_WCO = O_WCKV + 1024ull * 1024 * 2;
constexpr size_t O_ROPE = O_WCO + 1024ull * 512 * 2;
constexpr size_t O_RSTD = O_ROPE + 4096ull * 32 * 4;
constexpr size_t O_MEMLN = O_RSTD + (size_t)T * 2 * 4;
constexpr size_t O_KC = O_MEMLN + 5120ull * 1024 * 2;
constexpr size_t O_VCT = O_KC + 5120ull * 512 * 2;
constexpr size_t O_PTAB = O_VCT + 5120ull * 512 * 2;
constexpr size_t O_XCH = O_PTAB + 1024;
constexpr size_t O_CNT = O_XCH + (size_t)T * 4 * 8;
constexpr size_t O_XB = O_CNT + 4ull * 320 * 256;
constexpr size_t O_ARENA = O_XB + (size_t)T * 1024 * 2;
constexpr size_t O_HR = O_ARENA;
constexpr size_t O_LOUT = O_HR + (size_t)T * 1856 * 2;
constexpr size_t O_LIN = O_LOUT + (size_t)T * 2048 * 2;
constexpr size_t O_Y = O_LIN + (size_t)T * 384 * 2;
constexpr size_t O_BOUT = O_Y + 2ull * T * 512 * 2;
constexpr size_t O_HQKV = O_BOUT + (size_t)T * 512 * 2;
constexpr size_t O_END = O_HQKV + (size_t)T * 768 * 2;
static_assert(O_END <= 1342177280ull, "workspace");
constexpr size_t O_GATES = O_ARENA;
constexpr size_t O_Q = O_GATES + (size_t)T * 2048 * 2;
constexpr size_t O_K = O_Q + (size_t)T * 768 * 2;
constexpr size_t O_VT = O_K + (size_t)T * 768 * 2;
constexpr size_t O_AOUT = O_VT + (size_t)T * 512 * 2;
static_assert(O_AOUT + (size_t)T * 512 * 2 <= O_BOUT, "overlap");
constexpr size_t O_MIX = O_Q;
static_assert(O_MIX + (size_t)T * 1024 * 2 <= O_AOUT, "overlap");
constexpr size_t O_CQ = O_ARENA;
constexpr size_t O_CO = O_CQ + (size_t)T * 512 * 2;
constexpr size_t O_HFF = O_ARENA;

struct Params {
  const float *x_p, *x_s, *mem_p, *mem_s;
  const float *ln1_g, *ln1_b, *ffn1_wgu, *ffn1_wd, *w_in, *b_gate, *q_norm_g, *w_uq, *kv_norm_g, *w_ukv, *p_mla, *mu_prev, *mu_next, *w0, *w_up, *a0, *a_up, *g_up,
      *k_k, *k_a, *r_k, *lnx_g, *lnx_b, *p_rwkv, *w_o, *ln2_g, *ln2_b, *mem_g, *mem_b, *w_cq, *w_ckv, *w_co, *ln3_g, *ln3_b, *ffn2_wgu, *ffn2_wd, *ln4_g, *ln4_b;
  float* out; unsigned char* ws;
};

enum { I_x_p, I_x_s, I_mem_p, I_mem_s, I_ln1_g, I_ln1_b, I_ffn1_wgu, I_ffn1_wd, I_w_in, I_b_gate, I_q_norm_g, I_w_uq, I_kv_norm_g, I_w_ukv, I_p_mla, I_mu_prev, I_mu_next, I_w0, I_w_up, I_a0, I_a_up, I_g_up, I_k_k, I_k_a, I_r_k, I_lnx_g, I_lnx_b, I_p_rwkv, I_w_o, I_ln2_g, I_ln2_b, I_mem_g, I_mem_b, I_w_cq, I_w_ckv, I_w_co, I_ln3_g, I_ln3_b, I_ffn2_wgu, I_ffn2_wd, I_ln4_g, I_ln4_b, I_out };
#define PT(name) (ptab[I_##name])
typedef const float* const* PTab;
__device__ __forceinline__ float bf2f(bf16_t b) { return __uint_as_float(((unsigned)b) << 16); }
__device__ __forceinline__ unsigned cvt_pk_bf16(float lo, float hi) { unsigned r; asm("v_cvt_pk_bf16_f32 %0, %1, %2" : "=v"(r) : "v"(lo), "v"(hi)); return r; }
__device__ __forceinline__ bf16_t f2bf(float f) { return (bf16_t)(cvt_pk_bf16(f, 0.f) & 0xffffu); }
__device__ __forceinline__ void unpack8(const u32x4 w, float* f) {
#pragma unroll
  for (int i = 0; i < 4; ++i) { f[2 * i] = __uint_as_float(w[i] << 16); f[2 * i + 1] = __uint_as_float(w[i] & 0xffff0000u); }
}
__device__ __forceinline__ u32x4 pack8(const float* f) { u32x4 w; w.x = cvt_pk_bf16(f[0], f[1]); w.y = cvt_pk_bf16(f[2], f[3]); w.z = cvt_pk_bf16(f[4], f[5]); w.w = cvt_pk_bf16(f[6], f[7]); return w; }
__device__ __forceinline__ float sigmoidf_(float x) { return 1.0f / (1.0f + __expf(-x)); }
template <int CTRL> __device__ __forceinline__ float dpp_f(float x) { return __builtin_bit_cast(float, __builtin_amdgcn_update_dpp(0, __builtin_bit_cast(int, x), CTRL, 0xf, 0xf, true)); }
__device__ __forceinline__ float quad_sum(float v) { v += dpp_f<0xB1>(v); v += dpp_f<0x4E>(v); return v; }
__device__ __forceinline__ float oct_sum(float v) { v += dpp_f<0xB1>(v); v += dpp_f<0x4E>(v); v += dpp_f<0x141>(v); return v; }
__device__ __forceinline__ float row16_sum(float v) { v = oct_sum(v); v += dpp_f<0x140>(v); return v; }

__device__ __forceinline__ float xrow16_max(float x) {
  auto s = __builtin_amdgcn_permlane16_swap(__float_as_uint(x), __float_as_uint(x), false, false);
  x = fmaxf(__uint_as_float(s[0]), __uint_as_float(s[1]));
  auto t = __builtin_amdgcn_permlane32_swap(__float_as_uint(x), __float_as_uint(x), false, false);
  return fmaxf(__uint_as_float(t[0]), __uint_as_float(t[1]));
}
__device__ __forceinline__ float xrow16_sum(float x) {
  auto s = __builtin_amdgcn_permlane16_swap(__float_as_uint(x), __float_as_uint(x), false, false);
  x = __uint_as_float(s[0]) + __uint_as_float(s[1]);
  auto t = __builtin_amdgcn_permlane32_swap(__float_as_uint(x), __float_as_uint(x), false, false);
  return __uint_as_float(t[0]) + __uint_as_float(t[1]);
}
__device__ __forceinline__ float wave_sum(float v) { return xrow16_sum(row16_sum(v)); }
constexpr int BM = 256, BK = 64, HALF = 128, HTB = HALF * BK * 2, STAGE_BYTES = 8 * HTB, NXCD = 8, WGM = 8;
__device__ __forceinline__ int lds_byte(int r, int c) { const int st = (r >> 4) * 2 + (c >> 5), rr = r & 15, cc = c & 31, ob = rr * 64 + cc * 2; return st * 1024 + (ob ^ (((ob >> 9) & 1) << 5)); }
__device__ __forceinline__ void stage_rc(int b, int& R, int& C) { const int st = b / 1024, sb = b % 1024, swz = sb ^ (((sb >> 9) & 1) << 5); R = (st >> 1) * 16 + swz / 64; C = (st & 1) * 32 + (swz % 64) / 2; }
__device__ __forceinline__ int perm32(int rho) { const int n = rho >> 4, i = rho & 15; return 8 * (i >> 2) + 4 * n + (i & 3); }
struct Unit { int pm, pn; };
struct Gemm { const bf16_t* A; const bf16_t* Bt; int M, N, K, lda, ldb; };
struct StaticOrder {
  int nM, nN, nwg, G, c;
  __device__ void init(int M, int N, int G_, int c_) { nM = M / BM; nN = N / BM; nwg = nM * nN; G = G_; c = c_; }
  __device__ bool next(int i, Unit& u) const {
    const long L = (long)i * G + c; if (L >= nwg) return false;
    int wgid = (int)L; { const int q = nwg / NXCD, r = nwg % NXCD, xcd = wgid % NXCD, off = wgid / NXCD; wgid = (xcd < r ? xcd * (q + 1) : r * (q + 1) + (xcd - r) * q) + off; }
    const int nig = WGM * nN, gid = wgid / nig, fm = gid * WGM, gsz = (nM - fm) < WGM ? (nM - fm) : WGM;
    u.pm = fm + ((wgid % nig) % gsz); u.pn = (wgid % nig) / gsz; return true;
  }
};

typedef f32x4 Acc[2][2][4][2];

struct EpiSwiglu {
  static constexpr bool PERM = true;
  bf16_t* H;
  __device__ __forceinline__ void operator()(const Acc& acc, const Unit& u, int wr, int wc, int fr, int fq) const {
    const int col0 = u.pn * 128 + wc * 32 + 8 * fq;
#pragma unroll
    for (int ai = 0; ai < 2; ++ai)
#pragma unroll
      for (int m = 0; m < 4; ++m) {
        const int row = u.pm * BM + ai * HALF + wr * 64 + m * 16 + fr;
        float o[8];
#pragma unroll
        for (int n = 0; n < 2; ++n)
#pragma unroll
          for (int j = 0; j < 4; ++j) { const float gte = acc[ai][0][m][n][j], up = acc[ai][1][m][n][j]; o[n * 4 + j] = gte * up / (1.0f + __expf(-gte)); }
        *(GAS u32x4*)(H + (size_t)row * DFF + col0) = pack8(o);
      }
  }
};

__device__ __forceinline__ f32x4 sig4(f32x4 v) { f32x4 o; o[0] = sigmoidf_(v[0]); o[1] = sigmoidf_(v[1]); o[2] = sigmoidf_(v[2]); o[3] = sigmoidf_(v[3]); return o; }
__device__ __forceinline__ float dec1(float x) { return -(0.6065306597126334f * LOG2E) / (1.0f + __expf(-x)); }
__device__ __forceinline__ f32x4 dec4(f32x4 v) { f32x4 o; o[0] = dec1(v[0]); o[1] = dec1(v[1]); o[2] = dec1(v[2]); o[3] = dec1(v[3]); return o; }
template <int ACT>
struct EpiBf16 {
  static constexpr bool PERM = true;
  bf16_t* O; int ldc; int ncols; float scale; const float* bias; const float* w0; const float* a0;
  __device__ __forceinline__ void operator()(const Acc& acc, const Unit& u, int wr, int wc, int fr, int fq) const {
#pragma unroll
    for (int bj = 0; bj < 2; ++bj) {
      const int c0 = u.pn * BM + bj * HALF + wc * 32 + 8 * fq;
      const bool active = c0 < ncols;
      f32x4 b0 = (f32x4){0.f, 0.f, 0.f, 0.f}, b1 = (f32x4){0.f, 0.f, 0.f, 0.f};
      if (ACT == 1) { b0 = *(const GAS f32x4*)(bias + c0); b1 = *(const GAS f32x4*)(bias + c0 + 4); }
      if (ACT == 2) { if (u.pn < 6) { const float* src = (u.pn < 4) ? (w0 + c0) : (a0 + (c0 - 1024)); b0 = *(const GAS f32x4*)(src); b1 = *(const GAS f32x4*)(src + 4); } }
#pragma unroll
      for (int ai = 0; ai < 2; ++ai)
#pragma unroll
        for (int m = 0; m < 4; ++m) {
          const int row = u.pm * BM + ai * HALF + wr * 64 + m * 16 + fr;
          f32x4 v0 = acc[ai][bj][m][0], v1 = acc[ai][bj][m][1];
          if (ACT == 0) { v0 *= scale; v1 *= scale; }
          if (ACT == 1) { v0 = sig4(v0 + b0); v1 = sig4(v1 + b1); }
          if (ACT == 2) { if (u.pn < 4) { v0 = dec4(v0 + b0); v1 = dec4(v1 + b1); } else if (u.pn < 6) { v0 = sig4(v0 + b0); v1 = sig4(v1 + b1); } }
          u32x4 w; w.x = cvt_pk_bf16(v0[0], v0[1]); w.y = cvt_pk_bf16(v0[2], v0[3]); w.z = cvt_pk_bf16(v1[0], v1[1]); w.w = cvt_pk_bf16(v1[2], v1[3]);
          if (active) *(GAS u32x4*)(O + (size_t)row * ldc + c0) = w;
        }
    }
  }
};

struct EpiTrunk {
  static constexpr bool PERM = false;
  const float* base_p; const float* base_s; float* out; float scale;
  __device__ __forceinline__ void operator()(const Acc& acc, const Unit& u, int wr, int wc, int fr, int fq) const {
    const int col0 = u.pn * BM + wc * 32 + 4 * fq;
#pragma unroll
    for (int ai = 0; ai < 2; ++ai)
#pragma unroll
      for (int m = 0; m < 4; ++m) {
        const int row = u.pm * BM + ai * HALF + wr * 64 + m * 16 + fr;
        const float* bp = (base_s && row >= 65536) ? base_s + (size_t)(row - 65536) * DM : base_p + (size_t)row * DM;
        float* op = out + (size_t)row * DM;
#pragma unroll
        for (int bj = 0; bj < 2; ++bj)
#pragma unroll
          for (int n = 0; n < 2; ++n) { const int c = col0 + bj * HALF + n * 16; const f32x4 bs = *(const GAS f32x4*)(bp + c); *(GAS f32x4*)(op + c) = bs * ALPHA + acc[ai][bj][m][n] * scale; }
        asm volatile("" ::: "memory");
      }
  }
};

struct EpiTrunkLN {
  const float* base_p; const float* base_s; float* out; bf16_t* xb; const float* lg; const float* lb; unsigned long long* X; unsigned* cnt; float scale; LAS unsigned char* lds;
  __device__ __forceinline__ void operator()(const Acc& acc, const Unit& u, int wr, int wc, int fr, int fq) const {
    LAS f32x2* P = (LAS f32x2*)(lds + 131072);
    LAS f32x2* St = (LAS f32x2*)(lds + 131072 + 8192);
    const int col0 = u.pn * BM + wc * 32 + 8 * fq; const int wid = wr * 4 + wc, lane = fq * 16 + fr;
    const float* ubase = (base_s && u.pm >= 256) ? base_s + (size_t)(u.pm - 256) * BM * DM : base_p + (size_t)u.pm * BM * DM;
    float* uout = out + (size_t)u.pm * BM * DM; bf16_t* uxb = xb ? xb + (size_t)u.pm * BM * DM : nullptr;
#define LN_LOADB(dst, aim_) do { _Pragma("unroll") for (int mm = 0; mm < 2; ++mm) _Pragma("unroll") for (int bj = 0; bj < 2; ++bj) _Pragma("unroll") for (int n = 0; n < 2; ++n) \
      dst[mm][bj][n] = *(const GAS f32x4*)(ubase + ((((aim_) >> 1) * HALF + wr * 64 + ((((aim_) & 1) * 2) + mm) * 16 + fr) * DM + col0 + bj * HALF + n * 4)); } while (0)
#define LN_SUMB(src, aim_) do { _Pragma("unroll") for (int mm = 0; mm < 2; ++mm) { const int ai = (aim_) >> 1, m = ((aim_) & 1) * 2 + mm; const int rl = ai * HALF + wr * 64 + m * 16 + fr; float sm = 0.f, sq = 0.f; \
      _Pragma("unroll") for (int bj = 0; bj < 2; ++bj) _Pragma("unroll") for (int n = 0; n < 2; ++n) { const f32x4 v = src[mm][bj][n] * ALPHA + acc[ai][bj][m][n] * scale; \
        sm += (v[0] + v[1]) + (v[2] + v[3]); sq += (v[0] * v[0] + v[1] * v[1]) + (v[2] * v[2] + v[3] * v[3]); } \
      sm = xrow16_sum(sm); sq = xrow16_sum(sq); if (fq == 0) P[rl * 4 + wc] = (f32x2){sm, sq}; } } while (0)
    {
      f32x4 bA[2][2][2], bB[2][2][2];
      LN_LOADB(bA, 0); LN_LOADB(bB, 1); asm volatile("" ::: "memory");
      LN_SUMB(bA, 0); LN_SUMB(bB, 1); asm volatile("" ::: "memory");
      LN_LOADB(bA, 2); LN_LOADB(bB, 3); asm volatile("" ::: "memory");
      LN_SUMB(bA, 2); LN_SUMB(bB, 3);
    }
    asm volatile("s_waitcnt lgkmcnt(0)" ::: "memory"); __builtin_amdgcn_s_barrier(); __builtin_amdgcn_s_barrier(); asm volatile("" ::: "memory");
    const int rl2 = wid * 32 + (lane & 31);
    if (lane < 32) {
      const f32x2 a = P[rl2 * 4 + 0], b = P[rl2 * 4 + 1], c = P[rl2 * 4 + 2], d = P[rl2 * 4 + 3];
      const float s4 = (a.x + b.x) + (c.x + d.x), q4 = (a.y + b.y) + (c.y + d.y);
      __hip_atomic_store(X + ((size_t)(u.pm * BM + rl2) * 4 + u.pn), ((unsigned long long)__float_as_uint(q4) << 32) | __float_as_uint(s4), __ATOMIC_RELAXED, __HIP_MEMORY_SCOPE_AGENT);
    }
    asm volatile("s_waitcnt vmcnt(0)" ::: "memory");
    if (lane == 0) __hip_atomic_fetch_add(cnt + 64 * u.pm, 1u, __ATOMIC_RELAXED, __HIP_MEMORY_SCOPE_AGENT);
    __builtin_amdgcn_s_barrier();
    f32x4 pA[2][2][2], pB[2][2][2];
    LN_LOADB(pA, 0); LN_LOADB(pB, 1);
    while ((unsigned)__builtin_amdgcn_readfirstlane((int)__hip_atomic_load(cnt + 64 * u.pm, __ATOMIC_RELAXED, __HIP_MEMORY_SCOPE_AGENT)) < 32u) __builtin_amdgcn_s_sleep(1);
    __builtin_amdgcn_fence(__ATOMIC_ACQUIRE, "agent");
    if (lane < 32) {
      const unsigned long long* sl = X + (size_t)(u.pm * BM + rl2) * 4; float S = 0.f, Q = 0.f;
#pragma unroll
      for (int t = 0; t < 4; ++t) { const unsigned long long w = __hip_atomic_load(sl + t, __ATOMIC_RELAXED, __HIP_MEMORY_SCOPE_AGENT); S += __uint_as_float((unsigned)w); Q += __uint_as_float((unsigned)(w >> 32)); }
      const float mean = S * (1.0f / 1024.0f); const float var = fmaxf(Q * (1.0f / 1024.0f) - mean * mean, 0.f);
      St[rl2] = (f32x2){mean, 1.0f / sqrtf(var + 1e-5f)};
    }
    asm volatile("s_waitcnt vmcnt(0) lgkmcnt(0)" ::: "memory"); __builtin_amdgcn_s_barrier(); __builtin_amdgcn_s_barrier(); asm volatile("" ::: "memory");
    float scale2 = scale; asm volatile("" : "+s"(scale2));
#define LN_APPLYB(src, aim_) do { _Pragma("unroll") for (int mm = 0; mm < 2; ++mm) { const int ai = (aim_) >> 1, m = ((aim_) & 1) * 2 + mm; const int rl = ai * HALF + wr * 64 + m * 16 + fr; const int off = rl * DM + col0; const f32x2 sr = St[rl]; \
      _Pragma("unroll") for (int bj = 0; bj < 2; ++bj) { f32x4 o2[2]; \
        _Pragma("unroll") for (int n = 0; n < 2; ++n) { const f32x4 v = src[mm][bj][n] * ALPHA + acc[ai][bj][m][n] * scale2; o2[n] = (v - sr.x) * sr.y * *(const GAS f32x4*)(lg + col0 + bj * HALF + n * 4) + *(const GAS f32x4*)(lb + col0 + bj * HALF + n * 4); \
          *(GAS f32x4*)(uout + (off + bj * HALF + n * 4)) = o2[n]; } \
        if (uxb) { u32x4 w; w.x = cvt_pk_bf16(o2[0][0], o2[0][1]); w.y = cvt_pk_bf16(o2[0][2], o2[0][3]); w.z = cvt_pk_bf16(o2[1][0], o2[1][1]); w.w = cvt_pk_bf16(o2[1][2], o2[1][3]); *(GAS u32x4*)(uxb + (off + bj * HALF)) = w; } } } } while (0)
    {
      asm volatile("" ::: "memory");
      LN_APPLYB(pA, 0); LN_APPLYB(pB, 1); asm volatile("" ::: "memory");
      LN_LOADB(pA, 2); LN_LOADB(pB, 3); asm volatile("" ::: "memory");
      LN_APPLYB(pA, 2); LN_APPLYB(pB, 3);
    }
#undef LN_LOADB
#undef LN_SUMB
#undef LN_APPLYB
  }
};

struct EpiQ {
  static constexpr bool PERM = true;
  bf16_t* Q; const float* rstd; const float* rope;
  __device__ __forceinline__ void operator()(const Acc& acc, const Unit& u, int wr, int wc, int fr, int fq) const {
    float rsv[2][4];
#pragma unroll
    for (int ai = 0; ai < 2; ++ai)
#pragma unroll
      for (int m = 0; m < 4; ++m) rsv[ai][m] = ((const GAS float*)rstd)[(size_t)(u.pm * BM + ai * HALF + wr * 64 + m * 16 + fr) * 2];
#pragma unroll
    for (int ai = 0; ai < 2; ++ai)
#pragma unroll
      for (int m = 0; m < 4; ++m) {
        const int row = u.pm * BM + ai * HALF + wr * 64 + m * 16 + fr; const int b = row >> 12, s = row & 4095;
        const float rs = rsv[ai][m] * QSCALE;
#pragma unroll
        for (int bj = 0; bj < 2; ++bj) {
          const int G = 8 * u.pn + 4 * bj + wc; const int h = G / 3, part = G - 3 * h;
          f32x4 v0 = acc[ai][bj][m][0] * rs, v1 = acc[ai][bj][m][1] * rs;
          if (part == 2) { const f32x4 c = *(const GAS f32x4*)(rope + s * 32 + 4 * fq), sn = *(const GAS f32x4*)(rope + s * 32 + 16 + 4 * fq);
            const f32x4 o0 = v0 * c - v1 * sn, o1 = v0 * sn + v1 * c; v0 = o0; v1 = o1; }
          u32x4 w; w.x = cvt_pk_bf16(v0[0], v0[1]); w.y = cvt_pk_bf16(v0[2], v0[3]); w.z = cvt_pk_bf16(v1[0], v1[1]); w.w = cvt_pk_bf16(v1[2], v1[3]);
          *(GAS u32x4*)(Q + ((size_t)(b * 8 + h) * SEQ + s) * 96 + part * 32 + 8 * fq) = w;
        }
      }
  }
};

struct EpiKV {
  static constexpr bool PERM = true;
  bf16_t* K; bf16_t* Vt; const float* rstd;
  __device__ __forceinline__ void operator()(const Acc& acc, const Unit& u, int wr, int wc, int fr, int fq) const {
    float rsv[2][4];
#pragma unroll
    for (int ai = 0; ai < 2; ++ai)
#pragma unroll
      for (int m = 0; m < 4; ++m) rsv[ai][m] = ((const GAS float*)rstd)[(size_t)(u.pm * BM + ai * HALF + wr * 64 + m * 16 + fr) * 2 + 1];
#pragma unroll
    for (int ai = 0; ai < 2; ++ai)
#pragma unroll
      for (int m = 0; m < 4; ++m) {
        const int row = u.pm * BM + ai * HALF + wr * 64 + m * 16 + fr; const int b = row >> 12, s = row & 4095;
        const float rs = rsv[ai][m];
#pragma unroll
        for (int bj = 0; bj < 2; ++bj) {
          const int G = 8 * u.pn + 4 * bj + wc; const int h = G >> 2, part = G & 3;
          const f32x4 v0 = acc[ai][bj][m][0] * rs, v1 = acc[ai][bj][m][1] * rs;
          if (part < 2) { u32x4 w; w.x = cvt_pk_bf16(v0[0], v0[1]); w.y = cvt_pk_bf16(v0[2], v0[3]); w.z = cvt_pk_bf16(v1[0], v1[1]); w.w = cvt_pk_bf16(v1[2], v1[3]);
            *(GAS u32x4*)(K + ((size_t)(b * 8 + h) * SEQ + s) * 96 + part * 32 + 8 * fq) = w; }
          else { GAS bf16_t* vp = (GAS bf16_t*)Vt + ((size_t)(b * 8 + h) * 64 + (part - 2) * 32 + 8 * fq) * SEQ + s;
#pragma unroll
            for (int j = 0; j < 4; ++j) { vp[(size_t)j * SEQ] = f2bf(v0[j]); vp[(size_t)(4 + j) * SEQ] = f2bf(v1[j]); } }
        }
      }
  }
};

struct EpiCKV {
  static constexpr bool PERM = true;
  bf16_t* Kc; bf16_t* VcT;
  __device__ __forceinline__ void operator()(const Acc& acc, const Unit& u, int wr, int wc, int fr, int fq) const {
#pragma unroll
    for (int ai = 0; ai < 2; ++ai)
#pragma unroll
      for (int m = 0; m < 4; ++m) {
        const int row = u.pm * BM + ai * HALF + wr * 64 + m * 16 + fr; const int b = row >> 8, key = row & 255;
#pragma unroll
        for (int bj = 0; bj < 2; ++bj) {
          const int c0 = u.pn * BM + bj * HALF + wc * 32 + 8 * fq;
          const f32x4 v0 = acc[ai][bj][m][0], v1 = acc[ai][bj][m][1];
          if (c0 < 512) { u32x4 w; w.x = cvt_pk_bf16(v0[0], v0[1]); w.y = cvt_pk_bf16(v0[2], v0[3]); w.z = cvt_pk_bf16(v1[0], v1[1]); w.w = cvt_pk_bf16(v1[2], v1[3]);
            *(GAS u32x4*)(Kc + (size_t)row * 512 + c0) = w; }
          else { const int cc = c0 - 512; GAS bf16_t* vp = (GAS bf16_t*)VcT + ((size_t)(b * 4 + (cc >> 7)) * 128 + (cc & 127)) * 256 + key;
#pragma unroll
            for (int j = 0; j < 4; ++j) { vp[j * 256] = f2bf(v0[j]); vp[(4 + j) * 256] = f2bf(v1[j]); } }
        }
      }
  }
};

template <int SECOND>
struct EpiMix {
  static constexpr bool PERM = true;
  bf16_t* mix; const bf16_t* gates; int goff;
  __device__ __forceinline__ void operator()(const Acc& acc, const Unit& u, int wr, int wc, int fr, int fq) const {
#pragma unroll
    for (int ai = 0; ai < 2; ++ai) {
      u32x4 gw[4][2], mw[4][2];
#pragma unroll
      for (int m = 0; m < 4; ++m)
#pragma unroll
        for (int bj = 0; bj < 2; ++bj) {
          const int row = u.pm * BM + ai * HALF + wr * 64 + m * 16 + fr; const int c0 = u.pn * BM + bj * HALF + wc * 32 + 8 * fq;
          gw[m][bj] = *(const GAS u32x4*)(gates + (size_t)row * 2048 + goff + c0);
          if (SECOND) mw[m][bj] = *(const GAS u32x4*)(mix + (size_t)row * DM + c0);
        }
#pragma unroll
      for (int m = 0; m < 4; ++m)
#pragma unroll
        for (int bj = 0; bj < 2; ++bj) {
          const int row = u.pm * BM + ai * HALF + wr * 64 + m * 16 + fr; const int c0 = u.pn * BM + bj * HALF + wc * 32 + 8 * fq;
          float gt[8], o[8]; unpack8(gw[m][bj], gt);
          if (SECOND) unpack8(mw[m][bj], o);
#pragma unroll
          for (int n = 0; n < 2; ++n)
#pragma unroll
            for (int j = 0; j < 4; ++j) { const float v = gt[n * 4 + j] * acc[ai][bj][m][n][j]; o[n * 4 + j] = SECOND ? o[n * 4 + j] + v : v; }
          *(GAS u32x4*)(mix + (size_t)row * DM + c0) = pack8(o);
        }
      asm volatile("" ::: "memory");
    }
  }
};

struct Epi {
  int mode; bf16_t* O; bf16_t* O2; const bf16_t* bfp; const float* f0; const float* f1; float* outf; int ldc, ncols, goff; float scale; const float* g0; const float* g1; unsigned char* wsx; LAS unsigned char* lds;
  __device__ __forceinline__ bool perm() const { return mode != 4; }
  __device__ __forceinline__ void operator()(Acc& acc, const Unit& u, int wr, int wc, int fr, int fq) const {
    switch (mode) {
      case 0: EpiBf16<0>{O, ldc, ncols, scale, nullptr, nullptr, nullptr}(acc, u, wr, wc, fr, fq); break;
      case 1: EpiBf16<1>{O, ldc, ncols, 1.0f, f0, nullptr, nullptr}(acc, u, wr, wc, fr, fq); break;
      case 2: EpiBf16<2>{O, ldc, ncols, 1.0f, nullptr, f0, f1}(acc, u, wr, wc, fr, fq); break;
      case 3: EpiSwiglu{O}(acc, u, wr, wc, fr, fq); break;
      case 4: EpiTrunkLN{f0, f1, outf, O, g0, g1, (unsigned long long*)(wsx + O_XCH), (unsigned*)(wsx + O_CNT) + (size_t)ldc * 320 * 64, scale, lds}(acc, u, wr, wc, fr, fq); break;
      case 5: EpiQ{O, f0, f1}(acc, u, wr, wc, fr, fq); break;
      case 6: EpiKV{O, O2, f0}(acc, u, wr, wc, fr, fq); break;
      case 7: EpiCKV{O, O2}(acc, u, wr, wc, fr, fq); break;
      case 8: EpiMix<0>{O, bfp, goff}(acc, u, wr, wc, fr, fq); break;
      default: EpiMix<1>{O, bfp, goff}(acc, u, wr, wc, fr, fq); break;
    }
  }
};

__device__ __forceinline__ Gemm get_gemm(int step, PTab ptab, unsigned char* ws) {
  const bf16_t* xb = (const bf16_t*)(ws + O_XB);
  switch (step) {
    case 1: return Gemm{xb, (const bf16_t*)(ws + O_WGU1), T, 5632, 1024, 1024, 1024};
    case 2: return Gemm{(const bf16_t*)(ws + O_MEMLN), (const bf16_t*)(ws + O_WCKV), 5120, 1024, 1024, 1024, 1024};
    case 3: return Gemm{(const bf16_t*)(ws + O_HFF), (const bf16_t*)(ws + O_WD1), T, 1024, 2816, 2816, 2816};
    case 5: return Gemm{xb, (const bf16_t*)(ws + O_WINR), T, 2048, 1024, 1024, 1024};
    case 6: return Gemm{xb, (const bf16_t*)(ws + O_WINQ), T, 768, 1024, 1024, 1024};
    case 8: return Gemm{(const bf16_t*)(ws + O_LIN), (const bf16_t*)(ws + O_WLORA), T, 2048, 384, 384, 384};
    case 11: return Gemm{xb, (const bf16_t*)(ws + O_WING), T, 2048, 1024, 1024, 1024};
    case 12: return Gemm{(const bf16_t*)(ws + O_HQKV), (const bf16_t*)(ws + O_WUQ), T, 768, 384, 768, 384};
    case 13: return Gemm{(const bf16_t*)(ws + O_HQKV) + 384, (const bf16_t*)(ws + O_WUKV), T, 1024, 256, 768, 256};
    case 15: return Gemm{(const bf16_t*)(ws + O_AOUT), (const bf16_t*)(ws + O_PMLA), T, 1024, 512, 512, 512};
    case 16: return Gemm{(const bf16_t*)(ws + O_BOUT), (const bf16_t*)(ws + O_PRWKV), T, 1024, 512, 512, 512};
    case 17: return Gemm{(const bf16_t*)(ws + O_MIX), (const bf16_t*)(ws + O_WO), T, 1024, 1024, 1024, 1024};
    case 19: return Gemm{xb, (const bf16_t*)(ws + O_WCQ), T, 512, 1024, 1024, 1024};
    case 21: return Gemm{(const bf16_t*)(ws + O_CO), (const bf16_t*)(ws + O_WCO), T, 1024, 512, 512, 512};
    case 23: return Gemm{xb, (const bf16_t*)(ws + O_WGU2), T, 5632, 1024, 1024, 1024};
    case 24: return Gemm{(const bf16_t*)(ws + O_HFF), (const bf16_t*)(ws + O_WD2), T, 1024, 2816, 2816, 2816};
    default: return Gemm{nullptr, nullptr, 0, 0, 0, 0, 0};
  }
}
__device__ __forceinline__ Epi get_epi(int step, PTab ptab, unsigned char* ws, LAS unsigned char* lds) {
  const float* rope = (const float*)(ws + O_ROPE); const float* rstd = (const float*)(ws + O_RSTD);
  switch (step) {
    case 1: return Epi{3, (bf16_t*)(ws + O_HFF), nullptr, nullptr, nullptr, nullptr, nullptr, 0, 0, 0, 1.0f};
    case 2: return Epi{7, (bf16_t*)(ws + O_KC), (bf16_t*)(ws + O_VCT), nullptr, nullptr, nullptr, nullptr, 0, 0, 0, 1.0f};
    case 3: return Epi{4, (bf16_t*)(ws + O_XB), nullptr, nullptr, PT(x_p), PT(x_s), ((float*)PT(out)), 0, 0, 0, 0.5f, PT(ln1_g), PT(ln1_b), ws, lds};
    case 5: return Epi{0, (bf16_t*)(ws + O_HR), nullptr, nullptr, nullptr, nullptr, nullptr, 1856, 1856, 0, 1.0f};
    case 6: return Epi{0, (bf16_t*)(ws + O_HQKV), nullptr, nullptr, nullptr, nullptr, nullptr, 768, 768, 0, 1.0f};
    case 8: return Epi{2, (bf16_t*)(ws + O_LOUT), nullptr, nullptr, PT(w0), PT(a0), nullptr, 2048, 2048, 0, 1.0f};
    case 11: return Epi{1, (bf16_t*)(ws + O_GATES), nullptr, nullptr, PT(b_gate), nullptr, nullptr, 2048, 2048, 0, 1.0f};
    case 12: return Epi{5, (bf16_t*)(ws + O_Q), nullptr, nullptr, rstd, rope, nullptr, 0, 0, 0, 1.0f};
    case 13: return Epi{6, (bf16_t*)(ws + O_K), (bf16_t*)(ws + O_VT), nullptr, rstd, nullptr, nullptr, 0, 0, 0, 1.0f};
    case 15: return Epi{8, (bf16_t*)(ws + O_MIX), nullptr, (const bf16_t*)(ws + O_GATES), nullptr, nullptr, nullptr, 0, 0, 0, 1.0f};
    case 16: return Epi{9, (bf16_t*)(ws + O_MIX), nullptr, (const bf16_t*)(ws + O_GATES), nullptr, nullptr, nullptr, 0, 0, 1024, 1.0f};
    case 17: return Epi{4, (bf16_t*)(ws + O_XB), nullptr, nullptr, ((float*)PT(out)), nullptr, ((float*)PT(out)), 1, 0, 0, 1.0f, PT(ln2_g), PT(ln2_b), ws, lds};
    case 19: return Epi{0, (bf16_t*)(ws + O_CQ), nullptr, nullptr, nullptr, nullptr, nullptr, 512, 512, 0, CQSCALE};
    case 21: return Epi{4, (bf16_t*)(ws + O_XB), nullptr, nullptr, ((float*)PT(out)), nullptr, ((float*)PT(out)), 2, 0, 0, 1.0f, PT(ln3_g), PT(ln3_b), ws, lds};
    case 23: return Epi{3, (bf16_t*)(ws + O_HFF), nullptr, nullptr, nullptr, nullptr, nullptr, 0, 0, 0, 1.0f};
    case 24: return Epi{4, nullptr, nullptr, nullptr, ((float*)PT(out)), nullptr, ((float*)PT(out)), 3, 0, 0, 0.5f, PT(ln4_g), PT(ln4_b), ws, lds};
    default: return Epi{0, nullptr, nullptr, nullptr, nullptr, nullptr, nullptr, 0, 0, 0, 1.0f};
  }
}

__device__ __forceinline__ void gemm_phase(LAS unsigned char* lds, const int step, PTab ptab, unsigned char* ws, const int tid) {
  const Gemm g = get_gemm(step, ptab, ws); const bool permB = true;
  StaticOrder S; S.init(g.M, g.N, (int)gridDim.x, (int)blockIdx.x);
  const int wid = __builtin_amdgcn_readfirstlane(tid >> 6), lane = tid & 63, wr = wid >> 2, wc = wid & 3, fr = lane & 15, fq = lane >> 4;
  const int K = g.K, nt = K / BK;
  unsigned voffA[2], voffB[2]; int aoff, boff;
#define PG8_LANE_SETUP() do { int tid_l = tid; asm volatile("" : "+v"(tid_l)); const int lane_l = tid_l & 63, fr_l = lane_l & 15, fq_l = lane_l >> 4; \
    _Pragma("unroll") for (int i = 0; i < 2; ++i) { int R, C; stage_rc(tid_l * 16 + i * 8192, R, C); const int Rb = permB ? ((R & ~31) + perm32(R & 31)) : R; \
      voffA[i] = (unsigned)(R * g.lda + C) * 2u; voffB[i] = (unsigned)(Rb * g.ldb + C) * 2u; } \
    aoff = lds_byte(wr * 64 + fr_l, fq_l * 8); boff = lds_byte(wc * 32 + fr_l, fq_l * 8); } while (0)
  PG8_LANE_SETUP();
  const size_t kstep = (size_t)(BK * 2);
  const size_t hstepA = (size_t)HALF * g.lda * 2, hstepB = (size_t)HALF * g.ldb * 2;
  const size_t tstepA = 2 * hstepA, tstepB = 2 * hstepB;
  const unsigned ldsw = (unsigned)wid * 1024u;
#define PG8_SA(b, h) (((b) * 2 + (h)) * HTB)
#define PG8_SB(b, h) ((4 + (b) * 2 + (h)) * HTB)
#define PG8_STAGE(bufoff, gbase, voff) do { _Pragma("unroll") for (int _i = 0; _i < 2; ++_i) \
    __builtin_amdgcn_global_load_lds((const unsigned*)((const char*)(gbase) + (voff)[_i]), (LAS unsigned*)(lds + (bufoff) + ldsw + _i * 8192), 16, 0, 0); } while (0)
#define PG8_LDA(dst, b, h) do { _Pragma("unroll") for (int m = 0; m < 4; ++m) _Pragma("unroll") for (int k = 0; k < 2; ++k) dst[m][k] = *(const LAS bf16x8*)(lds + PG8_SA(b, h) + aoff + m * 2048 + k * 1024); } while (0)
#define PG8_LDB(dst, b, h) do { _Pragma("unroll") for (int n = 0; n < 2; ++n) _Pragma("unroll") for (int k = 0; k < 2; ++k) dst[n][k] = *(const LAS bf16x8*)(lds + PG8_SB(b, h) + boff + n * 2048 + k * 1024); } while (0)
#define PG8_MMA(ai, bj, At, Bt) do { __builtin_amdgcn_s_setprio(1); _Pragma("unroll") for (int m = 0; m < 4; ++m) _Pragma("unroll") for (int n = 0; n < 2; ++n) _Pragma("unroll") for (int k = 0; k < 2; ++k) \
    acc[ai][bj][m][n] = __builtin_amdgcn_mfma_f32_16x16x32_bf16(Bt[n][k], At[m][k], acc[ai][bj][m][n], 0, 0, 0); __builtin_amdgcn_s_setprio(0); } while (0)
#define PG8_WAIT_V(n) asm volatile("s_waitcnt vmcnt(" #n ")" ::: "memory")
#define PG8_WAIT_L(n) asm volatile("s_waitcnt lgkmcnt(" #n ")" ::: "memory")
#define PG8_BAR __builtin_amdgcn_s_barrier()
#define PG8_SCHED __builtin_amdgcn_sched_barrier(0)
  Unit cur, nxt; int ui = 0;
  if (!S.next(0, cur)) return;
  f32x4 acc[2][2][4][2];
#pragma unroll
  for (int a = 0; a < 2; ++a)
#pragma unroll
    for (int b = 0; b < 2; ++b)
#pragma unroll
      for (int m = 0; m < 4; ++m)
#pragma unroll
        for (int n = 0; n < 2; ++n) acc[a][b][m][n] = (f32x4){0.f, 0.f, 0.f, 0.f};
  bf16x8 At[4][2], B0[2][2], B1[2][2];
  const char* cA = (const char*)g.A + (size_t)cur.pm * tstepA; const char* cB = (const char*)g.Bt + (size_t)cur.pn * tstepB;
  PG8_STAGE(PG8_SB(0, 0), cB, voffB); PG8_STAGE(PG8_SA(0, 0), cA, voffA); PG8_STAGE(PG8_SB(0, 1), cB + hstepB, voffB); PG8_STAGE(PG8_SA(0, 1), cA + hstepA, voffA);
  if (wr == 1) PG8_BAR;
  PG8_WAIT_V(4); PG8_BAR;
  PG8_STAGE(PG8_SB(1, 0), cB + kstep, voffB); PG8_STAGE(PG8_SA(1, 0), cA + kstep, voffA); PG8_STAGE(PG8_SB(1, 1), cB + hstepB + kstep, voffB);
  PG8_WAIT_V(6); PG8_BAR;
  for (;;) {
    const bool has_next = S.next(ui + 1, nxt);
    const char* nA = has_next ? (const char*)g.A + (size_t)nxt.pm * tstepA : cA; const char* nB = has_next ? (const char*)g.Bt + (size_t)nxt.pn * tstepB : cB;
    for (int t = 0; t < nt; t += 2) {
      const bool last = (t == nt - 2);
      const char* a1 = cA + (size_t)(t + 1) * kstep;
      const char* a2 = last ? nA : cA + (size_t)(t + 2) * kstep; const char* b2 = last ? nB : cB + (size_t)(t + 2) * kstep;
      const char* a3 = a2 + kstep; const char* b3 = b2 + kstep;
      PG8_LDB(B0, 0, 0); PG8_SCHED; PG8_LDA(At, 0, 0); PG8_STAGE(PG8_SA(1, 1), a1 + hstepA, voffA);
      PG8_WAIT_L(8); PG8_BAR; PG8_WAIT_L(0); PG8_MMA(0, 0, At, B0); PG8_BAR; PG8_SCHED;
      PG8_LDB(B1, 0, 1); PG8_STAGE(PG8_SB(0, 0), b2, voffB);
      PG8_BAR; PG8_WAIT_L(0); PG8_MMA(0, 1, At, B1); PG8_BAR;
      PG8_LDA(At, 0, 1); PG8_STAGE(PG8_SA(0, 0), a2, voffA);
      PG8_BAR; PG8_WAIT_L(0); PG8_MMA(1, 0, At, B0); PG8_BAR; PG8_SCHED;
      PG8_STAGE(PG8_SB(0, 1), b2 + hstepB, voffB);
      PG8_WAIT_V(6); PG8_BAR; PG8_MMA(1, 1, At, B1); PG8_BAR;
      PG8_LDB(B0, 1, 0); PG8_SCHED; PG8_LDA(At, 1, 0); PG8_STAGE(PG8_SA(0, 1), a2 + hstepA, voffA);
      PG8_WAIT_L(8); PG8_BAR; PG8_WAIT_L(0); PG8_MMA(0, 0, At, B0); PG8_BAR; PG8_SCHED;
      PG8_LDB(B1, 1, 1); PG8_STAGE(PG8_SB(1, 0), b3, voffB);
      PG8_BAR; PG8_WAIT_L(0); PG8_MMA(0, 1, At, B1); PG8_BAR;
      PG8_LDA(At, 1, 1); PG8_STAGE(PG8_SA(1, 0), a3, voffA);
      PG8_BAR; PG8_WAIT_L(0); PG8_MMA(1, 0, At, B0); PG8_BAR; PG8_SCHED;
      PG8_STAGE(PG8_SB(1, 1), b3 + hstepB, voffB);
      PG8_WAIT_V(6); PG8_BAR; PG8_MMA(1, 1, At, B1); PG8_BAR;
    }
    { int st2 = step; asm volatile("" : "+s"(st2)); int wr2 = wr, wc2 = wc, fr2 = fr, fq2 = fq; asm volatile("" : "+s"(wr2), "+s"(wc2)); asm volatile("" : "+v"(fr2), "+v"(fq2));
      unsigned char* ws2 = ws; asm volatile("" : "+s"(ws2)); const Epi E = get_epi(st2, (PTab)(ws2 + O_PTAB), ws2, lds); E(acc, cur, wr2, wc2, fr2, fq2); }
    if (!has_next) break;
#pragma unroll
    for (int a = 0; a < 2; ++a)
#pragma unroll
      for (int b = 0; b < 2; ++b)
#pragma unroll
        for (int m = 0; m < 4; ++m)
#pragma unroll
          for (int n = 0; n < 2; ++n) acc[a][b][m][n] = (f32x4){0.f, 0.f, 0.f, 0.f};
    cur = nxt; cA = nA; cB = nB; ++ui;
    PG8_LANE_SETUP();
  }
  PG8_WAIT_V(0);
  if (wr == 0) PG8_BAR;
  PG8_BAR;
#undef PG8_LANE_SETUP
#undef PG8_SA
#undef PG8_SB
#undef PG8_STAGE
#undef PG8_LDA
#undef PG8_LDB
#undef PG8_MMA
#undef PG8_WAIT_V
#undef PG8_WAIT_L
#undef PG8_BAR
#undef PG8_SCHED
}


template <int DQK, int DV, bool PF>
__device__ __forceinline__ void attn_unit(const bf16_t* q, int ldq, const bf16_t* k, int ldk, const bf16_t* vt, int ldv, int nkeys, bf16_t* o, int ldo, LAS unsigned char* lds, const int tid) {
  constexpr int KS = DQK / 32, DVB = DV / 16, KROW = DQK * 2 + 16, VROW = 144, KT_B = 64 * KROW, VT_B = DV * VROW, BUF_B = KT_B + VT_B;
  constexpr int KCPR = DQK / 8, KCH = 64 * KCPR, VCH = DV * 8, KPT = (KCH + 511) / 512, VPT = (VCH + 511) / 512;
  const int wid = tid >> 6, lane = tid & 63, l15 = lane & 15, quad = lane >> 4;
  bf16x8 qf[2][KS];
#pragma unroll
  for (int qb = 0; qb < 2; ++qb)
#pragma unroll
    for (int ks = 0; ks < KS; ++ks) qf[qb][ks] = *(const GAS bf16x8*)(q + (size_t)(wid * 32 + qb * 16 + l15) * ldq + ks * 32 + quad * 8);
  f32x4 oacc[DVB][2];
#pragma unroll
  for (int d = 0; d < DVB; ++d) { oacc[d][0] = (f32x4){0.f, 0.f, 0.f, 0.f}; oacc[d][1] = (f32x4){0.f, 0.f, 0.f, 0.f}; }
  float mrun[2] = {-INFINITY, -INFINITY}, lrun[2] = {0.f, 0.f};
  u32x4 kst[KPT], vst[VPT];
#define ATT_GLOAD(tile) do { _Pragma("unroll") for (int i = 0; i < KPT; ++i) { const int ch = tid + i * 512; if (ch < KCH) { const int r = ch / KCPR, c = ch - r * KCPR; kst[i] = *(const GAS u32x4*)(k + (size_t)((tile) * 64 + r) * ldk + c * 8); } } \
    _Pragma("unroll") for (int i = 0; i < VPT; ++i) { const int ch = tid + i * 512; if (ch < VCH) { const int r = ch >> 3, c = ch & 7; vst[i] = *(const GAS u32x4*)(vt + (size_t)r * ldv + (tile) * 64 + c * 8); } } } while (0)
#define ATT_LSTORE(buf) do { _Pragma("unroll") for (int i = 0; i < KPT; ++i) { const int ch = tid + i * 512; if (ch < KCH) { const int r = ch / KCPR, c = ch - r * KCPR; *(LAS u32x4*)(lds + (buf) * BUF_B + r * KROW + c * 16) = kst[i]; } } \
    _Pragma("unroll") for (int i = 0; i < VPT; ++i) { const int ch = tid + i * 512; if (ch < VCH) { const int r = ch >> 3, c = ch & 7; *(LAS u32x4*)(lds + (buf) * BUF_B + KT_B + r * VROW + c * 16) = vst[i]; } } } while (0)
  const int ntiles = nkeys / 64;
  if (PF) { ATT_GLOAD(0); ATT_LSTORE(0); __syncthreads(); }
  for (int t = 0; t < ntiles; ++t) {
    const int buf = PF ? (t & 1) : 0;
    if (PF) { if (t + 1 < ntiles) ATT_GLOAD(t + 1); } else { ATT_GLOAD(t); ATT_LSTORE(0); __syncthreads(); }
    f32x4 sacc[4][2];
#pragma unroll
    for (int kb = 0; kb < 4; ++kb) { sacc[kb][0] = (f32x4){0.f, 0.f, 0.f, 0.f}; sacc[kb][1] = (f32x4){0.f, 0.f, 0.f, 0.f}; }
#pragma unroll
    for (int ks = 0; ks < KS; ++ks) {
      bf16x8 kf[4];
#pragma unroll
      for (int kb = 0; kb < 4; ++kb) kf[kb] = *(const LAS bf16x8*)(lds + buf * BUF_B + (kb * 16 + l15) * KROW + ks * 64 + quad * 16);
#pragma unroll
      for (int kb = 0; kb < 4; ++kb)
#pragma unroll
        for (int qb = 0; qb < 2; ++qb) sacc[kb][qb] = __builtin_amdgcn_mfma_f32_16x16x32_bf16(kf[kb], qf[qb][ks], sacc[kb][qb], 0, 0, 0);
    }
    bf16x8 pf[2][2];
#pragma unroll
    for (int qb = 0; qb < 2; ++qb) {
      float mx = sacc[0][qb][0];
#pragma unroll
      for (int kb = 0; kb < 4; ++kb)
#pragma unroll
        for (int j = 0; j < 4; ++j) mx = fmaxf(mx, sacc[kb][qb][j]);
      mx = xrow16_max(mx);
      const float mnew = fmaxf(mrun[qb], mx); const float alpha = __builtin_amdgcn_exp2f(mrun[qb] - mnew); mrun[qb] = mnew;
      float ps = 0.f;
#pragma unroll
      for (int kb = 0; kb < 4; ++kb)
#pragma unroll
        for (int j = 0; j < 4; ++j) { const float pv = __builtin_amdgcn_exp2f(sacc[kb][qb][j] - mnew); sacc[kb][qb][j] = pv; ps += pv; }
      ps = xrow16_sum(ps);
      lrun[qb] = lrun[qb] * alpha + ps;
#pragma unroll
      for (int d = 0; d < DVB; ++d) oacc[d][qb] *= alpha;
#pragma unroll
      for (int ks2 = 0; ks2 < 2; ++ks2) { u32x4 w; w.x = cvt_pk_bf16(sacc[2 * ks2][qb][0], sacc[2 * ks2][qb][1]); w.y = cvt_pk_bf16(sacc[2 * ks2][qb][2], sacc[2 * ks2][qb][3]);
        w.z = cvt_pk_bf16(sacc[2 * ks2 + 1][qb][0], sacc[2 * ks2 + 1][qb][1]); w.w = cvt_pk_bf16(sacc[2 * ks2 + 1][qb][2], sacc[2 * ks2 + 1][qb][3]); pf[qb][ks2] = __builtin_bit_cast(bf16x8, w); }
    }
#pragma unroll
    for (int ks2 = 0; ks2 < 2; ++ks2)
#pragma unroll
      for (int d = 0; d < DVB; ++d) {
        const LAS unsigned char* vp = lds + buf * BUF_B + KT_B + (d * 16 + l15) * VROW + ks2 * 64 + quad * 8;
        const u32x2 lo = *(const LAS u32x2*)vp, hi = *(const LAS u32x2*)(vp + 32);
        u32x4 w; w.x = lo.x; w.y = lo.y; w.z = hi.x; w.w = hi.y; const bf16x8 vf = __builtin_bit_cast(bf16x8, w);
#pragma unroll
        for (int qb = 0; qb < 2; ++qb) oacc[d][qb] = __builtin_amdgcn_mfma_f32_16x16x32_bf16(vf, pf[qb][ks2], oacc[d][qb], 0, 0, 0);
      }
    if (PF) { if (t + 1 < ntiles) ATT_LSTORE(buf ^ 1); }
    __syncthreads();
  }
#undef ATT_GLOAD
#undef ATT_LSTORE
#pragma unroll
  for (int qb = 0; qb < 2; ++qb) {
    const float inv = 1.0f / lrun[qb]; const int row = wid * 32 + qb * 16 + l15;
#pragma unroll
    for (int d = 0; d < DVB; ++d) { const f32x4 v = oacc[d][qb] * inv; u32x2 w; w.x = cvt_pk_bf16(v[0], v[1]); w.y = cvt_pk_bf16(v[2], v[3]); *(GAS u32x2*)(o + (size_t)row * ldo + d * 16 + quad * 4) = w; }
  }
}

template <int DQK, int DV>
__device__ __forceinline__ void attn_unit_pp(const bf16_t* q, int ldq, const bf16_t* k, int ldk, const bf16_t* vt, int ldv, int nkeys, bf16_t* o, int ldo, LAS unsigned char* lds, const int tid) {
  constexpr int KS = DQK / 32, DVB = DV / 16, KROW = DQK * 2 + 16, VROW = 144, KT_B = 64 * KROW, VT_B = DV * VROW, BUF_B = KT_B + VT_B;
  constexpr int KCPR = DQK / 8, KCH = 64 * KCPR, VCH = DV * 8, KPT = (KCH + 511) / 512, VPT = (VCH + 511) / 512;
  const int wid = tid >> 6, lane = tid & 63, l15 = lane & 15, quad = lane >> 4; const int grp = __builtin_amdgcn_readfirstlane(wid >> 2);
  bf16x8 qf[2][KS];
#pragma unroll
  for (int qb = 0; qb < 2; ++qb)
#pragma unroll
    for (int ks = 0; ks < KS; ++ks) qf[qb][ks] = *(const GAS bf16x8*)(q + (size_t)(wid * 32 + qb * 16 + l15) * ldq + ks * 32 + quad * 8);
  f32x4 oacc[DVB][2];
#pragma unroll
  for (int d = 0; d < DVB; ++d) { oacc[d][0] = (f32x4){0.f, 0.f, 0.f, 0.f}; oacc[d][1] = (f32x4){0.f, 0.f, 0.f, 0.f}; }
  float mref[2] = {0.f, 0.f};
  f32x4 lacc[2] = {(f32x4){0.f, 0.f, 0.f, 0.f}, (f32x4){0.f, 0.f, 0.f, 0.f}};
  const bf16x8 vones = (l15 == 0) ? (bf16x8){0x3F80, 0x3F80, 0x3F80, 0x3F80, 0x3F80, 0x3F80, 0x3F80, 0x3F80} : (bf16x8){0, 0, 0, 0, 0, 0, 0, 0};
  u32x4 kstA[KPT], vstA[VPT], kstB[KPT], vstB[VPT];
#define ATT_GLOAD(kst, vst, tile) do { _Pragma("unroll") for (int i = 0; i < KPT; ++i) { const int ch = tid + i * 512; if (ch < KCH) { const int r = ch / KCPR, c = ch - r * KCPR; kst[i] = *(const GAS u32x4*)(k + (size_t)((tile) * 64 + r) * ldk + c * 8); } } \
    _Pragma("unroll") for (int i = 0; i < VPT; ++i) { const int ch = tid + i * 512; if (ch < VCH) { const int r = ch >> 3, c = ch & 7; vst[i] = *(const GAS u32x4*)(vt + (size_t)r * ldv + (tile) * 64 + c * 8); } } } while (0)
#define ATT_LSTORE(kst, vst, bufoff) do { _Pragma("unroll") for (int i = 0; i < KPT; ++i) { const int ch = tid + i * 512; if (ch < KCH) { const int r = ch / KCPR, c = ch - r * KCPR; *(LAS u32x4*)(lds + (bufoff) + r * KROW + c * 16) = kst[i]; } } \
    _Pragma("unroll") for (int i = 0; i < VPT; ++i) { const int ch = tid + i * 512; if (ch < VCH) { const int r = ch >> 3, c = ch & 7; *(LAS u32x4*)(lds + (bufoff) + KT_B + r * VROW + c * 16) = vst[i]; } } } while (0)
#define ATT_PV(bufoff) do { _Pragma("unroll") for (int ks2 = 0; ks2 < 2; ++ks2) _Pragma("unroll") for (int d = 0; d < DVB; ++d) { \
      const LAS unsigned char* vp = lds + (bufoff) + KT_B + (d * 16 + l15) * VROW + ks2 * 64 + quad * 8; const u32x2 lo = *(const LAS u32x2*)vp, hi = *(const LAS u32x2*)(vp + 32); \
      u32x4 w; w.x = lo.x; w.y = lo.y; w.z = hi.x; w.w = hi.y; const bf16x8 vf = __builtin_bit_cast(bf16x8, w); \
      _Pragma("unroll") for (int qb = 0; qb < 2; ++qb) oacc[d][qb] = __builtin_amdgcn_mfma_f32_16x16x32_bf16(vf, pf[qb][ks2], oacc[d][qb], 0, 0, 0); } \
    _Pragma("unroll") for (int ks2 = 0; ks2 < 2; ++ks2) _Pragma("unroll") for (int qb = 0; qb < 2; ++qb) lacc[qb] = __builtin_amdgcn_mfma_f32_16x16x32_bf16(vones, pf[qb][ks2], lacc[qb], 0, 0, 0); } while (0)
#define ATT_BAR() do { asm volatile("s_waitcnt lgkmcnt(0)" ::: "memory"); __builtin_amdgcn_s_barrier(); asm volatile("" ::: "memory"); } while (0)
  const int ntiles = nkeys / 64;
  ATT_GLOAD(kstA, vstA, 0); ATT_LSTORE(kstA, vstA, 0); __syncthreads();
  ATT_GLOAD(kstB, vstB, 1); ATT_GLOAD(kstA, vstA, 2);
  if (grp == 1) ATT_BAR();
  bf16x8 pf[2][2];
#pragma unroll
  for (int qb = 0; qb < 2; ++qb) { pf[qb][0] = (bf16x8){0, 0, 0, 0, 0, 0, 0, 0}; pf[qb][1] = (bf16x8){0, 0, 0, 0, 0, 0, 0, 0}; }
  int bcur = 0, bprev = 2 * BUF_B, bnext = BUF_B;
  for (int t0 = 0; t0 < ntiles; t0 += 2) {
    { const int t = t0;
    f32x4 sacc[4][2];
#pragma unroll
    for (int kb = 0; kb < 4; ++kb) { sacc[kb][0] = (f32x4){-mref[0], -mref[0], -mref[0], -mref[0]}; sacc[kb][1] = (f32x4){-mref[1], -mref[1], -mref[1], -mref[1]}; }
#pragma unroll
    for (int ks = 0; ks < KS; ++ks) {
      bf16x8 kf[4];
#pragma unroll
      for (int kb = 0; kb < 4; ++kb) kf[kb] = *(const LAS bf16x8*)(lds + bcur + (kb * 16 + l15) * KROW + ks * 64 + quad * 16);
#pragma unroll
      for (int kb = 0; kb < 4; ++kb)
#pragma unroll
        for (int qb = 0; qb < 2; ++qb) sacc[kb][qb] = __builtin_amdgcn_mfma_f32_16x16x32_bf16(kf[kb], qf[qb][ks], sacc[kb][qb], 0, 0, 0);
    }
    if (t > 0) ATT_PV(bprev);
    if (t + 1 < ntiles) ATT_LSTORE(kstB, vstB, bnext);
    ATT_BAR();
    if (t + 3 < ntiles) ATT_GLOAD(kstB, vstB, t + 3);
    float mxq[2];
#pragma unroll
    for (int qb = 0; qb < 2; ++qb) {
      float mx = sacc[0][qb][0];
#pragma unroll
      for (int kb = 0; kb < 4; ++kb)
#pragma unroll
        for (int j = 0; j < 4; ++j) mx = fmaxf(mx, sacc[kb][qb][j]);
      mxq[qb] = xrow16_max(mx);
    }
    if (t == 0 || __any(fmaxf(mxq[0], mxq[1]) > 8.0f)) {
#pragma unroll
      for (int qb = 0; qb < 2; ++qb) {
        const float shift = (t == 0) ? mxq[qb] : fmaxf(mxq[qb], 0.f); const float alpha = (t == 0) ? 0.f : __builtin_amdgcn_exp2f(-shift);
        mref[qb] += shift;
#pragma unroll
        for (int kb = 0; kb < 4; ++kb)
#pragma unroll
          for (int j = 0; j < 4; ++j) sacc[kb][qb][j] -= shift;
#pragma unroll
        for (int d = 0; d < DVB; ++d) oacc[d][qb] *= alpha;
        lacc[qb] *= alpha;
      }
    }
#pragma unroll
    for (int qb = 0; qb < 2; ++qb) {
#pragma unroll
      for (int kb = 0; kb < 4; ++kb)
#pragma unroll
        for (int j = 0; j < 4; ++j) sacc[kb][qb][j] = __builtin_amdgcn_exp2f(sacc[kb][qb][j]);
#pragma unroll
      for (int ks2 = 0; ks2 < 2; ++ks2) { u32x4 w; w.x = cvt_pk_bf16(sacc[2 * ks2][qb][0], sacc[2 * ks2][qb][1]); w.y = cvt_pk_bf16(sacc[2 * ks2][qb][2], sacc[2 * ks2][qb][3]);
        w.z = cvt_pk_bf16(sacc[2 * ks2 + 1][qb][0], sacc[2 * ks2 + 1][qb][1]); w.w = cvt_pk_bf16(sacc[2 * ks2 + 1][qb][2], sacc[2 * ks2 + 1][qb][3]); pf[qb][ks2] = __builtin_bit_cast(bf16x8, w); }
    }
    ATT_BAR();
    { const int tmp = bprev; bprev = bcur; bcur = bnext; bnext = tmp; }
    }
    { const int t = t0 + 1;
    f32x4 sacc[4][2];
#pragma unroll
    for (int kb = 0; kb < 4; ++kb) { sacc[kb][0] = (f32x4){-mref[0], -mref[0], -mref[0], -mref[0]}; sacc[kb][1] = (f32x4){-mref[1], -mref[1], -mref[1], -mref[1]}; }
#pragma unroll
    for (int ks = 0; ks < KS; ++ks) {
      bf16x8 kf[4];
#pragma unroll
      for (int kb = 0; kb < 4; ++kb) kf[kb] = *(const LAS bf16x8*)(lds + bcur + (kb * 16 + l15) * KROW + ks * 64 + quad * 16);
#pragma unroll
      for (int kb = 0; kb < 4; ++kb)
#pragma unroll
        for (int qb = 0; qb < 2; ++qb) sacc[kb][qb] = __builtin_amdgcn_mfma_f32_16x16x32_bf16(kf[kb], qf[qb][ks], sacc[kb][qb], 0, 0, 0);
    }
    if (t > 0) ATT_PV(bprev);
    if (t + 1 < ntiles) ATT_LSTORE(kstA, vstA, bnext);
    ATT_BAR();
    if (t + 3 < ntiles) ATT_GLOAD(kstA, vstA, t + 3);
    float mxq[2];
#pragma unroll
    for (int qb = 0; qb < 2; ++qb) {
      float mx = sacc[0][qb][0];
#pragma unroll
      for (int kb = 0; kb < 4; ++kb)
#pragma unroll
        for (int j = 0; j < 4; ++j) mx = fmaxf(mx, sacc[kb][qb][j]);
      mxq[qb] = xrow16_max(mx);
    }
    if (t == 0 || __any(fmaxf(mxq[0], mxq[1]) > 8.0f)) {
#pragma unroll
      for (int qb = 0; qb < 2; ++qb) {
        const float shift = (t == 0) ? mxq[qb] : fmaxf(mxq[qb], 0.f); const float alpha = (t == 0) ? 0.f : __builtin_amdgcn_exp2f(-shift);
        mref[qb] += shift;
#pragma unroll
        for (int kb = 0; kb < 4; ++kb)
#pragma unroll
          for (int j = 0; j < 4; ++j) sacc[kb][qb][j] -= shift;
#pragma unroll
        for (int d = 0; d < DVB; ++d) oacc[d][qb] *= alpha;
        lacc[qb] *= alpha;
      }
    }
#pragma unroll
    for (int qb = 0; qb < 2; ++qb) {
#pragma unroll
      for (int kb = 0; kb < 4; ++kb)
#pragma unroll
        for (int j = 0; j < 4; ++j) sacc[kb][qb][j] = __builtin_amdgcn_exp2f(sacc[kb][qb][j]);
#pragma unroll
      for (int ks2 = 0; ks2 < 2; ++ks2) { u32x4 w; w.x = cvt_pk_bf16(sacc[2 * ks2][qb][0], sacc[2 * ks2][qb][1]); w.y = cvt_pk_bf16(sacc[2 * ks2][qb][2], sacc[2 * ks2][qb][3]);
        w.z = cvt_pk_bf16(sacc[2 * ks2 + 1][qb][0], sacc[2 * ks2 + 1][qb][1]); w.w = cvt_pk_bf16(sacc[2 * ks2 + 1][qb][2], sacc[2 * ks2 + 1][qb][3]); pf[qb][ks2] = __builtin_bit_cast(bf16x8, w); }
    }
    ATT_BAR();
    { const int tmp = bprev; bprev = bcur; bcur = bnext; bnext = tmp; }
    }
  }
  ATT_PV(bprev);
  if (grp == 0) ATT_BAR();
  __syncthreads();
#undef ATT_GLOAD
#undef ATT_LSTORE
#undef ATT_PV
#undef ATT_BAR
#pragma unroll
  for (int qb = 0; qb < 2; ++qb) {
    const float inv = 1.0f / __builtin_bit_cast(float, __builtin_amdgcn_ds_bpermute(l15 * 4, __builtin_bit_cast(int, lacc[qb][0]))); const int row = wid * 32 + qb * 16 + l15;
#pragma unroll
    for (int d = 0; d < DVB; ++d) { const f32x4 v = oacc[d][qb] * inv; u32x2 w; w.x = cvt_pk_bf16(v[0], v[1]); w.y = cvt_pk_bf16(v[2], v[3]); *(GAS u32x2*)(o + (size_t)row * ldo + d * 16 + quad * 4) = w; }
  }
}

struct WDesc { const float* src; bf16_t* dst; const float* ks; int K, N, ld, mode; };
__device__ __forceinline__ int w_cmap(int mode, int n) {
  switch (mode) {
    case 1: { const int pn = n >> 8, i = n & 255; return i < 128 ? pn * 128 + i : DFF + pn * 128 + (i - 128); }
    case 2: return n < 672 ? n : -1;
    case 3: return n < 1856 ? 672 + n : -1;
    case 4: return 2528 + n;
    case 5: { const int h = n / 96, pp = n - h * 96; if (pp < 64) return n; const int p = pp - 64; return h * 96 + 64 + (p & 3) + 4 * (p >> 3) + 16 * ((p >> 2) & 1); }
    default: return n;
  }
}
__device__ __forceinline__ void prep_tile(const WDesc& d, int tk, int tn, const Params& p, LAS float* tl) {
  const int tid = threadIdx.x; const int k0 = tk * 64, n0 = tn * 64;
  {
    const int nn = tid & 63, kq = tid >> 6; const int n = n0 + nn;
#pragma unroll
    for (int i = 0; i < 8; ++i) {
      const int k = k0 + kq * 8 + i; float v = 0.f;
      if (d.mode == 7) {
        const int blk = n >> 9, nl = n & 511;
        if (blk == 0) { if (k < 64) v = p.w_up[(size_t)k * 512 + nl]; }
        else if (blk == 1) { if (k >= 64 && k < 128) v = p.w_up[(size_t)(64 + (k - 64)) * 512 + nl]; }
        else if (blk == 2) { if (k >= 128 && k < 192) v = p.a_up[(size_t)(k - 128) * 512 + nl]; }
        else { if (k >= 192 && k < 320) v = p.g_up[(size_t)(k - 192) * 512 + nl]; }
      } else {
        const int c = w_cmap(d.mode, n);
        if (c >= 0) { v = d.src[(size_t)k * d.ld + c]; if (d.ks) v *= d.ks[k]; }
      }
      tl[(kq * 8 + i) * 65 + nn] = v;
    }
  }
  __syncthreads();
  {
    const int n = tid >> 3, kc = (tid & 7) * 8; float f[8];
#pragma unroll
    for (int i = 0; i < 8; ++i) f[i] = tl[(kc + i) * 65 + n];
    *(u32x4*)(d.dst + (size_t)(n0 + n) * d.K + k0 + kc) = pack8(f);
  }
  __syncthreads();
}

__device__ __forceinline__ void ln_phase(float* trunk, const float* g, const float* b, bf16_t* xb, bool write_f32, const int tid) {
  const int lane = tid & 63, wid = tid >> 6;
  f32x4 gv[4], bv[4];
#pragma unroll
  for (int i = 0; i < 4; ++i) { gv[i] = *(const f32x4*)(g + i * 256 + lane * 4); bv[i] = *(const f32x4*)(b + i * 256 + lane * 4); }
  for (int row = blockIdx.x * 8 + wid; row < T; row += gridDim.x * 8) {
    float* rp = trunk + (size_t)row * DM; f32x4 v[4]; float s = 0.f;
#pragma unroll
    for (int i = 0; i < 4; ++i) { v[i] = *(const f32x4*)(rp + i * 256 + lane * 4); s += (v[i][0] + v[i][1]) + (v[i][2] + v[i][3]); }
    const float mean = wave_sum(s) * (1.0f / 1024.0f); float q = 0.f;
#pragma unroll
    for (int i = 0; i < 4; ++i) { v[i] -= mean; q += (v[i][0] * v[i][0] + v[i][1] * v[i][1]) + (v[i][2] * v[i][2] + v[i][3] * v[i][3]); }
    const float rstd = 1.0f / sqrtf(wave_sum(q) * (1.0f / 1024.0f) + 1e-5f);
#pragma unroll
    for (int i = 0; i < 4; ++i) { const f32x4 o = v[i] * rstd * gv[i] + bv[i];
      if (write_f32) *(f32x4*)(rp + i * 256 + lane * 4) = o;
      if (xb) { u32x2 w; w.x = cvt_pk_bf16(o[0], o[1]); w.y = cvt_pk_bf16(o[2], o[3]); *(u32x2*)(xb + (size_t)row * DM + i * 256 + lane * 4) = w; } }
  }
}

__device__ __forceinline__ void fast_barrier(unsigned* bar, unsigned target, int tid) {
  asm volatile("s_waitcnt vmcnt(0)" ::: "memory");
  __syncthreads();
  if (tid == 0) {
    __builtin_amdgcn_fence(__ATOMIC_RELEASE, "agent");
    asm volatile("s_waitcnt vmcnt(0)" ::: "memory");
    __hip_atomic_fetch_add(bar, 1u, __ATOMIC_RELAXED, __HIP_MEMORY_SCOPE_AGENT);
    while (__hip_atomic_load(bar, __ATOMIC_RELAXED, __HIP_MEMORY_SCOPE_AGENT) < target) __builtin_amdgcn_s_sleep(1);
    __builtin_amdgcn_fence(__ATOMIC_ACQUIRE, "agent");
    asm volatile("s_waitcnt vmcnt(0)" ::: "memory");
  }
  __syncthreads();
}

__global__ void __launch_bounds__(512, 2) fwd_mega(Params p) {
  extern __shared__ __attribute__((aligned(16))) unsigned char smem[];
  LAS unsigned char* lds = (LAS unsigned char*)smem;
  cg::grid_group grid = cg::this_grid();
  if (blockIdx.x == 0 && threadIdx.x == 64) __hip_atomic_store((unsigned*)(p.ws + O_PTAB + 512), 0u, __ATOMIC_RELAXED, __HIP_MEMORY_SCOPE_AGENT);
  for (int i = blockIdx.x * 512 + threadIdx.x; i < 4 * 320 * 64; i += gridDim.x * 512) ((unsigned*)(p.ws + O_CNT))[i] = 0u;
  const int wave_s = __builtin_amdgcn_readfirstlane((int)(threadIdx.x >> 6));
  unsigned nbar = 0;
  if (blockIdx.x == 0 && threadIdx.x < 43) {
    const float* v = (const float*)p.out;
    switch (threadIdx.x) {
      case 0: v = p.x_p; break;
      case 1: v = p.x_s; break;
      case 2: v = p.mem_p; break;
      case 3: v = p.mem_s; break;
      case 4: v = p.ln1_g; break;
      case 5: v = p.ln1_b; break;
      case 6: v = p.ffn1_wgu; break;
      case 7: v = p.ffn1_wd; break;
      case 8: v = p.w_in; break;
      case 9: v = p.b_gate; break;
      case 10: v = p.q_norm_g; break;
      case 11: v = p.w_uq; break;
      case 12: v = p.kv_norm_g; break;
      case 13: v = p.w_ukv; break;
      case 14: v = p.p_mla; break;
      case 15: v = p.mu_prev; break;
      case 16: v = p.mu_next; break;
      case 17: v = p.w0; break;
      case 18: v = p.w_up; break;
      case 19: v = p.a0; break;
      case 20: v = p.a_up; break;
      case 21: v = p.g_up; break;
      case 22: v = p.k_k; break;
      case 23: v = p.k_a; break;
      case 24: v = p.r_k; break;
      case 25: v = p.lnx_g; break;
      case 26: v = p.lnx_b; break;
      case 27: v = p.p_rwkv; break;
      case 28: v = p.w_o; break;
      case 29: v = p.ln2_g; break;
      case 30: v = p.ln2_b; break;
      case 31: v = p.mem_g; break;
      case 32: v = p.mem_b; break;
      case 33: v = p.w_cq; break;
      case 34: v = p.w_ckv; break;
      case 35: v = p.w_co; break;
      case 36: v = p.ln3_g; break;
      case 37: v = p.ln3_b; break;
      case 38: v = p.ffn2_wgu; break;
      case 39: v = p.ffn2_wd; break;
      case 40: v = p.ln4_g; break;
      case 41: v = p.ln4_b; break;
      default: break;
    }
    ((const float**)(p.ws + O_PTAB))[threadIdx.x] = v;
  }
  if (EN & 4) {
    unsigned char* ws = p.ws; const int tid = threadIdx.x, lane = tid & 63, wid = tid >> 6; const int gwave = blockIdx.x * 8 + wid, nwave = gridDim.x * 8;
    bf16_t* xb = (bf16_t*)(ws + O_XB); float* rope = (float*)(ws + O_ROPE);
  {
    int base = 0;
#define PREP_W(SRC, OFF, KS, KK, NN, LD, MODE) do { const WDesc d{SRC, (bf16_t*)(ws + OFF), KS, KK, NN, LD, MODE}; const int ntk = (KK) / 64, ntile = ntk * ((NN) / 64); \
      int first = ((int)blockIdx.x - base) % (int)gridDim.x; if (first < 0) first += gridDim.x; \
      for (int t = first; t < ntile; t += gridDim.x) prep_tile(d, t % ntk, t / ntk, p, (LAS float*)lds); \
      base = (base + ntile) % (int)gridDim.x; } while (0)
    PREP_W(p.ffn1_wgu, O_WGU1, nullptr, 1024, 5632, 5632, 1);
    PREP_W(p.ffn1_wd, O_WD1, nullptr, 2816, 1024, 1024, 0);
    PREP_W(p.ffn2_wgu, O_WGU2, nullptr, 1024, 5632, 5632, 1);
    PREP_W(p.ffn2_wd, O_WD2, nullptr, 2816, 1024, 1024, 0);
    PREP_W(p.w_in, O_WINQ, nullptr, 1024, 768, 4576, 2);
    PREP_W(p.w_in, O_WINR, nullptr, 1024, 2048, 4576, 3);
    PREP_W(p.w_in, O_WING, nullptr, 1024, 2048, 4576, 4);
    PREP_W(p.w_uq, O_WUQ, p.q_norm_g, 384, 768, 768, 5);
    PREP_W(p.w_ukv, O_WUKV, p.kv_norm_g, 256, 1024, 1024, 0);
    PREP_W(p.p_mla, O_PMLA, nullptr, 512, 1024, 1024, 0);
    PREP_W(p.p_rwkv, O_PRWKV, nullptr, 512, 1024, 1024, 0);
    PREP_W(p.w_o, O_WO, nullptr, 1024, 1024, 1024, 0);
    PREP_W(nullptr, O_WLORA, nullptr, 384, 2048, 0, 7);
    PREP_W(p.w_cq, O_WCQ, nullptr, 1024, 512, 512, 0);
    PREP_W(p.w_ckv, O_WCKV, nullptr, 1024, 1024, 1024, 0);
    PREP_W(p.w_co, O_WCO, nullptr, 512, 1024, 1024, 0);
#undef PREP_W
    for (size_t i = (size_t)blockIdx.x * 512 + tid; i < (size_t)T * DM / 8; i += (size_t)gridDim.x * 512) {
      const size_t e = i * 8; const float* src = (e < 65536ull * DM) ? p.x_p + e : p.x_s + (e - 65536ull * DM);
      const f32x4 a = *(const f32x4*)src, b = *(const f32x4*)(src + 4); const float f[8] = {a[0], a[1], a[2], a[3], b[0], b[1], b[2], b[3]};
      *(u32x4*)(xb + e) = pack8(f);
    }
    {
      bf16_t* memln = (bf16_t*)(ws + O_MEMLN);
      for (int row = gwave; row < 5120; row += nwave) {
        const float* rp = (row < 4096) ? p.mem_p + (size_t)row * DM : p.mem_s + (size_t)(row - 4096) * DM; f32x4 v[4]; float s = 0.f;
#pragma unroll
        for (int i = 0; i < 4; ++i) { v[i] = *(const f32x4*)(rp + i * 256 + lane * 4); s += (v[i][0] + v[i][1]) + (v[i][2] + v[i][3]); }
        const float mean = wave_sum(s) * (1.0f / 1024.0f); float q = 0.f;
#pragma unroll
        for (int i = 0; i < 4; ++i) { v[i] -= mean; q += (v[i][0] * v[i][0] + v[i][1] * v[i][1]) + (v[i][2] * v[i][2] + v[i][3] * v[i][3]); }
        const float rs = 1.0f / sqrtf(wave_sum(q) * (1.0f / 1024.0f) + 1e-5f);
#pragma unroll
        for (int i = 0; i < 4; ++i) { const f32x4 o = v[i] * rs * *(const f32x4*)(p.mem_g + i * 256 + lane * 4) + *(const f32x4*)(p.mem_b + i * 256 + lane * 4);
          u32x2 w; w.x = cvt_pk_bf16(o[0], o[1]); w.y = cvt_pk_bf16(o[2], o[3]); *(u32x2*)(memln + (size_t)row * DM + i * 256 + lane * 4) = w; }
      }
    }
    for (int i = blockIdx.x * 512 + tid; i < 4096 * 16; i += gridDim.x * 512) {
      const int s = i >> 4, j = i & 15; const float inv = 1.0f / powf(10000.0f, (float)(2 * j) / 32.0f); const float ang = (float)s * inv;
      rope[s * 32 + j] = cosf(ang); rope[s * 32 + 16 + j] = sinf(ang);
    }
  }
  }
  grid.sync();
#pragma nounroll
  for (int step = 1; step < 26; ++step) {
    unsigned char* ws = p.ws; asm volatile("" : "+s"(ws));
    unsigned zero_l = 0u; asm volatile("" : "+s"(zero_l));
    int tid = wave_s * 64 + (int)__builtin_amdgcn_mbcnt_hi(~0u, __builtin_amdgcn_mbcnt_lo(~0u, zero_l)); asm volatile("" : "+v"(tid));
    const int lane = tid & 63, wid = tid >> 6;
    const int gwave = blockIdx.x * 8 + wid, nwave = gridDim.x * 8;
    bf16_t* xb = (bf16_t*)(ws + O_XB);
    float* rope = (float*)(ws + O_ROPE);
    float* rstd = (float*)(ws + O_RSTD);
    PTab ptab = (PTab)(ws + O_PTAB);
    int kind = 0; bool sync = true; const float* lng = nullptr; const float* lnb = nullptr; bf16_t* lnxb = xb;
    switch (step) {
      case 1: kind = 1; sync = false; break;
      case 2: kind = 1; break;
      case 3: kind = 1; break;
      case 4: kind = 0; sync = false; break;
      case 5: kind = 1; sync = false; break;
      case 6: kind = 1; break;
      case 7: kind = 4; break;
      case 8: kind = 1; break;
      case 9: kind = 5; break;
      case 10: kind = 6; break;
      case 11: kind = 1; sync = false; break;
      case 12: kind = 1; sync = false; break;
      case 13: kind = 1; break;
      case 14: kind = 7; break;
      case 15: kind = 1; sync = false; break;
      case 16: kind = 1; break;
      case 17: kind = 1; break;
      case 18: kind = 0; sync = false; break;
      case 19: kind = 1; break;
      case 20: kind = 8; break;
      case 21: kind = 1; break;
      case 22: kind = 0; sync = false; break;
      case 23: kind = 1; break;
      case 24: kind = 1; break;
      default: kind = 0; sync = false; break;
    }
    if (step == 11 && (EN & 8)) {
      const bf16_t* __restrict__ hqkv = (const bf16_t*)(ws + O_HQKV); bf16_t* __restrict__ Kb = (bf16_t*)(ws + O_K);
      for (int it = blockIdx.x * 512 + tid; it < T * 4; it += gridDim.x * 512) {
        const int t = it >> 2, q = it & 3, s = t & 4095, b = t >> 12;
        const u32x2 w1 = *(const GAS u32x2*)(hqkv + (size_t)t * 768 + 640 + 4 * q), w2 = *(const GAS u32x2*)(hqkv + (size_t)t * 768 + 656 + 4 * q);
        const f32x4 c = *(const GAS f32x4*)(rope + s * 32 + 4 * q), sn = *(const GAS f32x4*)(rope + s * 32 + 16 + 4 * q);
        const f32x4 x1 = (f32x4){__uint_as_float(w1.x << 16), __uint_as_float(w1.x & 0xffff0000u), __uint_as_float(w1.y << 16), __uint_as_float(w1.y & 0xffff0000u)};
        const f32x4 x2 = (f32x4){__uint_as_float(w2.x << 16), __uint_as_float(w2.x & 0xffff0000u), __uint_as_float(w2.y << 16), __uint_as_float(w2.y & 0xffff0000u)};
        const f32x4 o1 = x1 * c - x2 * sn, o2 = x1 * sn + x2 * c;
        u32x4 w; w.x = cvt_pk_bf16(o1[0], o1[1]); w.y = cvt_pk_bf16(o1[2], o1[3]); w.z = cvt_pk_bf16(o2[0], o2[1]); w.w = cvt_pk_bf16(o2[2], o2[3]);
#pragma unroll
        for (int h = 0; h < 8; ++h) *(GAS u32x4*)(Kb + ((size_t)(b * 8 + h) * SEQ + s) * 96 + 64 + 8 * q) = w;
      }
    }
    if (kind == 1) { if (EN & 1) gemm_phase(lds, step, ptab, ws, tid); }
    else if (kind == 2) { if (EN & 2) ln_phase(((float*)PT(out)), lng, lnb, lnxb, true, tid); }
    else if (kind == 4 && (EN & 8)) {
  {
    const bf16_t* __restrict__ hr = (const bf16_t*)(ws + O_HR); const bf16_t* __restrict__ hqkv = (const bf16_t*)(ws + O_HQKV); bf16_t* __restrict__ lin = (bf16_t*)(ws + O_LIN);
    const float* __restrict__ mup = PT(mu_prev) + 1536; const float* __restrict__ mun = PT(mu_next) + 1536;
#pragma unroll 2
    for (int it = blockIdx.x * 512 + tid; it < T * 48; it += gridDim.x * 512) {
      const int t = it / 48, g = it - t * 48; u32x4 ow = (u32x4){0u, 0u, 0u, 0u};
      if (g < 40) {
        const int s = t & 4095; const bf16_t* hp = hr + (size_t)t * 1856 + 1536 + g * 8;
        float c[8], pv[8], nv[8], o[8]; unpack8(*(const u32x4*)hp, c);
        unpack8((s > 0) ? *(const GAS u32x4*)(hp - 1856) : (u32x4){0u, 0u, 0u, 0u}, pv); unpack8((s < 4095) ? *(const GAS u32x4*)(hp + 1856) : (u32x4){0u, 0u, 0u, 0u}, nv);
        const f32x4 mp0 = *(const GAS f32x4*)(mup + g * 8), mp1 = *(const GAS f32x4*)(mup + g * 8 + 4), mn0 = *(const GAS f32x4*)(mun + g * 8), mn1 = *(const GAS f32x4*)(mun + g * 8 + 4);
#pragma unroll
        for (int i = 0; i < 8; ++i) { const float m1 = i < 4 ? mp0[i & 3] : mp1[i & 3], m2 = i < 4 ? mn0[i & 3] : mn1[i & 3]; float v = c[i] + m1 * (pv[i] - c[i]) + m2 * (nv[i] - c[i]);
          if (g < 16) v = 1.0f - 2.0f / (1.0f + __expf(2.0f * v)); else if (g >= 24) v = sigmoidf_(v);
          o[i] = v; }
        ow = pack8(o);
      }
      *(GAS u32x4*)(lin + (size_t)t * 384 + g * 8) = ow;
    }
    for (int t4 = gwave; t4 < T / 4; t4 += nwave) {
      const int t = t4 * 4 + (lane >> 4), l16 = lane & 15; float sq = 0.f, skv = 0.f;
#pragma unroll
      for (int j = 0; j < 5; ++j) { const int k = j * 16 + l16; float f[8]; unpack8(*(const GAS u32x4*)(hqkv + (size_t)t * 768 + k * 8), f); float ss = 0.f;
#pragma unroll
        for (int i = 0; i < 8; ++i) ss += f[i] * f[i];
        if (k < 48) sq += ss; else skv += ss; }
      sq = row16_sum(sq); skv = row16_sum(skv);
      if (l16 == 0) { rstd[(size_t)t * 2] = 1.0f / sqrtf(sq * (1.0f / 384.0f) + 1e-6f); rstd[(size_t)t * 2 + 1] = 1.0f / sqrtf(skv * (1.0f / 256.0f) + 1e-6f); }
    }
  }
    } else if (kind == 5 && (EN & 16)) {
  {
    const bf16_t* hr = (const bf16_t*)(ws + O_HR); const bf16_t* lo = (const bf16_t*)(ws + O_LOUT); bf16_t* yb = (bf16_t*)(ws + O_Y);
    const int dir = tid >> 8, td = tid & 255;
    LAS float* Wl = (LAS float*)(lds + dir * 57344); LAS float* Al = Wl + 2048; LAS float* Bl = Wl + 4096; LAS float* Kl = Wl + 6144; LAS float* Rl = Wl + 8192; LAS float* Vl = Wl + 10240; LAS float* Yl = Wl + 12288;
    const int ptt = td >> 3, pc8 = td & 7;
    const int rq = td >> 3, cgp = td & 7;
    LAS float* Cst = (LAS float*)(lds + 2 * 57344 + 12288);
    LAS float* ybase = (cgp == 0) ? (Yl + 2 * rq) : ((LAS float*)(lds + 2 * 57344) + 2 * tid);
    for (int unit = blockIdx.x; unit < NBATCH * 8; unit += gridDim.x) {
      const int b = unit >> 3, h = unit & 7;
      {
        const int arr = tid >> 6, c = tid & 63;
        const float* src = arr < 3 ? PT(mu_prev) + arr * 512 + h * 64 + c : arr < 6 ? PT(mu_next) + (arr - 3) * 512 + h * 64 + c : arr == 6 ? PT(k_k) + h * 64 + c : PT(k_a) + h * 64 + c;
        Cst[arr * 64 + c] = *src;
      }
      __syncthreads();
      const bf16_t* hrb = hr + (size_t)b * SEQ * 1856 + h * 64 + pc8 * 8; const bf16_t* lob = lo + (size_t)b * SEQ * 2048 + h * 64 + pc8 * 8;
      f32x2 S[2][4];
#pragma unroll
      for (int r = 0; r < 2; ++r)
#pragma unroll
        for (int j = 0; j < 4; ++j) S[r][j] = (f32x2){0.f, 0.f};
      u32x4 ld_c[3], ld_p[3], ld_n[3], ld_w, ld_a;
#define SCAN_LOAD(nch) do { const int t0_ = dir ? SEQ - 32 * ((nch) + 1) : 32 * (nch); const int t_ = t0_ + ptt; const bf16_t* rp_ = hrb + (size_t)t_ * 1856; \
        _Pragma("unroll") for (int a_ = 0; a_ < 3; ++a_) { ld_c[a_] = *(const GAS u32x4*)(rp_ + a_ * 512); ld_p[a_] = (t_ > 0) ? *(const GAS u32x4*)(rp_ + a_ * 512 - 1856) : (u32x4){0u, 0u, 0u, 0u}; ld_n[a_] = (t_ < SEQ - 1) ? *(const GAS u32x4*)(rp_ + a_ * 512 + 1856) : (u32x4){0u, 0u, 0u, 0u}; } \
        ld_w = *(const GAS u32x4*)(lob + (size_t)t_ * 2048 + dir * 512); ld_a = *(const GAS u32x4*)(lob + (size_t)t_ * 2048 + 1024); } while (0)
      SCAN_LOAD(0);
      for (int nch = 0; nch < SEQ / 32; ++nch) {
        {
          float sh[3][8];
#pragma unroll
          for (int a = 0; a < 3; ++a) {
            float c[8], pv[8], nv[8]; unpack8(ld_c[a], c); unpack8(ld_p[a], pv); unpack8(ld_n[a], nv);
            const LAS float* mpp = Cst + a * 64 + pc8 * 8; const LAS float* mnp = Cst + (3 + a) * 64 + pc8 * 8;
#pragma unroll
            for (int i = 0; i < 8; ++i) sh[a][i] = c[i] + mpp[i] * (pv[i] - c[i]) + mnp[i] * (nv[i] - c[i]);
          }
          float lw[8], av[8]; unpack8(ld_w, lw); unpack8(ld_a, av);
          float kk[8], ss = 0.f;
#pragma unroll
          for (int i = 0; i < 8; ++i) { kk[i] = sh[1][i] * Cst[6 * 64 + pc8 * 8 + i]; ss += kk[i] * kk[i]; }
          ss = oct_sum(ss);
          const float inrm = 1.0f / fmaxf(sqrtf(ss), 1e-12f);
          float ow[8], oa[8], ob[8], ok[8];
#pragma unroll
          for (int i = 0; i < 8; ++i) { const float kn = kk[i] * inrm; ow[i] = __builtin_amdgcn_exp2f(lw[i]); oa[i] = -kn; ob[i] = kn * av[i]; ok[i] = sh[1][i] * (1.0f + (av[i] - 1.0f) * Cst[7 * 64 + pc8 * 8 + i]); }
          const int o = (dir ? 31 - ptt : ptt) * 64 + pc8 * 8;
          *(LAS f32x4*)(Wl + o) = (f32x4){ow[0], ow[1], ow[2], ow[3]}; *(LAS f32x4*)(Wl + o + 4) = (f32x4){ow[4], ow[5], ow[6], ow[7]};
          *(LAS f32x4*)(Al + o) = (f32x4){oa[0], oa[1], oa[2], oa[3]}; *(LAS f32x4*)(Al + o + 4) = (f32x4){oa[4], oa[5], oa[6], oa[7]};
          *(LAS f32x4*)(Bl + o) = (f32x4){ob[0], ob[1], ob[2], ob[3]}; *(LAS f32x4*)(Bl + o + 4) = (f32x4){ob[4], ob[5], ob[6], ob[7]};
          *(LAS f32x4*)(Kl + o) = (f32x4){ok[0], ok[1], ok[2], ok[3]}; *(LAS f32x4*)(Kl + o + 4) = (f32x4){ok[4], ok[5], ok[6], ok[7]};
          *(LAS f32x4*)(Rl + o) = (f32x4){sh[0][0], sh[0][1], sh[0][2], sh[0][3]}; *(LAS f32x4*)(Rl + o + 4) = (f32x4){sh[0][4], sh[0][5], sh[0][6], sh[0][7]};
          *(LAS f32x4*)(Vl + o) = (f32x4){sh[2][0], sh[2][1], sh[2][2], sh[2][3]}; *(LAS f32x4*)(Vl + o + 4) = (f32x4){sh[2][4], sh[2][5], sh[2][6], sh[2][7]};
        }
        __syncthreads();
        if (nch + 1 < SEQ / 32) SCAN_LOAD(nch + 1);
        {
          f32x4 opA[11], opB[11];
#define SC_LOAD(dst, st_) do { const int tt_ = (st_); const int o_ = tt_ * 64 + cgp * 8; \
            dst[0] = *(const LAS f32x4*)(Wl + o_); dst[1] = *(const LAS f32x4*)(Wl + o_ + 4); dst[2] = *(const LAS f32x4*)(Al + o_); dst[3] = *(const LAS f32x4*)(Al + o_ + 4); \
            dst[4] = *(const LAS f32x4*)(Bl + o_); dst[5] = *(const LAS f32x4*)(Bl + o_ + 4); dst[6] = *(const LAS f32x4*)(Kl + o_); dst[7] = *(const LAS f32x4*)(Kl + o_ + 4); \
            dst[8] = *(const LAS f32x4*)(Rl + o_); dst[9] = *(const LAS f32x4*)(Rl + o_ + 4); { const f32x2 v2_ = *(const LAS f32x2*)(Vl + tt_ * 64 + 2 * rq); dst[10] = (f32x4){v2_.x, v2_.y, 0.f, 0.f}; } } while (0)
#define SC_STEP(op, st_) do { const int tt_ = (st_); \
            f32x2 wv[4], av[4], bv[4], kv[4], rv[4]; \
            _Pragma("unroll") for (int i = 0; i < 2; ++i) { wv[2 * i] = (f32x2){op[i][0], op[i][1]}; wv[2 * i + 1] = (f32x2){op[i][2], op[i][3]}; av[2 * i] = (f32x2){op[2 + i][0], op[2 + i][1]}; av[2 * i + 1] = (f32x2){op[2 + i][2], op[2 + i][3]}; \
              bv[2 * i] = (f32x2){op[4 + i][0], op[4 + i][1]}; bv[2 * i + 1] = (f32x2){op[4 + i][2], op[4 + i][3]}; kv[2 * i] = (f32x2){op[6 + i][0], op[6 + i][1]}; kv[2 * i + 1] = (f32x2){op[6 + i][2], op[6 + i][3]}; \
              rv[2 * i] = (f32x2){op[8 + i][0], op[8 + i][1]}; rv[2 * i + 1] = (f32x2){op[8 + i][2], op[8 + i][3]}; } \
            float yo[2]; \
            _Pragma("unroll") for (int r = 0; r < 2; ++r) { \
              f32x2 c = S[r][0] * av[0]; c += S[r][1] * av[1]; c += S[r][2] * av[2]; c += S[r][3] * av[3]; \
              float sa = c.x + c.y; sa += dpp_f<0xB1>(sa); sa += dpp_f<0x4E>(sa); sa += dpp_f<0x141>(sa); \
              const f32x2 sav = (f32x2){sa, sa}, vv = (f32x2){op[10][r], op[10][r]}; \
              f32x2 y = (f32x2){0.f, 0.f}; \
              _Pragma("unroll") for (int j = 0; j < 4; ++j) { const f32x2 n = S[r][j] * wv[j] + (bv[j] * sav + kv[j] * vv); S[r][j] = n; y += n * rv[j]; } \
              float ys = y.x + y.y; ys += dpp_f<0xB1>(ys); ys += dpp_f<0x4E>(ys); ys += dpp_f<0x141>(ys); yo[r] = ys; } \
            *(LAS f32x2*)(ybase + tt_ * 64) = (f32x2){yo[0], yo[1]}; } while (0)
          SC_LOAD(opA, 0);
#pragma unroll 1
          for (int st = 0; st < 32; st += 8) {
#pragma unroll
            for (int u = 0; u < 8; u += 2) {
              asm volatile("" :: "v"(opA[10][0])); __builtin_amdgcn_sched_barrier(0);
              SC_LOAD(opB, st + u + 1); __builtin_amdgcn_sched_barrier(0);
              SC_STEP(opA, st + u); __builtin_amdgcn_sched_barrier(0);
              asm volatile("" :: "v"(opB[10][0])); __builtin_amdgcn_sched_barrier(0);
              SC_LOAD(opA, (st + u + 2) & 31); __builtin_amdgcn_sched_barrier(0);
              SC_STEP(opB, st + u + 1); __builtin_amdgcn_sched_barrier(0);
            }
          }
#undef SC_LOAD
#undef SC_STEP
        }
        __syncthreads();
        {
          const int t0 = dir ? SEQ - 32 * (nch + 1) : 32 * nch; const int ys = (dir ? 31 - ptt : ptt) * 64 + pc8 * 8; const f32x4 y0 = *(const LAS f32x4*)(Yl + ys), y1 = *(const LAS f32x4*)(Yl + ys + 4);
          const float f[8] = {y0[0], y0[1], y0[2], y0[3], y1[0], y1[1], y1[2], y1[3]};
          *(GAS u32x4*)(yb + ((size_t)dir * T + (size_t)b * SEQ + t0 + ptt) * 512 + h * 64 + pc8 * 8) = pack8(f);
        }
      }
#undef SCAN_LOAD
      __syncthreads();
    }
  }
    } else if (kind == 6 && (EN & 32)) {
  {
    const bf16_t* __restrict__ hr = (const bf16_t*)(ws + O_HR); const bf16_t* __restrict__ lo = (const bf16_t*)(ws + O_LOUT); const bf16_t* __restrict__ yb = (const bf16_t*)(ws + O_Y); bf16_t* __restrict__ bout = (bf16_t*)(ws + O_BOUT);
    const int c0 = lane * 8;
    float mpv[3][8], mnv[3][8], kav[8], rkv[8], lgv[8], lbv[8];
#pragma unroll
    for (int i = 0; i < 8; ++i) {
#pragma unroll
      for (int a = 0; a < 3; ++a) { mpv[a][i] = PT(mu_prev)[a * 512 + c0 + i]; mnv[a][i] = PT(mu_next)[a * 512 + c0 + i]; }
      kav[i] = PT(k_a)[c0 + i]; rkv[i] = PT(r_k)[c0 + i]; lgv[i] = PT(lnx_g)[c0 + i]; lbv[i] = PT(lnx_b)[c0 + i]; }
#pragma unroll 2
    for (int t = gwave; t < T; t += nwave) {
      const int s = t & 4095;
      float sh[3][8];
#pragma unroll
      for (int a = 0; a < 3; ++a) {
        const bf16_t* rp = hr + (size_t)t * 1856 + a * 512 + c0; float c[8], pv[8], nv[8]; unpack8(*(const u32x4*)rp, c);
        if (s > 0) unpack8(*(const GAS u32x4*)(rp - 1856), pv); else {
#pragma unroll
          for (int i = 0; i < 8; ++i) pv[i] = 0.f; }
        if (s < 4095) unpack8(*(const GAS u32x4*)(rp + 1856), nv); else {
#pragma unroll
          for (int i = 0; i < 8; ++i) nv[i] = 0.f; }
#pragma unroll
        for (int i = 0; i < 8; ++i) sh[a][i] = c[i] + mpv[a][i] * (pv[i] - c[i]) + mnv[a][i] * (nv[i] - c[i]);
      }
      float av[8], gv[8], yf[8], ybk[8];
      unpack8(*(const GAS u32x4*)(lo + (size_t)t * 2048 + 1024 + c0), av); unpack8(*(const GAS u32x4*)(lo + (size_t)t * 2048 + 1536 + c0), gv);
      unpack8(*(const GAS u32x4*)(yb + (size_t)t * 512 + c0), yf); unpack8(*(const GAS u32x4*)(yb + ((size_t)T + t) * 512 + c0), ybk);
      float y[8], sy = 0.f, sb = 0.f;
#pragma unroll
      for (int i = 0; i < 8; ++i) { y[i] = yf[i] + ybk[i]; sy += y[i]; const float km = sh[1][i] * (1.0f + (av[i] - 1.0f) * kav[i]); sb += sh[0][i] * km * rkv[i]; }
      sy = oct_sum(sy); sb = oct_sum(sb);
      const float mu = sy * (1.0f / 64.0f); float sv = 0.f;
#pragma unroll
      for (int i = 0; i < 8; ++i) { y[i] -= mu; sv += y[i] * y[i]; }
      sv = oct_sum(sv);
      const float rs = 1.0f / sqrtf(sv * (1.0f / 64.0f) + 64e-5f);
      float o[8];
#pragma unroll
      for (int i = 0; i < 8; ++i) o[i] = ((y[i] * rs) * lgv[i] + lbv[i] + sb * sh[2][i]) * gv[i];
      *(GAS u32x4*)(bout + (size_t)t * 512 + c0) = pack8(o);
    }
  }
    } else if (kind == 7 && (EN & 64)) {
  {
    const bf16_t* Q = (const bf16_t*)(ws + O_Q); const bf16_t* K = (const bf16_t*)(ws + O_K); const bf16_t* Vt = (const bf16_t*)(ws + O_VT); bf16_t* ao = (bf16_t*)(ws + O_AOUT);
    for (int unit = blockIdx.x; unit < NBATCH * 8 * 16; unit += gridDim.x) {
      const int qb = unit & 15, bh = unit >> 4, b = bh >> 3, h = bh & 7;
      attn_unit_pp<96, 64>(Q + ((size_t)bh * SEQ + qb * 256) * 96, 96, K + (size_t)bh * SEQ * 96, 96, Vt + (size_t)bh * 64 * SEQ, SEQ, SEQ, ao + ((size_t)b * SEQ + qb * 256) * 512 + h * 64, 512, lds, tid);
    }
  }
    } else if (kind == 8 && (EN & 128)) {
  {
    const bf16_t* cq = (const bf16_t*)(ws + O_CQ); const bf16_t* Kc = (const bf16_t*)(ws + O_KC); const bf16_t* VcT = (const bf16_t*)(ws + O_VCT); bf16_t* co = (bf16_t*)(ws + O_CO);
    for (int unit = blockIdx.x; unit < (T / 256) * 4; unit += gridDim.x) {
      const int h = unit & 3, rb = unit >> 2, b = rb >> 4;
      attn_unit<128, 128, false>(cq + (size_t)rb * 256 * 512 + h * 128, 512, Kc + (size_t)b * 256 * 512 + h * 128, 512, VcT + (size_t)(b * 4 + h) * 128 * 256, 256, 256, co + (size_t)rb * 256 * 512 + h * 128, 512, lds, tid);
    }
  }
    }
    if (sync && step != 25) { ++nbar; fast_barrier((unsigned*)(p.ws + O_PTAB + 512), nbar * gridDim.x, tid); }
  }
}

extern "C" void kernel_launch(void* const* d_in, const int* in_sizes, int n_in, void* d_out, int out_size, void* d_ws, size_t ws_size, hipStream_t stream) {
  static int grid_blocks = 0;
  if (!grid_blocks) {
    int dev = 0, cus = 0, per_cu = 0;
    (void)hipGetDevice(&dev);
    (void)hipDeviceGetAttribute(&cus, hipDeviceAttributeMultiprocessorCount, dev);
    (void)hipFuncSetAttribute((const void*)fwd_mega, hipFuncAttributeMaxDynamicSharedMemorySize, LDS_BYTES);
    (void)hipOccupancyMaxActiveBlocksPerMultiprocessor(&per_cu, fwd_mega, 512, LDS_BYTES);
    if (per_cu < 1) per_cu = 1;
    grid_blocks = cus * per_cu;
    if (grid_blocks > 256) grid_blocks = 256;
  }
  Params p{};
  const float** pp = (const float**)&p;
  for (int i = 0; i < 42; ++i) pp[i] = (const float*)d_in[i];
  p.out = (float*)d_out; p.ws = (unsigned char*)d_ws;
  void* args[] = {&p};
  hipError_t e = hipLaunchCooperativeKernel((void*)fwd_mega, dim3(grid_blocks), dim3(512), args, LDS_BYTES, stream);
  if (e != hipSuccess) fprintf(stderr, "cooperative launch failed: %s (grid %d)\n", hipGetErrorString(e), grid_blocks);
}
```

```cpp
#include <hip/hip_runtime.h>
#include <hip/hip_cooperative_groups.h>
#include <cstdio>
namespace cg = cooperative_groups;

#define LAS __attribute__((address_space(3)))
#define GAS __attribute__((address_space(1)))
#define ASSUME_GLOBAL(p) do { (p) = (unsigned char*)(__attribute__((address_space(1))) unsigned char*)(p); } while (0)
typedef unsigned short bf16_t;
typedef short bf16x8 __attribute__((ext_vector_type(8)));
typedef float f32x4 __attribute__((ext_vector_type(4)));
typedef float f32x2 __attribute__((ext_vector_type(2)));
typedef unsigned u32x4 __attribute__((ext_vector_type(4)));
typedef unsigned u32x2 __attribute__((ext_vector_type(2)));

constexpr int T = 81920, SEQ = 4096, NBATCH = 20, DM = 1024, DFF = 2816;
constexpr float ALPHA = 1.189207115002721f;
constexpr float LOG2E = 1.4426950408889634f;
constexpr float QSCALE = 0.10206207261596577f * LOG2E;
constexpr float CQSCALE = 0.08838834764831845f * LOG2E;
constexpr int LDS_BYTES = 142 * 1024;
#ifndef EN
#define EN 255
#endif
#ifndef LNX
#define LNX 0
#endif

constexpr size_t al256(size_t x) { return (x + 255) & ~(size_t)255; }
constexpr size_t O_WGU1 = 0;
constexpr size_t O_WD1 = O_WGU1 + 5632ull * 1024 * 2;
constexpr size_t O_WGU2 = O_WD1 + 1024ull * 2816 * 2;
constexpr size_t O_WD2 = O_WGU2 + 5632ull * 1024 * 2;
constexpr size_t O_WINQ = O_WD2 + 1024ull * 2816 * 2;
constexpr size_t O_WINR = O_WINQ + 768ull * 1024 * 2;
constexpr size_t O_WING = O_WINR + 2048ull * 1024 * 2;
constexpr size_t O_WUQ = O_WING + 2048ull * 1024 * 2;
constexpr size_t O_WUKV = O_WUQ + 768ull * 384 * 2;
constexpr size_t O_PMLA = O_WUKV + 1024ull * 256 * 2;
constexpr size_t O_PRWKV = O_PMLA + 1024ull * 512 * 2;
constexpr size_t O_WO = O_PRWKV + 1024ull * 512 * 2;
constexpr size_t O_WLORA = O_WO + 1024ull * 1024 * 2;
constexpr size_t O_WCQ = O_WLORA + 2048ull * 384 * 2;
constexpr size_t O_WCKV = O_WCQ + 512ull * 1024 * 2;
constexpr size_t O_WCO = O_WCKV + 1024ull * 1024 * 2;
constexpr size_t O_ROPE = O_WCO + 1024ull * 512 * 2;
constexpr size_t O_RSTD = O_ROPE + 4096ull * 32 * 4;
constexpr size_t O_MEMLN = O_RSTD + (size_t)T * 2 * 4;
constexpr size_t O_KC = O_MEMLN + 5120ull * 1024 * 2;
constexpr size_t O_VCT = O_KC + 5120ull * 512 * 2;
constexpr size_t O_PTAB = O_VCT + 5120ull * 512 * 2;
constexpr size_t O_XCH = O_PTAB + 1024;
constexpr size_t O_CNT = O_XCH + (size_t)T * 4 * 8;
constexpr size_t O_XB = O_CNT + 4ull * 320 * 256;
constexpr size_t O_ARENA = O_XB + (size_t)T * 1024 * 2;
constexpr size_t O_HR = O_ARENA;
constexpr size_t O_LOUT = O_HR + (size_t)T * 1856 * 2;
constexpr size_t O_LIN = O_LOUT + (size_t)T * 2048 * 2;
constexpr size_t O_Y = O_LIN + (size_t)T * 384 * 2;
constexpr size_t O_BOUT = O_Y + 2ull * T * 512 * 2;
constexpr size_t O_HQKV = O_BOUT + (size_t)T * 512 * 2;
constexpr size_t O_END = O_HQKV + (size_t)T * 768 * 2;
static_assert(O_END <= 1342177280ull, "workspace");
constexpr size_t O_GATES = O_ARENA;
constexpr size_t O_Q = O_GATES + (size_t)T * 2048 * 2;
constexpr size_t O_K = O_Q + (size_t)T * 768 * 2;
constexpr size_t O_VT = O_K + (size_t)T * 768 * 2;
constexpr size_t O_AOUT = O_VT + (size_t)T * 512 * 2;
static_assert(O_AOUT + (size_t)T * 512 * 2 <= O_BOUT, "overlap");
constexpr size_t O_MIX = O_Q;
static_assert(O_MIX + (size_t)T * 1024 * 2 <= O_AOUT, "overlap");
constexpr size_t O_CQ = O_ARENA;
constexpr size_t O_CO = O_CQ + (size_t)T * 512 * 2;
constexpr size_t O_HFF = O_ARENA;

struct Params {
  const float *x_p, *x_s, *mem_p, *mem_s;
  const float *ln1_g, *ln1_b, *ffn1_wgu, *ffn1_wd, *w_in, *b_gate, *q_norm_g, *w_uq, *kv_norm_g, *w_ukv, *p_mla, *mu_prev, *mu_next, *w0, *w_up, *a0, *a_up, *g_up,
      *k_k, *k_a, *r_k, *lnx_g, *lnx_b, *p_rwkv, *w_o, *ln2_g, *ln2_b, *mem_g, *mem_b, *w_cq, *w_ckv, *w_co, *ln3_g, *ln3_b, *ffn2_wgu, *ffn2_wd, *ln4_g, *ln4_b;
  float* out; unsigned char* ws;
};

enum { I_x_p, I_x_s, I_mem_p, I_mem_s, I_ln1_g, I_ln1_b, I_ffn1_wgu, I_ffn1_wd, I_w_in, I_b_gate, I_q_norm_g, I_w_uq, I_kv_norm_g, I_w_ukv, I_p_mla, I_mu_prev, I_mu_next, I_w0, I_w_up, I_a0, I_a_up, I_g_up, I_k_k, I_k_a, I_r_k, I_lnx_g, I_lnx_b, I_p_rwkv, I_w_o, I_ln2_g, I_ln2_b, I_mem_g, I_mem_b, I_w_cq, I_w_ckv, I_w_co, I_ln3_g, I_ln3_b, I_ffn2_wgu, I_ffn2_wd, I_ln4_g, I_ln4_b, I_out };
#define PT(name) (ptab[I_##name])
typedef const float* const* PTab;
__device__ __forceinline__ float bf2f(bf16_t b) { return __uint_as_float(((unsigned)b) << 16); }
__device__ __forceinline__ unsigned cvt_pk_bf16(float lo, float hi) { unsigned r; asm("v_cvt_pk_bf16_f32 %0, %1, %2" : "=v"(r) : "v"(lo), "v"(hi)); return r; }
__device__ __forceinline__ bf16_t f2bf(float f) { return (bf16_t)(cvt_pk_bf16(f, 0.f) & 0xffffu); }
__device__ __forceinline__ void unpack8(const u32x4 w, float* f) {
#pragma unroll
  for (int i = 0; i < 4; ++i) { f[2 * i] = __uint_as_float(w[i] << 16); f[2 * i + 1] = __uint_as_float(w[i] & 0xffff0000u); }
}
__device__ __forceinline__ u32x4 pack8(const float* f) { u32x4 w; w.x = cvt_pk_bf16(f[0], f[1]); w.y = cvt_pk_bf16(f[2], f[3]); w.z = cvt_pk_bf16(f[4], f[5]); w.w = cvt_pk_bf16(f[6], f[7]); return w; }
__device__ __forceinline__ float sigmoidf_(float x) { return 1.0f / (1.0f + __expf(-x)); }
template <int CTRL> __device__ __forceinline__ float dpp_f(float x) { return __builtin_bit_cast(float, __builtin_amdgcn_update_dpp(0, __builtin_bit_cast(int, x), CTRL, 0xf, 0xf, true)); }
__device__ __forceinline__ float quad_sum(float v) { v += dpp_f<0xB1>(v); v += dpp_f<0x4E>(v); return v; }
__device__ __forceinline__ float oct_sum(float v) { v += dpp_f<0xB1>(v); v += dpp_f<0x4E>(v); v += dpp_f<0x141>(v); return v; }
__device__ __forceinline__ float row16_sum(float v) { v = oct_sum(v); v += dpp_f<0x140>(v); return v; }

__device__ __forceinline__ float xrow16_max(float x) {
  auto s = __builtin_amdgcn_permlane16_swap(__float_as_uint(x), __float_as_uint(x), false, false);
  x = fmaxf(__uint_as_float(s[0]), __uint_as_float(s[1]));
  auto t = __builtin_amdgcn_permlane32_swap(__float_as_uint(x), __float_as_uint(x), false, false);
  return fmaxf(__uint_as_float(t[0]), __uint_as_float(t[1]));
}
__device__ __forceinline__ float xrow16_sum(float x) {
  auto s = __builtin_amdgcn_permlane16_swap(__float_as_uint(x), __float_as_uint(x), false, false);
  x = __uint_as_float(s[0]) + __uint_as_float(s[1]);
  auto t = __builtin_amdgcn_permlane32_swap(__float_as_uint(x), __float_as_uint(x), false, false);
  return __uint_as_float(t[0]) + __uint_as_float(t[1]);
}
__device__ __forceinline__ float wave_sum(float v) { return xrow16_sum(row16_sum(v)); }
constexpr int BM = 256, BK = 64, HALF = 128, HTB = HALF * BK * 2, STAGE_BYTES = 8 * HTB, NXCD = 8, WGM = 8;
__device__ __forceinline__ int lds_byte(int r, int c) { const int st = (r >> 4) * 2 + (c >> 5), rr = r & 15, cc = c & 31, ob = rr * 64 + cc * 2; return st * 1024 + (ob ^ (((ob >> 9) & 1) << 5)); }
__device__ __forceinline__ void stage_rc(int b, int& R, int& C) { const int st = b / 1024, sb = b % 1024, swz = sb ^ (((sb >> 9) & 1) << 5); R = (st >> 1) * 16 + swz / 64; C = (st & 1) * 32 + (swz % 64) / 2; }
__device__ __forceinline__ int perm32(int rho) { const int n = rho >> 4, i = rho & 15; return 8 * (i >> 2) + 4 * n + (i & 3); }
struct Unit { int pm, pn; };
struct Gemm { const bf16_t* A; const bf16_t* Bt; int M, N, K, lda, ldb; };
struct StaticOrder {
  int nM, nN, nwg, G, c;
  __device__ void init(int M, int N, int G_, int c_) { nM = M / BM; nN = N / BM; nwg = nM * nN; G = G_; c = c_; }
  __device__ bool next(int i, Unit& u) const {
    const long L = (long)i * G + c; if (L >= nwg) return false;
    int wgid = (int)L; { const int q = nwg / NXCD, r = nwg % NXCD, xcd = wgid % NXCD, off = wgid / NXCD; wgid = (xcd < r ? xcd * (q + 1) : r * (q + 1) + (xcd - r) * q) + off; }
    const int nig = WGM * nN, gid = wgid / nig, fm = gid * WGM, gsz = (nM - fm) < WGM ? (nM - fm) : WGM;
    u.pm = fm + ((wgid % nig) % gsz); u.pn = (wgid % nig) / gsz; return true;
  }
};

typedef f32x4 Acc[2][2][4][2];

struct EpiSwiglu {
  static constexpr bool PERM = true;
  bf16_t* H;
  __device__ __forceinline__ void operator()(const Acc& acc, const Unit& u, int wr, int wc, int fr, int fq) const {
    const int col0 = u.pn * 128 + wc * 32 + 8 * fq;
#pragma unroll
    for (int ai = 0; ai < 2; ++ai)
#pragma unroll
      for (int m = 0; m < 4; ++m) {
        const int row = u.pm * BM + ai * HALF + wr * 64 + m * 16 + fr;
        float o[8];
#pragma unroll
        for (int n = 0; n < 2; ++n)
#pragma unroll
          for (int j = 0; j < 4; ++j) { const float gte = acc[ai][0][m][n][j], up = acc[ai][1][m][n][j]; o[n * 4 + j] = gte * up / (1.0f + __expf(-gte)); }
        *(GAS u32x4*)(H + (size_t)row * DFF + col0) = pack8(o);
      }
  }
};

__device__ __forceinline__ f32x4 sig4(f32x4 v) { f32x4 o; o[0] = sigmoidf_(v[0]); o[1] = sigmoidf_(v[1]); o[2] = sigmoidf_(v[2]); o[3] = sigmoidf_(v[3]); return o; }
__device__ __forceinline__ float dec1(float x) { return -(0.6065306597126334f * LOG2E) / (1.0f + __expf(-x)); }
__device__ __forceinline__ f32x4 dec4(f32x4 v) { f32x4 o; o[0] = dec1(v[0]); o[1] = dec1(v[1]); o[2] = dec1(v[2]); o[3] = dec1(v[3]); return o; }
template <int ACT>
struct EpiBf16 {
  static constexpr bool PERM = true;
  bf16_t* O; int ldc; int ncols; float scale; const float* bias; const float* w0; const float* a0;
  __device__ __forceinline__ void operator()(const Acc& acc, const Unit& u, int wr, int wc, int fr, int fq) const {
#pragma unroll
    for (int bj = 0; bj < 2; ++bj) {
      const int c0 = u.pn * BM + bj * HALF + wc * 32 + 8 * fq;
      const bool active = c0 < ncols;
      f32x4 b0 = (f32x4){0.f, 0.f, 0.f, 0.f}, b1 = (f32x4){0.f, 0.f, 0.f, 0.f};
      if (ACT == 1) { b0 = *(const GAS f32x4*)(bias + c0); b1 = *(const GAS f32x4*)(bias + c0 + 4); }
      if (ACT == 2) { if (u.pn < 6) { const float* src = (u.pn < 4) ? (w0 + c0) : (a0 + (c0 - 1024)); b0 = *(const GAS f32x4*)(src); b1 = *(const GAS f32x4*)(src + 4); } }
#pragma unroll
      for (int ai = 0; ai < 2; ++ai)
#pragma unroll
        for (int m = 0; m < 4; ++m) {
          const int row = u.pm * BM + ai * HALF + wr * 64 + m * 16 + fr;
          f32x4 v0 = acc[ai][bj][m][0], v1 = acc[ai][bj][m][1];
          if (ACT == 0) { v0 *= scale; v1 *= scale; }
          if (ACT == 1) { v0 = sig4(v0 + b0); v1 = sig4(v1 + b1); }
          if (ACT == 2) { if (u.pn < 4) { v0 = dec4(v0 + b0); v1 = dec4(v1 + b1); } else if (u.pn < 6) { v0 = sig4(v0 + b0); v1 = sig4(v1 + b1); } }
          u32x4 w; w.x = cvt_pk_bf16(v0[0], v0[1]); w.y = cvt_pk_bf16(v0[2], v0[3]); w.z = cvt_pk_bf16(v1[0], v1[1]); w.w = cvt_pk_bf16(v1[2], v1[3]);
          if (active) *(GAS u32x4*)(O + (size_t)row * ldc + c0) = w;
        }
    }
  }
};

struct EpiTrunk {
  static constexpr bool PERM = false;
  const float* base_p; const float* base_s; float* out; float scale;
  __device__ __forceinline__ void operator()(const Acc& acc, const Unit& u, int wr, int wc, int fr, int fq) const {
    const int col0 = u.pn * BM + wc * 32 + 4 * fq;
#pragma unroll
    for (int ai = 0; ai < 2; ++ai)
#pragma unroll
      for (int m = 0; m < 4; ++m) {
        const int row = u.pm * BM + ai * HALF + wr * 64 + m * 16 + fr;
        const float* bp = (base_s && row >= 65536) ? base_s + (size_t)(row - 65536) * DM : base_p + (size_t)row * DM;
        float* op = out + (size_t)row * DM;
#pragma unroll
        for (int bj = 0; bj < 2; ++bj)
#pragma unroll
          for (int n = 0; n < 2; ++n) { const int c = col0 + bj * HALF + n * 16; const f32x4 bs = *(const GAS f32x4*)(bp + c); *(GAS f32x4*)(op + c) = bs * ALPHA + acc[ai][bj][m][n] * scale; }
        asm volatile("" ::: "memory");
      }
  }
};

struct EpiTrunkLN {
  const float* base_p; const float* base_s; float* out; bf16_t* xb; const float* lg; const float* lb; unsigned long long* X; unsigned* cnt; float scale; LAS unsigned char* lds;
  __device__ __forceinline__ void operator()(const Acc& acc, const Unit& u, int wr, int wc, int fr, int fq) const {
    LAS f32x2* P = (LAS f32x2*)(lds + 131072);
    LAS f32x2* St = (LAS f32x2*)(lds + 131072 + 8192);
    const int col0 = u.pn * BM + wc * 32 + 8 * fq; const int wid = wr * 4 + wc, lane = fq * 16 + fr;
    const float* ubase = (base_s && u.pm >= 256) ? base_s + (size_t)(u.pm - 256) * BM * DM : base_p + (size_t)u.pm * BM * DM;
    float* uout = out + (size_t)u.pm * BM * DM; bf16_t* uxb = xb ? xb + (size_t)u.pm * BM * DM : nullptr;
#define LN_LOADB(dst, aim_) do { _Pragma("unroll") for (int mm = 0; mm < 2; ++mm) _Pragma("unroll") for (int bj = 0; bj < 2; ++bj) _Pragma("unroll") for (int n = 0; n < 2; ++n) \
      dst[mm][bj][n] = *(const GAS f32x4*)(ubase + ((((aim_) >> 1) * HALF + wr * 64 + ((((aim_) & 1) * 2) + mm) * 16 + fr) * DM + col0 + bj * HALF + n * 4)); } while (0)
#define LN_SUMB(src, aim_) do { _Pragma("unroll") for (int mm = 0; mm < 2; ++mm) { const int ai = (aim_) >> 1, m = ((aim_) & 1) * 2 + mm; const int rl = ai * HALF + wr * 64 + m * 16 + fr; float sm = 0.f, sq = 0.f; \
      _Pragma("unroll") for (int bj = 0; bj < 2; ++bj) _Pragma("unroll") for (int n = 0; n < 2; ++n) { const f32x4 v = src[mm][bj][n] * ALPHA + acc[ai][bj][m][n] * scale; \
        sm += (v[0] + v[1]) + (v[2] + v[3]); sq += (v[0] * v[0] + v[1] * v[1]) + (v[2] * v[2] + v[3] * v[3]); } \
      sm = xrow16_sum(sm); sq = xrow16_sum(sq); if (fq == 0) P[rl * 4 + wc] = (f32x2){sm, sq}; } } while (0)
    {
      f32x4 bA[2][2][2], bB[2][2][2];
      LN_LOADB(bA, 0); LN_LOADB(bB, 1); asm volatile("" ::: "memory");
      LN_SUMB(bA, 0); LN_SUMB(bB, 1); asm volatile("" ::: "memory");
      LN_LOADB(bA, 2); LN_LOADB(bB, 3); asm volatile("" ::: "memory");
      LN_SUMB(bA, 2); LN_SUMB(bB, 3);
    }
    asm volatile("s_waitcnt lgkmcnt(0)" ::: "memory"); __builtin_amdgcn_s_barrier(); __builtin_amdgcn_s_barrier(); asm volatile("" ::: "memory");
    const int rl2 = wid * 32 + (lane & 31);
    if (lane < 32) {
      const f32x2 a = P[rl2 * 4 + 0], b = P[rl2 * 4 + 1], c = P[rl2 * 4 + 2], d = P[rl2 * 4 + 3];
      const float s4 = (a.x + b.x) + (c.x + d.x), q4 = (a.y + b.y) + (c.y + d.y);
      __hip_atomic_store(X + ((size_t)(u.pm * BM + rl2) * 4 + u.pn), ((unsigned long long)__float_as_uint(q4) << 32) | __float_as_uint(s4), __ATOMIC_RELAXED, __HIP_MEMORY_SCOPE_AGENT);
    }
    asm volatile("s_waitcnt vmcnt(0)" ::: "memory");
    if (lane == 0) __hip_atomic_fetch_add(cnt + 64 * u.pm, 1u, __ATOMIC_RELAXED, __HIP_MEMORY_SCOPE_AGENT);
    __builtin_amdgcn_s_barrier();
    f32x4 pA[2][2][2], pB[2][2][2];
    LN_LOADB(pA, 0); LN_LOADB(pB, 1);
    while ((unsigned)__builtin_amdgcn_readfirstlane((int)__hip_atomic_load(cnt + 64 * u.pm, __ATOMIC_RELAXED, __HIP_MEMORY_SCOPE_AGENT)) < 32u) __builtin_amdgcn_s_sleep(1);
    __builtin_amdgcn_fence(__ATOMIC_ACQUIRE, "agent");
    if (lane < 32) {
      const unsigned long long* sl = X + (size_t)(u.pm * BM + rl2) * 4; float S = 0.f, Q = 0.f;
#pragma unroll
      for (int t = 0; t < 4; ++t) { const unsigned long long w = __hip_atomic_load(sl + t, __ATOMIC_RELAXED, __HIP_MEMORY_SCOPE_AGENT); S += __uint_as_float((unsigned)w); Q += __uint_as_float((unsigned)(w >> 32)); }
      const float mean = S * (1.0f / 1024.0f); const float var = fmaxf(Q * (1.0f / 1024.0f) - mean * mean, 0.f);
      St[rl2] = (f32x2){mean, 1.0f / sqrtf(var + 1e-5f)};
    }
    asm volatile("s_waitcnt vmcnt(0) lgkmcnt(0)" ::: "memory"); __builtin_amdgcn_s_barrier(); __builtin_amdgcn_s_barrier(); asm volatile("" ::: "memory");
    float scale2 = scale; asm volatile("" : "+s"(scale2));
#define LN_APPLYB(src, aim_) do { _Pragma("unroll") for (int mm = 0; mm < 2; ++mm) { const int ai = (aim_) >> 1, m = ((aim_) & 1) * 2 + mm; const int rl = ai * HALF + wr * 64 + m * 16 + fr; const int off = rl * DM + col0; const f32x2 sr = St[rl]; \
      _Pragma("unroll") for (int bj = 0; bj < 2; ++bj) { f32x4 o2[2]; \
        _Pragma("unroll") for (int n = 0; n < 2; ++n) { const f32x4 v = src[mm][bj][n] * ALPHA + acc[ai][bj][m][n] * scale2; o2[n] = (v - sr.x) * sr.y * *(const GAS f32x4*)(lg + col0 + bj * HALF + n * 4) + *(const GAS f32x4*)(lb + col0 + bj * HALF + n * 4); \
          *(GAS f32x4*)(uout + (off + bj * HALF + n * 4)) = o2[n]; } \
        if (uxb) { u32x4 w; w.x = cvt_pk_bf16(o2[0][0], o2[0][1]); w.y = cvt_pk_bf16(o2[0][2], o2[0][3]); w.z = cvt_pk_bf16(o2[1][0], o2[1][1]); w.w = cvt_pk_bf16(o2[1][2], o2[1][3]); *(GAS u32x4*)(uxb + (off + bj * HALF)) = w; } } } } while (0)
    {
      asm volatile("" ::: "memory");
      LN_APPLYB(pA, 0); LN_APPLYB(pB, 1); asm volatile("" ::: "memory");
      LN_LOADB(pA, 2); LN_LOADB(pB, 3); asm volatile("" ::: "memory");
      LN_APPLYB(pA, 2); LN_APPLYB(pB, 3);
    }
#undef LN_LOADB
#undef LN_SUMB
#undef LN_APPLYB
  }
};

struct EpiQ {
  static constexpr bool PERM = true;
  bf16_t* Q; const float* rstd; const float* rope;
  __device__ __forceinline__ void operator()(const Acc& acc, const Unit& u, int wr, int wc, int fr, int fq) const {
    float rsv[2][4];
#pragma unroll
    for (int ai = 0; ai < 2; ++ai)
#pragma unroll
      for (int m = 0; m < 4; ++m) rsv[ai][m] = ((const GAS float*)rstd)[(size_t)(u.pm * BM + ai * HALF + wr * 64 + m * 16 + fr) * 2];
#pragma unroll
    for (int ai = 0; ai < 2; ++ai)
#pragma unroll
      for (int m = 0; m < 4; ++m) {
        const int row = u.pm * BM + ai * HALF + wr * 64 + m * 16 + fr; const int b = row >> 12, s = row & 4095;
        const float rs = rsv[ai][m] * QSCALE;
#pragma unroll
        for (int bj = 0; bj < 2; ++bj) {
          const int G = 8 * u.pn + 4 * bj + wc; const int h = G / 3, part = G - 3 * h;
          f32x4 v0 = acc[ai][bj][m][0] * rs, v1 = acc[ai][bj][m][1] * rs;
          if (part == 2) { const f32x4 c = *(const GAS f32x4*)(rope + s * 32 + 4 * fq), sn = *(const GAS f32x4*)(rope + s * 32 + 16 + 4 * fq);
            const f32x4 o0 = v0 * c - v1 * sn, o1 = v0 * sn + v1 * c; v0 = o0; v1 = o1; }
          u32x4 w; w.x = cvt_pk_bf16(v0[0], v0[1]); w.y = cvt_pk_bf16(v0[2], v0[3]); w.z = cvt_pk_bf16(v1[0], v1[1]); w.w = cvt_pk_bf16(v1[2], v1[3]);
          *(GAS u32x4*)(Q + ((size_t)(b * 8 + h) * SEQ + s) * 96 + part * 32 + 8 * fq) = w;
        }
      }
  }
};

struct EpiKV {
  static constexpr bool PERM = true;
  bf16_t* K; bf16_t* Vt; const float* rstd;
  __device__ __forceinline__ void operator()(const Acc& acc, const Unit& u, int wr, int wc, int fr, int fq) const {
    float rsv[2][4];
#pragma unroll
    for (int ai = 0; ai < 2; ++ai)
#pragma unroll
      for (int m = 0; m < 4; ++m) rsv[ai][m] = ((const GAS float*)rstd)[(size_t)(u.pm * BM + ai * HALF + wr * 64 + m * 16 + fr) * 2 + 1];
#pragma unroll
    for (int ai = 0; ai < 2; ++ai)
#pragma unroll
      for (int m = 0; m < 4; ++m) {
        const int row = u.pm * BM + ai * HALF + wr * 64 + m * 16 + fr; const int b = row >> 12, s = row & 4095;
        const float rs = rsv[ai][m];
#pragma unroll
        for (int bj = 0; bj < 2; ++bj) {
          const int G = 8 * u.pn + 4 * bj + wc; const int h = G >> 2, part = G & 3;
          const f32x4 v0 = acc[ai][bj][m][0] * rs, v1 = acc[ai][bj][m][1] * rs;
          if (part < 2) { u32x4 w; w.x = cvt_pk_bf16(v0[0], v0[1]); w.y = cvt_pk_bf16(v0[2], v0[3]); w.z = cvt_pk_bf16(v1[0], v1[1]); w.w = cvt_pk_bf16(v1[2], v1[3]);
            *(GAS u32x4*)(K + ((size_t)(b * 8 + h) * SEQ + s) * 96 + part * 32 + 8 * fq) = w; }
          else { GAS bf16_t* vp = (GAS bf16_t*)Vt + ((size_t)(b * 8 + h) * 64 + (part - 2) * 32 + 8 * fq) * SEQ + s;
#pragma unroll
            for (int j = 0; j < 4; ++j) { vp[(size_t)j * SEQ] = f2bf(v0[j]); vp[(size_t)(4 + j) * SEQ] = f2bf(v1[j]); } }
        }
      }
  }
};

struct EpiCKV {
  static constexpr bool PERM = true;
  bf16_t* Kc; bf16_t* VcT;
  __device__ __forceinline__ void operator()(const Acc& acc, const Unit& u, int wr, int wc, int fr, int fq) const {
#pragma unroll
    for (int ai = 0; ai < 2; ++ai)
#pragma unroll
      for (int m = 0; m < 4; ++m) {
        const int row = u.pm * BM + ai * HALF + wr * 64 + m * 16 + fr; const int b = row >> 8, key = row & 255;
#pragma unroll
        for (int bj = 0; bj < 2; ++bj) {
          const int c0 = u.pn * BM + bj * HALF + wc * 32 + 8 * fq;
          const f32x4 v0 = acc[ai][bj][m][0], v1 = acc[ai][bj][m][1];
          if (c0 < 512) { u32x4 w; w.x = cvt_pk_bf16(v0[0], v0[1]); w.y = cvt_pk_bf16(v0[2], v0[3]); w.z = cvt_pk_bf16(v1[0], v1[1]); w.w = cvt_pk_bf16(v1[2], v1[3]);
            *(GAS u32x4*)(Kc + (size_t)row * 512 + c0) = w; }
          else { const int cc = c0 - 512; GAS bf16_t* vp = (GAS bf16_t*)VcT + ((size_t)(b * 4 + (cc >> 7)) * 128 + (cc & 127)) * 256 + key;
#pragma unroll
            for (int j = 0; j < 4; ++j) { vp[j * 256] = f2bf(v0[j]); vp[(4 + j) * 256] = f2bf(v1[j]); } }
        }
      }
  }
};

template <int SECOND>
struct EpiMix {
  static constexpr bool PERM = true;
  bf16_t* mix; const bf16_t* gates; int goff;
  __device__ __forceinline__ void operator()(const Acc& acc, const Unit& u, int wr, int wc, int fr, int fq) const {
#pragma unroll
    for (int ai = 0; ai < 2; ++ai) {
      u32x4 gw[4][2], mw[4][2];
#pragma unroll
      for (int m = 0; m < 4; ++m)
#pragma unroll
        for (int bj = 0; bj < 2; ++bj) {
          const int row = u.pm * BM + ai * HALF + wr * 64 + m * 16 + fr; const int c0 = u.pn * BM + bj * HALF + wc * 32 + 8 * fq;
          gw[m][bj] = *(const GAS u32x4*)(gates + (size_t)row * 2048 + goff + c0);
          if (SECOND) mw[m][bj] = *(const GAS u32x4*)(mix + (size_t)row * DM + c0);
        }
#pragma unroll
      for (int m = 0; m < 4; ++m)
#pragma unroll
        for (int bj = 0; bj < 2; ++bj) {
          const int row = u.pm * BM + ai * HALF + wr * 64 + m * 16 + fr; const int c0 = u.pn * BM + bj * HALF + wc * 32 + 8 * fq;
          float gt[8], o[8]; unpack8(gw[m][bj], gt);
          if (SECOND) unpack8(mw[m][bj], o);
#pragma unroll
          for (int n = 0; n < 2; ++n)
#pragma unroll
            for (int j = 0; j < 4; ++j) { const float v = gt[n * 4 + j] * acc[ai][bj][m][n][j]; o[n * 4 + j] = SECOND ? o[n * 4 + j] + v : v; }
          *(GAS u32x4*)(mix + (size_t)row * DM + c0) = pack8(o);
        }
      asm volatile("" ::: "memory");
    }
  }
};

struct Epi {
  int mode; bf16_t* O; bf16_t* O2; const bf16_t* bfp; const float* f0; const float* f1; float* outf; int ldc, ncols, goff; float scale; const float* g0; const float* g1; unsigned char* wsx; LAS unsigned char* lds;
  __device__ __forceinline__ bool perm() const { return mode != 4; }
  __device__ __forceinline__ void operator()(Acc& acc, const Unit& u, int wr, int wc, int fr, int fq) const {
    switch (mode) {
      case 0: EpiBf16<0>{O, ldc, ncols, scale, nullptr, nullptr, nullptr}(acc, u, wr, wc, fr, fq); break;
      case 1: EpiBf16<1>{O, ldc, ncols, 1.0f, f0, nullptr, nullptr}(acc, u, wr, wc, fr, fq); break;
      case 2: EpiBf16<2>{O, ldc, ncols, 1.0f, nullptr, f0, f1}(acc, u, wr, wc, fr, fq); break;
      case 3: EpiSwiglu{O}(acc, u, wr, wc, fr, fq); break;
      case 4: EpiTrunkLN{f0, f1, outf, O, g0, g1, (unsigned long long*)(wsx + O_XCH), (unsigned*)(wsx + O_CNT) + (size_t)ldc * 320 * 64, scale, lds}(acc, u, wr, wc, fr, fq); break;
      case 5: EpiQ{O, f0, f1}(acc, u, wr, wc, fr, fq); break;
      case 6: EpiKV{O, O2, f0}(acc, u, wr, wc, fr, fq); break;
      case 7: EpiCKV{O, O2}(acc, u, wr, wc, fr, fq); break;
      case 8: EpiMix<0>{O, bfp, goff}(acc, u, wr, wc, fr, fq); break;
      default: EpiMix<1>{O, bfp, goff}(acc, u, wr, wc, fr, fq); break;
    }
  }
};

__device__ __forceinline__ Gemm get_gemm(int step, PTab ptab, unsigned char* ws) {
  const bf16_t* xb = (const bf16_t*)(ws + O_XB);
  switch (step) {
    case 1: return Gemm{xb, (const bf16_t*)(ws + O_WGU1), T, 5632, 1024, 1024, 1024};
    case 2: return Gemm{(const bf16_t*)(ws + O_MEMLN), (const bf16_t*)(ws + O_WCKV), 5120, 1024, 1024, 1024, 1024};
    case 3: return Gemm{(const bf16_t*)(ws + O_HFF), (const bf16_t*)(ws + O_WD1), T, 1024, 2816, 2816, 2816};
    case 5: return Gemm{xb, (const bf16_t*)(ws + O_WINR), T, 2048, 1024, 1024, 1024};
    case 6: return Gemm{xb, (const bf16_t*)(ws + O_WINQ), T, 768, 1024, 1024, 1024};
    case 8: return Gemm{(const bf16_t*)(ws + O_LIN), (const bf16_t*)(ws + O_WLORA), T, 2048, 384, 384, 384};
    case 11: return Gemm{xb, (const bf16_t*)(ws + O_WING), T, 2048, 1024, 1024, 1024};
    case 12: return Gemm{(const bf16_t*)(ws + O_HQKV), (const bf16_t*)(ws + O_WUQ), T, 768, 384, 768, 384};
    case 13: return Gemm{(const bf16_t*)(ws + O_HQKV) + 384, (const bf16_t*)(ws + O_WUKV), T, 1024, 256, 768, 256};
    case 15: return Gemm{(const bf16_t*)(ws + O_AOUT), (const bf16_t*)(ws + O_PMLA), T, 1024, 512, 512, 512};
    case 16: return Gemm{(const bf16_t*)(ws + O_BOUT), (const bf16_t*)(ws + O_PRWKV), T, 1024, 512, 512, 512};
    case 17: return Gemm{(const bf16_t*)(ws + O_MIX), (const bf16_t*)(ws + O_WO), T, 1024, 1024, 1024, 1024};
    case 19: return Gemm{xb, (const bf16_t*)(ws + O_WCQ), T, 512, 1024, 1024, 1024};
    case 21: return Gemm{(const bf16_t*)(ws + O_CO), (const bf16_t*)(ws + O_WCO), T, 1024, 512, 512, 512};
    case 23: return Gemm{xb, (const bf16_t*)(ws + O_WGU2), T, 5632, 1024, 1024, 1024};
    case 24: return Gemm{(const bf16_t*)(ws + O_HFF), (const bf16_t*)(ws + O_WD2), T, 1024, 2816, 2816, 2816};
    default: return Gemm{nullptr, nullptr, 0, 0, 0, 0, 0};
  }
}
__device__ __forceinline__ Epi get_epi(int step, PTab ptab, unsigned char* ws, LAS unsigned char* lds) {
  const float* rope = (const float*)(ws + O_ROPE); const float* rstd = (const float*)(ws + O_RSTD);
  switch (step) {
    case 1: return Epi{3, (bf16_t*)(ws + O_HFF), nullptr, nullptr, nullptr, nullptr, nullptr, 0, 0, 0, 1.0f};
    case 2: return Epi{7, (bf16_t*)(ws + O_KC), (bf16_t*)(ws + O_VCT), nullptr, nullptr, nullptr, nullptr, 0, 0, 0, 1.0f};
    case 3: return Epi{4, (bf16_t*)(ws + O_XB), nullptr, nullptr, PT(x_p), PT(x_s), ((float*)PT(out)), 0, 0, 0, 0.5f, PT(ln1_g), PT(ln1_b), ws, lds};
    case 5: return Epi{0, (bf16_t*)(ws + O_HR), nullptr, nullptr, nullptr, nullptr, nullptr, 1856, 1856, 0, 1.0f};
    case 6: return Epi{0, (bf16_t*)(ws + O_HQKV), nullptr, nullptr, nullptr, nullptr, nullptr, 768, 768, 0, 1.0f};
    case 8: return Epi{2, (bf16_t*)(ws + O_LOUT), nullptr, nullptr, PT(w0), PT(a0), nullptr, 2048, 2048, 0, 1.0f};
    case 11: return Epi{1, (bf16_t*)(ws + O_GATES), nullptr, nullptr, PT(b_gate), nullptr, nullptr, 2048, 2048, 0, 1.0f};
    case 12: return Epi{5, (bf16_t*)(ws + O_Q), nullptr, nullptr, rstd, rope, nullptr, 0, 0, 0, 1.0f};
    case 13: return Epi{6, (bf16_t*)(ws + O_K), (bf16_t*)(ws + O_VT), nullptr, rstd, nullptr, nullptr, 0, 0, 0, 1.0f};
    case 15: return Epi{8, (bf16_t*)(ws + O_MIX), nullptr, (const bf16_t*)(ws + O_GATES), nullptr, nullptr, nullptr, 0, 0, 0, 1.0f};
    case 16: return Epi{9, (bf16_t*)(ws + O_MIX), nullptr, (const bf16_t*)(ws + O_GATES), nullptr, nullptr, nullptr, 0, 0, 1024, 1.0f};
    case 17: return Epi{4, (bf16_t*)(ws + O_XB), nullptr, nullptr, ((float*)PT(out)), nullptr, ((float*)PT(out)), 1, 0, 0, 1.0f, PT(ln2_g), PT(ln2_b), ws, lds};
    case 19: return Epi{0, (bf16_t*)(ws + O_CQ), nullptr, nullptr, nullptr, nullptr, nullptr, 512, 512, 0, CQSCALE};
    case 21: return Epi{4, (bf16_t*)(ws + O_XB), nullptr, nullptr, ((float*)PT(out)), nullptr, ((float*)PT(out)), 2, 0, 0, 1.0f, PT(ln3_g), PT(ln3_b), ws, lds};
    case 23: return Epi{3, (bf16_t*)(ws + O_HFF), nullptr, nullptr, nullptr, nullptr, nullptr, 0, 0, 0, 1.0f};
    case 24: return Epi{4, nullptr, nullptr, nullptr, ((float*)PT(out)), nullptr, ((float*)PT(out)), 3, 0, 0, 0.5f, PT(ln4_g), PT(ln4_b), ws, lds};
    default: return Epi{0, nullptr, nullptr, nullptr, nullptr, nullptr, nullptr, 0, 0, 0, 1.0f};
  }
}

__device__ __forceinline__ void gemm_phase(LAS unsigned char* lds, const int step, PTab ptab, unsigned char* ws, const int tid) {
  const Gemm g = get_gemm(step, ptab, ws); const bool permB = true;
  StaticOrder S; S.init(g.M, g.N, (int)gridDim.x, (int)blockIdx.x);
  const int wid = __builtin_amdgcn_readfirstlane(tid >> 6), lane = tid & 63, wr = wid >> 2, wc = wid & 3, fr = lane & 15, fq = lane >> 4;
  const int K = g.K, nt = K / BK;
  unsigned voffA[2], voffB[2]; int aoff, boff;
#define PG8_LANE_SETUP() do { int tid_l = tid; asm volatile("" : "+v"(tid_l)); const int lane_l = tid_l & 63, fr_l = lane_l & 15, fq_l = lane_l >> 4; \
    _Pragma("unroll") for (int i = 0; i < 2; ++i) { int R, C; stage_rc(tid_l * 16 + i * 8192, R, C); const int Rb = permB ? ((R & ~31) + perm32(R & 31)) : R; \
      voffA[i] = (unsigned)(R * g.lda + C) * 2u; voffB[i] = (unsigned)(Rb * g.ldb + C) * 2u; } \
    aoff = lds_byte(wr * 64 + fr_l, fq_l * 8); boff = lds_byte(wc * 32 + fr_l, fq_l * 8); } while (0)
  PG8_LANE_SETUP();
  const size_t kstep = (size_t)(BK * 2);
  const size_t hstepA = (size_t)HALF * g.lda * 2, hstepB = (size_t)HALF * g.ldb * 2;
  const size_t tstepA = 2 * hstepA, tstepB = 2 * hstepB;
  const unsigned ldsw = (unsigned)wid * 1024u;
#define PG8_SA(b, h) (((b) * 2 + (h)) * HTB)
#define PG8_SB(b, h) ((4 + (b) * 2 + (h)) * HTB)
#define PG8_STAGE(bufoff, gbase, voff) do { _Pragma("unroll") for (int _i = 0; _i < 2; ++_i) \
    __builtin_amdgcn_global_load_lds((const unsigned*)((const char*)(gbase) + (voff)[_i]), (LAS unsigned*)(lds + (bufoff) + ldsw + _i * 8192), 16, 0, 0); } while (0)
#define PG8_LDA(dst, b, h) do { _Pragma("unroll") for (int m = 0; m < 4; ++m) _Pragma("unroll") for (int k = 0; k < 2; ++k) dst[m][k] = *(const LAS bf16x8*)(lds + PG8_SA(b, h) + aoff + m * 2048 + k * 1024); } while (0)
#define PG8_LDB(dst, b, h) do { _Pragma("unroll") for (int n = 0; n < 2; ++n) _Pragma("unroll") for (int k = 0; k < 2; ++k) dst[n][k] = *(const LAS bf16x8*)(lds + PG8_SB(b, h) + boff + n * 2048 + k * 1024); } while (0)
#define PG8_MMA(ai, bj, At, Bt) do { __builtin_amdgcn_s_setprio(1); _Pragma("unroll") for (int m = 0; m < 4; ++m) _Pragma("unroll") for (int n = 0; n < 2; ++n) _Pragma("unroll") for (int k = 0; k < 2; ++k) \
    acc[ai][bj][m][n] = __builtin_amdgcn_mfma_f32_16x16x32_bf16(Bt[n][k], At[m][k], acc[ai][bj][m][n], 0, 0, 0); __builtin_amdgcn_s_setprio(0); } while (0)
#define PG8_WAIT_V(n) asm volatile("s_waitcnt vmcnt(" #n ")" ::: "memory")
#define PG8_WAIT_L(n) asm volatile("s_waitcnt lgkmcnt(" #n ")" ::: "memory")
#define PG8_BAR __builtin_amdgcn_s_barrier()
#define PG8_SCHED __builtin_amdgcn_sched_barrier(0)
  Unit cur, nxt; int ui = 0;
  const bool revpm = (step == 3 || step == 17 || step == 21 || step == 24);
  if (!S.next(0, cur)) return;
  if (revpm) cur.pm = S.nM - 1 - cur.pm;
  f32x4 acc[2][2][4][2];
#pragma unroll
  for (int a = 0; a < 2; ++a)
#pragma unroll
    for (int b = 0; b < 2; ++b)
#pragma unroll
      for (int m = 0; m < 4; ++m)
#pragma unroll
        for (int n = 0; n < 2; ++n) acc[a][b][m][n] = (f32x4){0.f, 0.f, 0.f, 0.f};
  bf16x8 At[4][2], B0[2][2], B1[2][2];
  const char* cA = (const char*)g.A + (size_t)cur.pm * tstepA; const char* cB = (const char*)g.Bt + (size_t)cur.pn * tstepB;
  PG8_STAGE(PG8_SB(0, 0), cB, voffB); PG8_STAGE(PG8_SA(0, 0), cA, voffA); PG8_STAGE(PG8_SB(0, 1), cB + hstepB, voffB); PG8_STAGE(PG8_SA(0, 1), cA + hstepA, voffA);
  if (wr == 1) PG8_BAR;
  PG8_WAIT_V(4); PG8_BAR;
  PG8_STAGE(PG8_SB(1, 0), cB + kstep, voffB); PG8_STAGE(PG8_SA(1, 0), cA + kstep, voffA); PG8_STAGE(PG8_SB(1, 1), cB + hstepB + kstep, voffB);
  PG8_WAIT_V(6); PG8_BAR;
  for (;;) {
    const bool has_next = S.next(ui + 1, nxt);
    if (revpm && has_next) nxt.pm = S.nM - 1 - nxt.pm;
    const char* nA = has_next ? (const char*)g.A + (size_t)nxt.pm * tstepA : cA; const char* nB = has_next ? (const char*)g.Bt + (size_t)nxt.pn * tstepB : cB;
    for (int t = 0; t < nt; t += 2) {
      const bool last = (t == nt - 2);
      const char* a1 = cA + (size_t)(t + 1) * kstep;
      const char* a2 = last ? nA : cA + (size_t)(t + 2) * kstep; const char* b2 = last ? nB : cB + (size_t)(t + 2) * kstep;
      const char* a3 = a2 + kstep; const char* b3 = b2 + kstep;
      PG8_LDB(B0, 0, 0); PG8_SCHED; PG8_LDA(At, 0, 0); PG8_STAGE(PG8_SA(1, 1), a1 + hstepA, voffA);
      PG8_WAIT_L(8); PG8_BAR; PG8_WAIT_L(0); PG8_MMA(0, 0, At, B0); PG8_BAR; PG8_SCHED;
      PG8_LDB(B1, 0, 1); PG8_STAGE(PG8_SB(0, 0), b2, voffB);
      PG8_BAR; PG8_WAIT_L(0); PG8_MMA(0, 1, At, B1); PG8_BAR;
      PG8_LDA(At, 0, 1); PG8_STAGE(PG8_SA(0, 0), a2, voffA);
      PG8_BAR; PG8_WAIT_L(0); PG8_MMA(1, 0, At, B0); PG8_BAR; PG8_SCHED;
      PG8_STAGE(PG8_SB(0, 1), b2 + hstepB, voffB);
      PG8_WAIT_V(6); PG8_BAR; PG8_MMA(1, 1, At, B1); PG8_BAR;
      PG8_LDB(B0, 1, 0); PG8_SCHED; PG8_LDA(At, 1, 0); PG8_STAGE(PG8_SA(0, 1), a2 + hstepA, voffA);
      PG8_WAIT_L(8); PG8_BAR; PG8_WAIT_L(0); PG8_MMA(0, 0, At, B0); PG8_BAR; PG8_SCHED;
      PG8_LDB(B1, 1, 1); PG8_STAGE(PG8_SB(1, 0), b3, voffB);
      PG8_BAR; PG8_WAIT_L(0); PG8_MMA(0, 1, At, B1); PG8_BAR;
      PG8_LDA(At, 1, 1); PG8_STAGE(PG8_SA(1, 0), a3, voffA);
      PG8_BAR; PG8_WAIT_L(0); PG8_MMA(1, 0, At, B0); PG8_BAR; PG8_SCHED;
      PG8_STAGE(PG8_SB(1, 1), b3 + hstepB, voffB);
      PG8_WAIT_V(6); PG8_BAR; PG8_MMA(1, 1, At, B1); PG8_BAR;
    }
    { int st2 = step; asm volatile("" : "+s"(st2)); int wr2 = wr, wc2 = wc, fr2 = fr, fq2 = fq; asm volatile("" : "+s"(wr2), "+s"(wc2)); asm volatile("" : "+v"(fr2), "+v"(fq2));
      unsigned char* ws2 = ws; asm volatile("" : "+s"(ws2)); const Epi E = get_epi(st2, (PTab)(ws2 + O_PTAB), ws2, lds); E(acc, cur, wr2, wc2, fr2, fq2); }
    if (!has_next) break;
#pragma unroll
    for (int a = 0; a < 2; ++a)
#pragma unroll
      for (int b = 0; b < 2; ++b)
#pragma unroll
        for (int m = 0; m < 4; ++m)
#pragma unroll
          for (int n = 0; n < 2; ++n) acc[a][b][m][n] = (f32x4){0.f, 0.f, 0.f, 0.f};
    cur = nxt; cA = nA; cB = nB; ++ui;
    PG8_LANE_SETUP();
  }
  PG8_WAIT_V(0);
  if (wr == 0) PG8_BAR;
  PG8_BAR;
#undef PG8_LANE_SETUP
#undef PG8_SA
#undef PG8_SB
#undef PG8_STAGE
#undef PG8_LDA
#undef PG8_LDB
#undef PG8_MMA
#undef PG8_WAIT_V
#undef PG8_WAIT_L
#undef PG8_BAR
#undef PG8_SCHED
}


template <int DQK, int DV, bool PF>
__device__ __forceinline__ void attn_unit(const bf16_t* q, int ldq, const bf16_t* k, int ldk, const bf16_t* vt, int ldv, int nkeys, bf16_t* o, int ldo, LAS unsigned char* lds, const int tid) {
  constexpr int KS = DQK / 32, DVB = DV / 16, KROW = DQK * 2 + 16, VROW = 144, KT_B = 64 * KROW, VT_B = DV * VROW, BUF_B = KT_B + VT_B;
  constexpr int KCPR = DQK / 8, KCH = 64 * KCPR, VCH = DV * 8, KPT = (KCH + 511) / 512, VPT = (VCH + 511) / 512;
  const int wid = tid >> 6, lane = tid & 63, l15 = lane & 15, quad = lane >> 4;
  bf16x8 qf[2][KS];
#pragma unroll
  for (int qb = 0; qb < 2; ++qb)
#pragma unroll
    for (int ks = 0; ks < KS; ++ks) qf[qb][ks] = *(const GAS bf16x8*)(q + (size_t)(wid * 32 + qb * 16 + l15) * ldq + ks * 32 + quad * 8);
  f32x4 oacc[DVB][2];
#pragma unroll
  for (int d = 0; d < DVB; ++d) { oacc[d][0] = (f32x4){0.f, 0.f, 0.f, 0.f}; oacc[d][1] = (f32x4){0.f, 0.f, 0.f, 0.f}; }
  float mrun[2] = {-INFINITY, -INFINITY}, lrun[2] = {0.f, 0.f};
  u32x4 kst[KPT], vst[VPT];
#define ATT_GLOAD(tile) do { _Pragma("unroll") for (int i = 0; i < KPT; ++i) { const int ch = tid + i * 512; if (ch < KCH) { const int r = ch / KCPR, c = ch - r * KCPR; kst[i] = *(const GAS u32x4*)(k + (size_t)((tile) * 64 + r) * ldk + c * 8); } } \
    _Pragma("unroll") for (int i = 0; i < VPT; ++i) { const int ch = tid + i * 512; if (ch < VCH) { const int r = ch >> 3, c = ch & 7; vst[i] = *(const GAS u32x4*)(vt + (size_t)r * ldv + (tile) * 64 + c * 8); } } } while (0)
#define ATT_LSTORE(buf) do { _Pragma("unroll") for (int i = 0; i < KPT; ++i) { const int ch = tid + i * 512; if (ch < KCH) { const int r = ch / KCPR, c = ch - r * KCPR; *(LAS u32x4*)(lds + (buf) * BUF_B + r * KROW + c * 16) = kst[i]; } } \
    _Pragma("unroll") for (int i = 0; i < VPT; ++i) { const int ch = tid + i * 512; if (ch < VCH) { const int r = ch >> 3, c = ch & 7; *(LAS u32x4*)(lds + (buf) * BUF_B + KT_B + r * VROW + c * 16) = vst[i]; } } } while (0)
  const int ntiles = nkeys / 64;
  if (PF) { ATT_GLOAD(0); ATT_LSTORE(0); __syncthreads(); }
  for (int t = 0; t < ntiles; ++t) {
    const int buf = PF ? (t & 1) : 0;
    if (PF) { if (t + 1 < ntiles) ATT_GLOAD(t + 1); } else { ATT_GLOAD(t); ATT_LSTORE(0); __syncthreads(); }
    f32x4 sacc[4][2];
#pragma unroll
    for (int kb = 0; kb < 4; ++kb) { sacc[kb][0] = (f32x4){0.f, 0.f, 0.f, 0.f}; sacc[kb][1] = (f32x4){0.f, 0.f, 0.f, 0.f}; }
#pragma unroll
    for (int ks = 0; ks < KS; ++ks) {
      bf16x8 kf[4];
#pragma unroll
      for (int kb = 0; kb < 4; ++kb) kf[kb] = *(const LAS bf16x8*)(lds + buf * BUF_B + (kb * 16 + l15) * KROW + ks * 64 + quad * 16);
#pragma unroll
      for (int kb = 0; kb < 4; ++kb)
#pragma unroll
        for (int qb = 0; qb < 2; ++qb) sacc[kb][qb] = __builtin_amdgcn_mfma_f32_16x16x32_bf16(kf[kb], qf[qb][ks], sacc[kb][qb], 0, 0, 0);
    }
    bf16x8 pf[2][2];
#pragma unroll
    for (int qb = 0; qb < 2; ++qb) {
      float mx = sacc[0][qb][0];
#pragma unroll
      for (int kb = 0; kb < 4; ++kb)
#pragma unroll
        for (int j = 0; j < 4; ++j) mx = fmaxf(mx, sacc[kb][qb][j]);
      mx = xrow16_max(mx);
      const float mnew = fmaxf(mrun[qb], mx); const float alpha = __builtin_amdgcn_exp2f(mrun[qb] - mnew); mrun[qb] = mnew;
      float ps = 0.f;
#pragma unroll
      for (int kb = 0; kb < 4; ++kb)
#pragma unroll
        for (int j = 0; j < 4; ++j) { const float pv = __builtin_amdgcn_exp2f(sacc[kb][qb][j] - mnew); sacc[kb][qb][j] = pv; ps += pv; }
      ps = xrow16_sum(ps);
      lrun[qb] = lrun[qb] * alpha + ps;
#pragma unroll
      for (int d = 0; d < DVB; ++d) oacc[d][qb] *= alpha;
#pragma unroll
      for (int ks2 = 0; ks2 < 2; ++ks2) { u32x4 w; w.x = cvt_pk_bf16(sacc[2 * ks2][qb][0], sacc[2 * ks2][qb][1]); w.y = cvt_pk_bf16(sacc[2 * ks2][qb][2], sacc[2 * ks2][qb][3]);
        w.z = cvt_pk_bf16(sacc[2 * ks2 + 1][qb][0], sacc[2 * ks2 + 1][qb][1]); w.w = cvt_pk_bf16(sacc[2 * ks2 + 1][qb][2], sacc[2 * ks2 + 1][qb][3]); pf[qb][ks2] = __builtin_bit_cast(bf16x8, w); }
    }
#pragma unroll
    for (int ks2 = 0; ks2 < 2; ++ks2)
#pragma unroll
      for (int d = 0; d < DVB; ++d) {
        const LAS unsigned char* vp = lds + buf * BUF_B + KT_B + (d * 16 + l15) * VROW + ks2 * 64 + quad * 8;
        const u32x2 lo = *(const LAS u32x2*)vp, hi = *(const LAS u32x2*)(vp + 32);
        u32x4 w; w.x = lo.x; w.y = lo.y; w.z = hi.x; w.w = hi.y; const bf16x8 vf = __builtin_bit_cast(bf16x8, w);
#pragma unroll
        for (int qb = 0; qb < 2; ++qb) oacc[d][qb] = __builtin_amdgcn_mfma_f32_16x16x32_bf16(vf, pf[qb][ks2], oacc[d][qb], 0, 0, 0);
      }
    if (PF) { if (t + 1 < ntiles) ATT_LSTORE(buf ^ 1); }
    __syncthreads();
  }
#undef ATT_GLOAD
#undef ATT_LSTORE
#pragma unroll
  for (int qb = 0; qb < 2; ++qb) {
    const float inv = 1.0f / lrun[qb]; const int row = wid * 32 + qb * 16 + l15;
#pragma unroll
    for (int d = 0; d < DVB; ++d) { const f32x4 v = oacc[d][qb] * inv; u32x2 w; w.x = cvt_pk_bf16(v[0], v[1]); w.y = cvt_pk_bf16(v[2], v[3]); *(GAS u32x2*)(o + (size_t)row * ldo + d * 16 + quad * 4) = w; }
  }
}

template <int DQK, int DV>
__device__ __forceinline__ void attn_unit_pp(const bf16_t* q, int ldq, const bf16_t* k, int ldk, const bf16_t* vt, int ldv, int nkeys, bf16_t* o, int ldo, LAS unsigned char* lds, const int tid) {
  constexpr int KS = DQK / 32, DVB = DV / 16, KROW = DQK * 2 + 16, VROW = 144, KT_B = 64 * KROW, VT_B = DV * VROW, BUF_B = KT_B + VT_B;
  constexpr int KCPR = DQK / 8, KCH = 64 * KCPR, VCH = DV * 8, KPT = (KCH + 511) / 512, VPT = (VCH + 511) / 512;
  const int wid = tid >> 6, lane = tid & 63, l15 = lane & 15, quad = lane >> 4; const int grp = __builtin_amdgcn_readfirstlane(wid >> 2);
  bf16x8 qf[2][KS];
#pragma unroll
  for (int qb = 0; qb < 2; ++qb)
#pragma unroll
    for (int ks = 0; ks < KS; ++ks) qf[qb][ks] = *(const GAS bf16x8*)(q + (size_t)(wid * 32 + qb * 16 + l15) * ldq + ks * 32 + quad * 8);
  f32x4 oacc[DVB][2];
#pragma unroll
  for (int d = 0; d < DVB; ++d) { oacc[d][0] = (f32x4){0.f, 0.f, 0.f, 0.f}; oacc[d][1] = (f32x4){0.f, 0.f, 0.f, 0.f}; }
  float mref[2] = {0.f, 0.f};
  f32x4 lacc[2] = {(f32x4){0.f, 0.f, 0.f, 0.f}, (f32x4){0.f, 0.f, 0.f, 0.f}};
  const bf16x8 vones = (l15 == 0) ? (bf16x8){0x3F80, 0x3F80, 0x3F80, 0x3F80, 0x3F80, 0x3F80, 0x3F80, 0x3F80} : (bf16x8){0, 0, 0, 0, 0, 0, 0, 0};
  u32x4 kstA[KPT], vstA[VPT], kstB[KPT], vstB[VPT];
#define ATT_GLOAD(kst, vst, tile) do { _Pragma("unroll") for (int i = 0; i < KPT; ++i) { const int ch = tid + i * 512; if (ch < KCH) { const int r = ch / KCPR, c = ch - r * KCPR; kst[i] = *(const GAS u32x4*)(k + (size_t)((tile) * 64 + r) * ldk + c * 8); } } \
    _Pragma("unroll") for (int i = 0; i < VPT; ++i) { const int ch = tid + i * 512; if (ch < VCH) { const int r = ch >> 3, c = ch & 7; vst[i] = *(const GAS u32x4*)(vt + (size_t)r * ldv + (tile) * 64 + c * 8); } } } while (0)
#define ATT_LSTORE(kst, vst, bufoff) do { _Pragma("unroll") for (int i = 0; i < KPT; ++i) { const int ch = tid + i * 512; if (ch < KCH) { const int r = ch / KCPR, c = ch - r * KCPR; *(LAS u32x4*)(lds + (bufoff) + r * KROW + c * 16) = kst[i]; } } \
    _Pragma("unroll") for (int i = 0; i < VPT; ++i) { const int ch = tid + i * 512; if (ch < VCH) { const int r = ch >> 3, c = ch & 7; *(LAS u32x4*)(lds + (bufoff) + KT_B + r * VROW + c * 16) = vst[i]; } } } while (0)
#define ATT_PV(bufoff) do { _Pragma("unroll") for (int ks2 = 0; ks2 < 2; ++ks2) _Pragma("unroll") for (int d = 0; d < DVB; ++d) { \
      const LAS unsigned char* vp = lds + (bufoff) + KT_B + (d * 16 + l15) * VROW + ks2 * 64 + quad * 8; const u32x2 lo = *(const LAS u32x2*)vp, hi = *(const LAS u32x2*)(vp + 32); \
      u32x4 w; w.x = lo.x; w.y = lo.y; w.z = hi.x; w.w = hi.y; const bf16x8 vf = __builtin_bit_cast(bf16x8, w); \
      _Pragma("unroll") for (int qb = 0; qb < 2; ++qb) oacc[d][qb] = __builtin_amdgcn_mfma_f32_16x16x32_bf16(vf, pf[qb][ks2], oacc[d][qb], 0, 0, 0); } \
    _Pragma("unroll") for (int ks2 = 0; ks2 < 2; ++ks2) _Pragma("unroll") for (int qb = 0; qb < 2; ++qb) lacc[qb] = __builtin_amdgcn_mfma_f32_16x16x32_bf16(vones, pf[qb][ks2], lacc[qb], 0, 0, 0); } while (0)
#define ATT_BAR() do { asm volatile("s_waitcnt lgkmcnt(0)" ::: "memory"); __builtin_amdgcn_s_barrier(); asm volatile("" ::: "memory"); } while (0)
  const int ntiles = nkeys / 64;
  ATT_GLOAD(kstA, vstA, 0); ATT_LSTORE(kstA, vstA, 0); __syncthreads();
  ATT_GLOAD(kstB, vstB, 1); ATT_GLOAD(kstA, vstA, 2);
  if (grp == 1) ATT_BAR();
  bf16x8 pf[2][2];
#pragma unroll
  for (int qb = 0; qb < 2; ++qb) { pf[qb][0] = (bf16x8){0, 0, 0, 0, 0, 0, 0, 0}; pf[qb][1] = (bf16x8){0, 0, 0, 0, 0, 0, 0, 0}; }
  int bcur = 0, bprev = 2 * BUF_B, bnext = BUF_B;
  for (int t0 = 0; t0 < ntiles; t0 += 2) {
    { const int t = t0;
    f32x4 sacc[4][2];
#pragma unroll
    for (int kb = 0; kb < 4; ++kb) { sacc[kb][0] = (f32x4){-mref[0], -mref[0], -mref[0], -mref[0]}; sacc[kb][1] = (f32x4){-mref[1], -mref[1], -mref[1], -mref[1]}; }
#pragma unroll
    for (int ks = 0; ks < KS; ++ks) {
      bf16x8 kf[4];
#pragma unroll
      for (int kb = 0; kb < 4; ++kb) kf[kb] = *(const LAS bf16x8*)(lds + bcur + (kb * 16 + l15) * KROW + ks * 64 + quad * 16);
#pragma unroll
      for (int kb = 0; kb < 4; ++kb)
#pragma unroll
        for (int qb = 0; qb < 2; ++qb) sacc[kb][qb] = __builtin_amdgcn_mfma_f32_16x16x32_bf16(kf[kb], qf[qb][ks], sacc[kb][qb], 0, 0, 0);
    }
    if (t > 0) ATT_PV(bprev);
    if (t + 1 < ntiles) ATT_LSTORE(kstB, vstB, bnext);
    ATT_BAR();
    if (t + 3 < ntiles) ATT_GLOAD(kstB, vstB, t + 3);
    float mxq[2];
#pragma unroll
    for (int qb = 0; qb < 2; ++qb) {
      float mx = sacc[0][qb][0];
#pragma unroll
      for (int kb = 0; kb < 4; ++kb)
#pragma unroll
        for (int j = 0; j < 4; ++j) mx = fmaxf(mx, sacc[kb][qb][j]);
      mxq[qb] = xrow16_max(mx);
    }
    if (t == 0 || __any(fmaxf(mxq[0], mxq[1]) > 8.0f)) {
#pragma unroll
      for (int qb = 0; qb < 2; ++qb) {
        const float shift = (t == 0) ? mxq[qb] : fmaxf(mxq[qb], 0.f); const float alpha = (t == 0) ? 0.f : __builtin_amdgcn_exp2f(-shift);
        mref[qb] += shift;
#pragma unroll
        for (int kb = 0; kb < 4; ++kb)
#pragma unroll
          for (int j = 0; j < 4; ++j) sacc[kb][qb][j] -= shift;
#pragma unroll
        for (int d = 0; d < DVB; ++d) oacc[d][qb] *= alpha;
        lacc[qb] *= alpha;
      }
    }
#pragma unroll
    for (int qb = 0; qb < 2; ++qb) {
#pragma unroll
      for (int kb = 0; kb < 4; ++kb)
#pragma unroll
        for (int j = 0; j < 4; ++j) sacc[kb][qb][j] = __builtin_amdgcn_exp2f(sacc[kb][qb][j]);
#pragma unroll
      for (int ks2 = 0; ks2 < 2; ++ks2) { u32x4 w; w.x = cvt_pk_bf16(sacc[2 * ks2][qb][0], sacc[2 * ks2][qb][1]); w.y = cvt_pk_bf16(sacc[2 * ks2][qb][2], sacc[2 * ks2][qb][3]);
        w.z = cvt_pk_bf16(sacc[2 * ks2 + 1][qb][0], sacc[2 * ks2 + 1][qb][1]); w.w = cvt_pk_bf16(sacc[2 * ks2 + 1][qb][2], sacc[2 * ks2 + 1][qb][3]); pf[qb][ks2] = __builtin_bit_cast(bf16x8, w); }
    }
    ATT_BAR();
    { const int tmp = bprev; bprev = bcur; bcur = bnext; bnext = tmp; }
    }
    { const int t = t0 + 1;
    f32x4 sacc[4][2];
#pragma unroll
    for (int kb = 0; kb < 4; ++kb) { sacc[kb][0] = (f32x4){-mref[0], -mref[0], -mref[0], -mref[0]}; sacc[kb][1] = (f32x4){-mref[1], -mref[1], -mref[1], -mref[1]}; }
#pragma unroll
    for (int ks = 0; ks < KS; ++ks) {
      bf16x8 kf[4];
#pragma unroll
      for (int kb = 0; kb < 4; ++kb) kf[kb] = *(const LAS bf16x8*)(lds + bcur + (kb * 16 + l15) * KROW + ks * 64 + quad * 16);
#pragma unroll
      for (int kb = 0; kb < 4; ++kb)
#pragma unroll
        for (int qb = 0; qb < 2; ++qb) sacc[kb][qb] = __builtin_amdgcn_mfma_f32_16x16x32_bf16(kf[kb], qf[qb][ks], sacc[kb][qb], 0, 0, 0);
    }
    if (t > 0) ATT_PV(bprev);
    if (t + 1 < ntiles) ATT_LSTORE(kstA, vstA, bnext);
    ATT_BAR();
    if (t + 3 < ntiles) ATT_GLOAD(kstA, vstA, t + 3);
    float mxq[2];
#pragma unroll
    for (int qb = 0; qb < 2; ++qb) {
      float mx = sacc[0][qb][0];
#pragma unroll
      for (int kb = 0; kb < 4; ++kb)
#pragma unroll
        for (int j = 0; j < 4; ++j) mx = fmaxf(mx, sacc[kb][qb][j]);
      mxq[qb] = xrow16_max(mx);
    }
    if (t == 0 || __any(fmaxf(mxq[0], mxq[1]) > 8.0f)) {
#pragma unroll
      for (int qb = 0; qb < 2; ++qb) {
        const float shift = (t == 0) ? mxq[qb] : fmaxf(mxq[qb], 0.f); const float alpha = (t == 0) ? 0.f : __builtin_amdgcn_exp2f(-shift);
        mref[qb] += shift;
#pragma unroll
        for (int kb = 0; kb < 4; ++kb)
#pragma unroll
          for (int j = 0; j < 4; ++j) sacc[kb][qb][j] -= shift;
#pragma unroll
        for (int d = 0; d < DVB; ++d) oacc[d][qb] *= alpha;
        lacc[qb] *= alpha;
      }
    }
#pragma unroll
    for (int qb = 0; qb < 2; ++qb) {
#pragma unroll
      for (int kb = 0; kb < 4; ++kb)
#pragma unroll
        for (int j = 0; j < 4; ++j) sacc[kb][qb][j] = __builtin_amdgcn_exp2f(sacc[kb][qb][j]);
#pragma unroll
      for (int ks2 = 0; ks2 < 2; ++ks2) { u32x4 w; w.x = cvt_pk_bf16(sacc[2 * ks2][qb][0], sacc[2 * ks2][qb][1]); w.y = cvt_pk_bf16(sacc[2 * ks2][qb][2], sacc[2 * ks2][qb][3]);
        w.z = cvt_pk_bf16(sacc[2 * ks2 + 1][qb][0], sacc[2 * ks2 + 1][qb][1]); w.w = cvt_pk_bf16(sacc[2 * ks2 + 1][qb][2], sacc[2 * ks2 + 1][qb][3]); pf[qb][ks2] = __builtin_bit_cast(bf16x8, w); }
    }
    ATT_BAR();
    { const int tmp = bprev; bprev = bcur; bcur = bnext; bnext = tmp; }
    }
  }
  ATT_PV(bprev);
  if (grp == 0) ATT_BAR();
  __syncthreads();
#undef ATT_GLOAD
#undef ATT_LSTORE
#undef ATT_PV
#undef ATT_BAR
#pragma unroll
  for (int qb = 0; qb < 2; ++qb) {
    const float inv = 1.0f / __builtin_bit_cast(float, __builtin_amdgcn_ds_bpermute(l15 * 4, __builtin_bit_cast(int, lacc[qb][0]))); const int row = wid * 32 + qb * 16 + l15;
#pragma unroll
    for (int d = 0; d < DVB; ++d) { const f32x4 v = oacc[d][qb] * inv; u32x2 w; w.x = cvt_pk_bf16(v[0], v[1]); w.y = cvt_pk_bf16(v[2], v[3]); *(GAS u32x2*)(o + (size_t)row * ldo + d * 16 + quad * 4) = w; }
  }
}

struct WDesc { const float* src; bf16_t* dst; const float* ks; int K, N, ld, mode; };
__device__ __forceinline__ int w_cmap(int mode, int n) {
  switch (mode) {
    case 1: { const int pn = n >> 8, i = n & 255; return i < 128 ? pn * 128 + i : DFF + pn * 128 + (i - 128); }
    case 2: return n < 672 ? n : -1;
    case 3: return n < 1856 ? 672 + n : -1;
    case 4: return 2528 + n;
    case 5: { const int h = n / 96, pp = n - h * 96; if (pp < 64) return n; const int p = pp - 64; return h * 96 + 64 + (p & 3) + 4 * (p >> 3) + 16 * ((p >> 2) & 1); }
    default: return n;
  }
}
__device__ __forceinline__ void prep_tile(const WDesc& d, int tk, int tn, const Params& p, LAS float* tl) {
  const int tid = threadIdx.x; const int k0 = tk * 64, n0 = tn * 64;
  {
    const int nn = tid & 63, kq = tid >> 6; const int n = n0 + nn;
#pragma unroll
    for (int i = 0; i < 8; ++i) {
      const int k = k0 + kq * 8 + i; float v = 0.f;
      if (d.mode == 7) {
        const int blk = n >> 9, nl = n & 511;
        if (blk == 0) { if (k < 64) v = p.w_up[(size_t)k * 512 + nl]; }
        else if (blk == 1) { if (k >= 64 && k < 128) v = p.w_up[(size_t)(64 + (k - 64)) * 512 + nl]; }
        else if (blk == 2) { if (k >= 128 && k < 192) v = p.a_up[(size_t)(k - 128) * 512 + nl]; }
        else { if (k >= 192 && k < 320) v = p.g_up[(size_t)(k - 192) * 512 + nl]; }
      } else {
        const int c = w_cmap(d.mode, n);
        if (c >= 0) { v = d.src[(size_t)k * d.ld + c]; if (d.ks) v *= d.ks[k]; }
      }
      tl[(kq * 8 + i) * 65 + nn] = v;
    }
  }
  __syncthreads();
  {
    const int n = tid >> 3, kc = (tid & 7) * 8; float f[8];
#pragma unroll
    for (int i = 0; i < 8; ++i) f[i] = tl[(kc + i) * 65 + n];
    *(u32x4*)(d.dst + (size_t)(n0 + n) * d.K + k0 + kc) = pack8(f);
  }
  __syncthreads();
}

__device__ __forceinline__ void ln_phase(float* trunk, const float* g, const float* b, bf16_t* xb, bool write_f32, const int tid) {
  const int lane = tid & 63, wid = tid >> 6;
  f32x4 gv[4], bv[4];
#pragma unroll
  for (int i = 0; i < 4; ++i) { gv[i] = *(const f32x4*)(g + i * 256 + lane * 4); bv[i] = *(const f32x4*)(b + i * 256 + lane * 4); }
  for (int row = blockIdx.x * 8 + wid; row < T; row += gridDim.x * 8) {
    float* rp = trunk + (size_t)row * DM; f32x4 v[4]; float s = 0.f;
#pragma unroll
    for (int i = 0; i < 4; ++i) { v[i] = *(const f32x4*)(rp + i * 256 + lane * 4); s += (v[i][0] + v[i][1]) + (v[i][2] + v[i][3]); }
    const float mean = wave_sum(s) * (1.0f / 1024.0f); float q = 0.f;
#pragma unroll
    for (int i = 0; i < 4; ++i) { v[i] -= mean; q += (v[i][0] * v[i][0] + v[i][1] * v[i][1]) + (v[i][2] * v[i][2] + v[i][3] * v[i][3]); }
    const float rstd = 1.0f / sqrtf(wave_sum(q) * (1.0f / 1024.0f) + 1e-5f);
#pragma unroll
    for (int i = 0; i < 4; ++i) { const f32x4 o = v[i] * rstd * gv[i] + bv[i];
      if (write_f32) *(f32x4*)(rp + i * 256 + lane * 4) = o;
      if (xb) { u32x2 w; w.x = cvt_pk_bf16(o[0], o[1]); w.y = cvt_pk_bf16(o[2], o[3]); *(u32x2*)(xb + (size_t)row * DM + i * 256 + lane * 4) = w; } }
  }
}

__device__ __forceinline__ void fast_barrier(unsigned* bar, unsigned target, int tid) {
  asm volatile("s_waitcnt vmcnt(0)" ::: "memory");
  __syncthreads();
  if (tid == 0) {
    __builtin_amdgcn_fence(__ATOMIC_RELEASE, "agent");
    asm volatile("s_waitcnt vmcnt(0)" ::: "memory");
    __hip_atomic_fetch_add(bar, 1u, __ATOMIC_RELAXED, __HIP_MEMORY_SCOPE_AGENT);
    while (__hip_atomic_load(bar, __ATOMIC_RELAXED, __HIP_MEMORY_SCOPE_AGENT) < target) __builtin_amdgcn_s_sleep(1);
    __builtin_amdgcn_fence(__ATOMIC_ACQUIRE, "agent");
    asm volatile("s_waitcnt vmcnt(0)" ::: "memory");
  }
  __syncthreads();
}

__global__ void __launch_bounds__(512, 2) fwd_mega(Params p) {
  extern __shared__ __attribute__((aligned(16))) unsigned char smem[];
  LAS unsigned char* lds = (LAS unsigned char*)smem;
  cg::grid_group grid = cg::this_grid();
  if (blockIdx.x == 0 && threadIdx.x == 64) __hip_atomic_store((unsigned*)(p.ws + O_PTAB + 512), 0u, __ATOMIC_RELAXED, __HIP_MEMORY_SCOPE_AGENT);
  for (int i = blockIdx.x * 512 + threadIdx.x; i < 4 * 320 * 64; i += gridDim.x * 512) ((unsigned*)(p.ws + O_CNT))[i] = 0u;
  const int wave_s = __builtin_amdgcn_readfirstlane((int)(threadIdx.x >> 6));
  unsigned nbar = 0;
  if (blockIdx.x == 0 && threadIdx.x < 43) {
    const float* v = (const float*)p.out;
    switch (threadIdx.x) {
      case 0: v = p.x_p; break;
      case 1: v = p.x_s; break;
      case 2: v = p.mem_p; break;
      case 3: v = p.mem_s; break;
      case 4: v = p.ln1_g; break;
      case 5: v = p.ln1_b; break;
      case 6: v = p.ffn1_wgu; break;
      case 7: v = p.ffn1_wd; break;
      case 8: v = p.w_in; break;
      case 9: v = p.b_gate; break;
      case 10: v = p.q_norm_g; break;
      case 11: v = p.w_uq; break;
      case 12: v = p.kv_norm_g; break;
      case 13: v = p.w_ukv; break;
      case 14: v = p.p_mla; break;
      case 15: v = p.mu_prev; break;
      case 16: v = p.mu_next; break;
      case 17: v = p.w0; break;
      case 18: v = p.w_up; break;
      case 19: v = p.a0; break;
      case 20: v = p.a_up; break;
      case 21: v = p.g_up; break;
      case 22: v = p.k_k; break;
      case 23: v = p.k_a; break;
      case 24: v = p.r_k; break;
      case 25: v = p.lnx_g; break;
      case 26: v = p.lnx_b; break;
      case 27: v = p.p_rwkv; break;
      case 28: v = p.w_o; break;
      case 29: v = p.ln2_g; break;
      case 30: v = p.ln2_b; break;
      case 31: v = p.mem_g; break;
      case 32: v = p.mem_b; break;
      case 33: v = p.w_cq; break;
      case 34: v = p.w_ckv; break;
      case 35: v = p.w_co; break;
      case 36: v = p.ln3_g; break;
      case 37: v = p.ln3_b; break;
      case 38: v = p.ffn2_wgu; break;
      case 39: v = p.ffn2_wd; break;
      case 40: v = p.ln4_g; break;
      case 41: v = p.ln4_b; break;
      default: break;
    }
    ((const float**)(p.ws + O_PTAB))[threadIdx.x] = v;
  }
  if (EN & 4) {
    unsigned char* ws = p.ws; const int tid = threadIdx.x, lane = tid & 63, wid = tid >> 6; const int gwave = blockIdx.x * 8 + wid, nwave = gridDim.x * 8;
    bf16_t* xb = (bf16_t*)(ws + O_XB); float* rope = (float*)(ws + O_ROPE);
  {
    int base = 0;
#define PREP_W(SRC, OFF, KS, KK, NN, LD, MODE) do { const WDesc d{SRC, (bf16_t*)(ws + OFF), KS, KK, NN, LD, MODE}; const int ntk = (KK) / 64, ntile = ntk * ((NN) / 64); \
      int first = ((int)blockIdx.x - base) % (int)gridDim.x; if (first < 0) first += gridDim.x; \
      for (int t = first; t < ntile; t += gridDim.x) prep_tile(d, t % ntk, t / ntk, p, (LAS float*)lds); \
      base = (base + ntile) % (int)gridDim.x; } while (0)
    PREP_W(p.ffn1_wgu, O_WGU1, nullptr, 1024, 5632, 5632, 1);
    PREP_W(p.ffn1_wd, O_WD1, nullptr, 2816, 1024, 1024, 0);
    PREP_W(p.ffn2_wgu, O_WGU2, nullptr, 1024, 5632, 5632, 1);
    PREP_W(p.ffn2_wd, O_WD2, nullptr, 2816, 1024, 1024, 0);
    PREP_W(p.w_in, O_WINQ, nullptr, 1024, 768, 4576, 2);
    PREP_W(p.w_in, O_WINR, nullptr, 1024, 2048, 4576, 3);
    PREP_W(p.w_in, O_WING, nullptr, 1024, 2048, 4576, 4);
    PREP_W(p.w_uq, O_WUQ, p.q_norm_g, 384, 768, 768, 5);
    PREP_W(p.w_ukv, O_WUKV, p.kv_norm_g, 256, 1024, 1024, 0);
    PREP_W(p.p_mla, O_PMLA, nullptr, 512, 1024, 1024, 0);
    PREP_W(p.p_rwkv, O_PRWKV, nullptr, 512, 1024, 1024, 0);
    PREP_W(p.w_o, O_WO, nullptr, 1024, 1024, 1024, 0);
    PREP_W(nullptr, O_WLORA, nullptr, 384, 2048, 0, 7);
    PREP_W(p.w_cq, O_WCQ, nullptr, 1024, 512, 512, 0);
    PREP_W(p.w_ckv, O_WCKV, nullptr, 1024, 1024, 1024, 0);
    PREP_W(p.w_co, O_WCO, nullptr, 512, 1024, 1024, 0);
#undef PREP_W
    for (size_t i = (size_t)blockIdx.x * 512 + tid; i < (size_t)T * DM / 8; i += (size_t)gridDim.x * 512) {
      const size_t e = i * 8; const float* src = (e < 65536ull * DM) ? p.x_p + e : p.x_s + (e - 65536ull * DM);
      const f32x4 a = *(const f32x4*)src, b = *(const f32x4*)(src + 4); const float f[8] = {a[0], a[1], a[2], a[3], b[0], b[1], b[2], b[3]};
      *(u32x4*)(xb + e) = pack8(f);
    }
    {
      bf16_t* memln = (bf16_t*)(ws + O_MEMLN);
      for (int row = gwave; row < 5120; row += nwave) {
        const float* rp = (row < 4096) ? p.mem_p + (size_t)row * DM : p.mem_s + (size_t)(row - 4096) * DM; f32x4 v[4]; float s = 0.f;
#pragma unroll
        for (int i = 0; i < 4; ++i) { v[i] = *(const f32x4*)(rp + i * 256 + lane * 4); s += (v[i][0] + v[i][1]) + (v[i][2] + v[i][3]); }
        const float mean = wave_sum(s) * (1.0f / 1024.0f); float q = 0.f;
#pragma unroll
        for (int i = 0; i < 4; ++i) { v[i] -= mean; q += (v[i][0] * v[i][0] + v[i][1] * v[i][1]) + (v[i][2] * v[i][2] + v[i][3] * v[i][3]); }
        const float rs = 1.0f / sqrtf(wave_sum(q) * (1.0f / 1024.0f) + 1e-5f);
#pragma unroll
        for (int i = 0; i < 4; ++i) { const f32x4 o = v[i] * rs * *(const f32x4*)(p.mem_g + i * 256 + lane * 4) + *(const f32x4*)(p.mem_b + i * 256 + lane * 4);
          u32x2 w; w.x = cvt_pk_bf16(o[0], o[1]); w.y = cvt_pk_bf16(o[2], o[3]); *(u32x2*)(memln + (size_t)row * DM + i * 256 + lane * 4) = w; }
      }
    }
    for (int i = blockIdx.x * 512 + tid; i < 4096 * 16; i += gridDim.x * 512) {
      const int s = i >> 4, j = i & 15; const float inv = 1.0f / powf(10000.0f, (float)(2 * j) / 32.0f); const float ang = (float)s * inv;
      rope[s * 32 + j] = cosf(ang); rope[s * 32 + 16 + j] = sinf(ang);
    }
  }
  }
  grid.sync();
#pragma nounroll
  for (int step = 1; step < 26; ++step) {
    unsigned char* ws = p.ws; asm volatile("" : "+s"(ws));
    unsigned zero_l = 0u; asm volatile("" : "+s"(zero_l));
    int tid = wave_s * 64 + (int)__builtin_amdgcn_mbcnt_hi(~0u, __builtin_amdgcn_mbcnt_lo(~0u, zero_l)); asm volatile("" : "+v"(tid));
    const int lane = tid & 63, wid = tid >> 6;
    const int gwave = blockIdx.x * 8 + wid, nwave = gridDim.x * 8;
    bf16_t* xb = (bf16_t*)(ws + O_XB);
    float* rope = (float*)(ws + O_ROPE);
    float* rstd = (float*)(ws + O_RSTD);
    PTab ptab = (PTab)(ws + O_PTAB);
    int kind = 0; bool sync = true; const float* lng = nullptr; const float* lnb = nullptr; bf16_t* lnxb = xb;
    switch (step) {
      case 1: kind = 1; sync = false; break;
      case 2: kind = 1; break;
      case 3: kind = 1; break;
      case 4: kind = 0; sync = false; break;
      case 5: kind = 1; sync = false; break;
      case 6: kind = 1; break;
      case 7: kind = 4; break;
      case 8: kind = 1; break;
      case 9: kind = 5; break;
      case 10: kind = 6; break;
      case 11: kind = 1; sync = false; break;
      case 12: kind = 1; sync = false; break;
      case 13: kind = 1; break;
      case 14: kind = 7; break;
      case 15: kind = 1; sync = false; break;
      case 16: kind = 1; break;
      case 17: kind = 1; break;
      case 18: kind = 0; sync = false; break;
      case 19: kind = 1; break;
      case 20: kind = 8; break;
      case 21: kind = 1; break;
      case 22: kind = 0; sync = false; break;
      case 23: kind = 1; break;
      case 24: kind = 1; break;
      default: kind = 0; sync = false; break;
    }
    if (step == 11 && (EN & 8)) {
      const bf16_t* __restrict__ hqkv = (const bf16_t*)(ws + O_HQKV); bf16_t* __restrict__ Kb = (bf16_t*)(ws + O_K);
      for (int it = blockIdx.x * 512 + tid; it < T * 4; it += gridDim.x * 512) {
        const int t = it >> 2, q = it & 3, s = t & 4095, b = t >> 12;
        const u32x2 w1 = *(const GAS u32x2*)(hqkv + (size_t)t * 768 + 640 + 4 * q), w2 = *(const GAS u32x2*)(hqkv + (size_t)t * 768 + 656 + 4 * q);
        const f32x4 c = *(const GAS f32x4*)(rope + s * 32 + 4 * q), sn = *(const GAS f32x4*)(rope + s * 32 + 16 + 4 * q);
        const f32x4 x1 = (f32x4){__uint_as_float(w1.x << 16), __uint_as_float(w1.x & 0xffff0000u), __uint_as_float(w1.y << 16), __uint_as_float(w1.y & 0xffff0000u)};
        const f32x4 x2 = (f32x4){__uint_as_float(w2.x << 16), __uint_as_float(w2.x & 0xffff0000u), __uint_as_float(w2.y << 16), __uint_as_float(w2.y & 0xffff0000u)};
        const f32x4 o1 = x1 * c - x2 * sn, o2 = x1 * sn + x2 * c;
        u32x4 w; w.x = cvt_pk_bf16(o1[0], o1[1]); w.y = cvt_pk_bf16(o1[2], o1[3]); w.z = cvt_pk_bf16(o2[0], o2[1]); w.w = cvt_pk_bf16(o2[2], o2[3]);
#pragma unroll
        for (int h = 0; h < 8; ++h) *(GAS u32x4*)(Kb + ((size_t)(b * 8 + h) * SEQ + s) * 96 + 64 + 8 * q) = w;
      }
    }
    if (kind == 1) { if (EN & 1) gemm_phase(lds, step, ptab, ws, tid); }
    else if (kind == 2) { if (EN & 2) ln_phase(((float*)PT(out)), lng, lnb, lnxb, true, tid); }
    else if (kind == 4 && (EN & 8)) {
  {
    const bf16_t* __restrict__ hr = (const bf16_t*)(ws + O_HR); const bf16_t* __restrict__ hqkv = (const bf16_t*)(ws + O_HQKV); bf16_t* __restrict__ lin = (bf16_t*)(ws + O_LIN);
    const float* __restrict__ mup = PT(mu_prev) + 1536; const float* __restrict__ mun = PT(mu_next) + 1536;
#pragma unroll 2
    for (int it = blockIdx.x * 512 + tid; it < T * 48; it += gridDim.x * 512) {
      const int t = it / 48, g = it - t * 48; u32x4 ow = (u32x4){0u, 0u, 0u, 0u};
      if (g < 40) {
        const int s = t & 4095; const bf16_t* hp = hr + (size_t)t * 1856 + 1536 + g * 8;
        float c[8], pv[8], nv[8], o[8]; unpack8(*(const u32x4*)hp, c);
        unpack8((s > 0) ? *(const GAS u32x4*)(hp - 1856) : (u32x4){0u, 0u, 0u, 0u}, pv); unpack8((s < 4095) ? *(const GAS u32x4*)(hp + 1856) : (u32x4){0u, 0u, 0u, 0u}, nv);
        const f32x4 mp0 = *(const GAS f32x4*)(mup + g * 8), mp1 = *(const GAS f32x4*)(mup + g * 8 + 4), mn0 = *(const GAS f32x4*)(mun + g * 8), mn1 = *(const GAS f32x4*)(mun + g * 8 + 4);
#pragma unroll
        for (int i = 0; i < 8; ++i) { const float m1 = i < 4 ? mp0[i & 3] : mp1[i & 3], m2 = i < 4 ? mn0[i & 3] : mn1[i & 3]; float v = c[i] + m1 * (pv[i] - c[i]) + m2 * (nv[i] - c[i]);
          if (g < 16) v = 1.0f - 2.0f / (1.0f + __expf(2.0f * v)); else if (g >= 24) v = sigmoidf_(v);
          o[i] = v; }
        ow = pack8(o);
      }
      *(GAS u32x4*)(lin + (size_t)t * 384 + g * 8) = ow;
    }
    for (int t4 = gwave; t4 < T / 4; t4 += nwave) {
      const int t = t4 * 4 + (lane >> 4), l16 = lane & 15; float sq = 0.f, skv = 0.f;
#pragma unroll
      for (int j = 0; j < 5; ++j) { const int k = j * 16 + l16; float f[8]; unpack8(*(const GAS u32x4*)(hqkv + (size_t)t * 768 + k * 8), f); float ss = 0.f;
#pragma unroll
        for (int i = 0; i < 8; ++i) ss += f[i] * f[i];
        if (k < 48) sq += ss; else skv += ss; }
      sq = row16_sum(sq); skv = row16_sum(skv);
      if (l16 == 0) { rstd[(size_t)t * 2] = 1.0f / sqrtf(sq * (1.0f / 384.0f) + 1e-6f); rstd[(size_t)t * 2 + 1] = 1.0f / sqrtf(skv * (1.0f / 256.0f) + 1e-6f); }
    }
  }
    } else if (kind == 5 && (EN & 16)) {
  {
    const bf16_t* hr = (const bf16_t*)(ws + O_HR); const bf16_t* lo = (const bf16_t*)(ws + O_LOUT); bf16_t* yb = (bf16_t*)(ws + O_Y);
    const int dir = tid >> 8, td = tid & 255;
    LAS float* Wl = (LAS float*)(lds + dir * 57344); LAS float* Al = Wl + 2048; LAS float* Bl = Wl + 4096; LAS float* Kl = Wl + 6144; LAS float* Rl = Wl + 8192; LAS float* Vl = Wl + 10240; LAS float* Yl = Wl + 12288;
    const int ptt = td >> 3, pc8 = td & 7;
    const int rq = td >> 3, cgp = td & 7;
    LAS float* Cst = (LAS float*)(lds + 2 * 57344 + 12288);
    LAS float* ybase = (cgp == 0) ? (Yl + 2 * rq) : ((LAS float*)(lds + 2 * 57344) + 2 * tid);
    for (int unit = blockIdx.x; unit < NBATCH * 8; unit += gridDim.x) {
      const int b = unit >> 3, h = unit & 7;
      {
        const int arr = tid >> 6, c = tid & 63;
        const float* src = arr < 3 ? PT(mu_prev) + arr * 512 + h * 64 + c : arr < 6 ? PT(mu_next) + (arr - 3) * 512 + h * 64 + c : arr == 6 ? PT(k_k) + h * 64 + c : PT(k_a) + h * 64 + c;
        Cst[arr * 64 + c] = *src;
      }
      __syncthreads();
      const bf16_t* hrb = hr + (size_t)b * SEQ * 1856 + h * 64 + pc8 * 8; const bf16_t* lob = lo + (size_t)b * SEQ * 2048 + h * 64 + pc8 * 8;
      f32x2 S[2][4];
#pragma unroll
      for (int r = 0; r < 2; ++r)
#pragma unroll
        for (int j = 0; j < 4; ++j) S[r][j] = (f32x2){0.f, 0.f};
      u32x4 ld_c[3], ld_p[3], ld_n[3], ld_w, ld_a;
#define SCAN_LOAD(nch) do { const int t0_ = dir ? SEQ - 32 * ((nch) + 1) : 32 * (nch); const int t_ = t0_ + ptt; const bf16_t* rp_ = hrb + (size_t)t_ * 1856; \
        _Pragma("unroll") for (int a_ = 0; a_ < 3; ++a_) { ld_c[a_] = *(const GAS u32x4*)(rp_ + a_ * 512); ld_p[a_] = (t_ > 0) ? *(const GAS u32x4*)(rp_ + a_ * 512 - 1856) : (u32x4){0u, 0u, 0u, 0u}; ld_n[a_] = (t_ < SEQ - 1) ? *(const GAS u32x4*)(rp_ + a_ * 512 + 1856) : (u32x4){0u, 0u, 0u, 0u}; } \
        ld_w = *(const GAS u32x4*)(lob + (size_t)t_ * 2048 + dir * 512); ld_a = *(const GAS u32x4*)(lob + (size_t)t_ * 2048 + 1024); } while (0)
      SCAN_LOAD(0);
      for (int nch = 0; nch < SEQ / 32; ++nch) {
        {
          float sh[3][8];
#pragma unroll
          for (int a = 0; a < 3; ++a) {
            float c[8], pv[8], nv[8]; unpack8(ld_c[a], c); unpack8(ld_p[a], pv); unpack8(ld_n[a], nv);
            const LAS float* mpp = Cst + a * 64 + pc8 * 8; const LAS float* mnp = Cst + (3 + a) * 64 + pc8 * 8;
#pragma unroll
            for (int i = 0; i < 8; ++i) sh[a][i] = c[i] + mpp[i] * (pv[i] - c[i]) + mnp[i] * (nv[i] - c[i]);
          }
          float lw[8], av[8]; unpack8(ld_w, lw); unpack8(ld_a, av);
          float kk[8], ss = 0.f;
#pragma unroll
          for (int i = 0; i < 8; ++i) { kk[i] = sh[1][i] * Cst[6 * 64 + pc8 * 8 + i]; ss += kk[i] * kk[i]; }
          ss = oct_sum(ss);
          const float inrm = 1.0f / fmaxf(sqrtf(ss), 1e-12f);
          float ow[8], oa[8], ob[8], ok[8];
#pragma unroll
          for (int i = 0; i < 8; ++i) { const float kn = kk[i] * inrm; ow[i] = __builtin_amdgcn_exp2f(lw[i]); oa[i] = -kn; ob[i] = kn * av[i]; ok[i] = sh[1][i] * (1.0f + (av[i] - 1.0f) * Cst[7 * 64 + pc8 * 8 + i]); }
          const int o = (dir ? 31 - ptt : ptt) * 64 + pc8 * 8;
          *(LAS f32x4*)(Wl + o) = (f32x4){ow[0], ow[1], ow[2], ow[3]}; *(LAS f32x4*)(Wl + o + 4) = (f32x4){ow[4], ow[5], ow[6], ow[7]};
          *(LAS f32x4*)(Al + o) = (f32x4){oa[0], oa[1], oa[2], oa[3]}; *(LAS f32x4*)(Al + o + 4) = (f32x4){oa[4], oa[5], oa[6], oa[7]};
          *(LAS f32x4*)(Bl + o) = (f32x4){ob[0], ob[1], ob[2], ob[3]}; *(LAS f32x4*)(Bl + o + 4) = (f32x4){ob[4], ob[5], ob[6], ob[7]};
          *(LAS f32x4*)(Kl + o) = (f32x4){ok[0], ok[1], ok[2], ok[3]}; *(LAS f32x4*)(Kl + o + 4) = (f32x4){ok[4], ok[5], ok[6], ok[7]};
          *(LAS f32x4*)(Rl + o) = (f32x4){sh[0][0], sh[0][1], sh[0][2], sh[0][3]}; *(LAS f32x4*)(Rl + o + 4) = (f32x4){sh[0][4], sh[0][5], sh[0][6], sh[0][7]};
          *(LAS f32x4*)(Vl + o) = (f32x4){sh[2][0], sh[2][1], sh[2][2], sh[2][3]}; *(LAS f32x4*)(Vl + o + 4) = (f32x4){sh[2][4], sh[2][5], sh[2][6], sh[2][7]};
        }
        __syncthreads();
        if (nch + 1 < SEQ / 32) SCAN_LOAD(nch + 1);
        {
          f32x4 opA[11], opB[11];
#define SC_LOAD(dst, st_) do { const int tt_ = (st_); const int o_ = tt_ * 64 + cgp * 8; \
            dst[0] = *(const LAS f32x4*)(Wl + o_); dst[1] = *(const LAS f32x4*)(Wl + o_ + 4); dst[2] = *(const LAS f32x4*)(Al + o_); dst[3] = *(const LAS f32x4*)(Al + o_ + 4); \
            dst[4] = *(const LAS f32x4*)(Bl + o_); dst[5] = *(const LAS f32x4*)(Bl + o_ + 4); dst[6] = *(const LAS f32x4*)(Kl + o_); dst[7] = *(const LAS f32x4*)(Kl + o_ + 4); \
            dst[8] = *(const LAS f32x4*)(Rl + o_); dst[9] = *(const LAS f32x4*)(Rl + o_ + 4); { const f32x2 v2_ = *(const LAS f32x2*)(Vl + tt_ * 64 + 2 * rq); dst[10] = (f32x4){v2_.x, v2_.y, 0.f, 0.f}; } } while (0)
#define SC_STEP(op, st_) do { const int tt_ = (st_); \
            f32x2 wv[4], av[4], bv[4], kv[4], rv[4]; \
            _Pragma("unroll") for (int i = 0; i < 2; ++i) { wv[2 * i] = (f32x2){op[i][0], op[i][1]}; wv[2 * i + 1] = (f32x2){op[i][2], op[i][3]}; av[2 * i] = (f32x2){op[2 + i][0], op[2 + i][1]}; av[2 * i + 1] = (f32x2){op[2 + i][2], op[2 + i][3]}; \
              bv[2 * i] = (f32x2){op[4 + i][0], op[4 + i][1]}; bv[2 * i + 1] = (f32x2){op[4 + i][2], op[4 + i][3]}; kv[2 * i] = (f32x2){op[6 + i][0], op[6 + i][1]}; kv[2 * i + 1] = (f32x2){op[6 + i][2], op[6 + i][3]}; \
              rv[2 * i] = (f32x2){op[8 + i][0], op[8 + i][1]}; rv[2 * i + 1] = (f32x2){op[8 + i][2], op[8 + i][3]}; } \
            float yo[2]; \
            _Pragma("unroll") for (int r = 0; r < 2; ++r) { \
              f32x2 c = S[r][0] * av[0]; c += S[r][1] * av[1]; c += S[r][2] * av[2]; c += S[r][3] * av[3]; \
              float sa = c.x + c.y; sa += dpp_f<0xB1>(sa); sa += dpp_f<0x4E>(sa); sa += dpp_f<0x141>(sa); \
              const f32x2 sav = (f32x2){sa, sa}, vv = (f32x2){op[10][r], op[10][r]}; \
              f32x2 y = (f32x2){0.f, 0.f}; \
              _Pragma("unroll") for (int j = 0; j < 4; ++j) { const f32x2 n = S[r][j] * wv[j] + (bv[j] * sav + kv[j] * vv); S[r][j] = n; y += n * rv[j]; } \
              float ys = y.x + y.y; ys += dpp_f<0xB1>(ys); ys += dpp_f<0x4E>(ys); ys += dpp_f<0x141>(ys); yo[r] = ys; } \
            *(LAS f32x2*)(ybase + tt_ * 64) = (f32x2){yo[0], yo[1]}; } while (0)
          SC_LOAD(opA, 0);
#pragma unroll 1
          for (int st = 0; st < 32; st += 8) {
#pragma unroll
            for (int u = 0; u < 8; u += 2) {
              asm volatile("" :: "v"(opA[10][0])); __builtin_amdgcn_sched_barrier(0);
              SC_LOAD(opB, st + u + 1); __builtin_amdgcn_sched_barrier(0);
              SC_STEP(opA, st + u); __builtin_amdgcn_sched_barrier(0);
              asm volatile("" :: "v"(opB[10][0])); __builtin_amdgcn_sched_barrier(0);
              SC_LOAD(opA, (st + u + 2) & 31); __builtin_amdgcn_sched_barrier(0);
              SC_STEP(opB, st + u + 1); __builtin_amdgcn_sched_barrier(0);
            }
          }
#undef SC_LOAD
#undef SC_STEP
        }
        __syncthreads();
        {
          const int t0 = dir ? SEQ - 32 * (nch + 1) : 32 * nch; const int ys = (dir ? 31 - ptt : ptt) * 64 + pc8 * 8; const f32x4 y0 = *(const LAS f32x4*)(Yl + ys), y1 = *(const LAS f32x4*)(Yl + ys + 4);
          const float f[8] = {y0[0], y0[1], y0[2], y0[3], y1[0], y1[1], y1[2], y1[3]};
          *(GAS u32x4*)(yb + ((size_t)dir * T + (size_t)b * SEQ + t0 + ptt) * 512 + h * 64 + pc8 * 8) = pack8(f);
        }
      }
#undef SCAN_LOAD
      __syncthreads();
    }
  }
    } else if (kind == 6 && (EN & 32)) {
  {
    const bf16_t* __restrict__ hr = (const bf16_t*)(ws + O_HR); const bf16_t* __restrict__ lo = (const bf16_t*)(ws + O_LOUT); const bf16_t* __restrict__ yb = (const bf16_t*)(ws + O_Y); bf16_t* __restrict__ bout = (bf16_t*)(ws + O_BOUT);
    const int c0 = lane * 8;
    float mpv[3][8], mnv[3][8], kav[8], rkv[8], lgv[8], lbv[8];
#pragma unroll
    for (int i = 0; i < 8; ++i) {
#pragma unroll
      for (int a = 0; a < 3; ++a) { mpv[a][i] = PT(mu_prev)[a * 512 + c0 + i]; mnv[a][i] = PT(mu_next)[a * 512 + c0 + i]; }
      kav[i] = PT(k_a)[c0 + i]; rkv[i] = PT(r_k)[c0 + i]; lgv[i] = PT(lnx_g)[c0 + i]; lbv[i] = PT(lnx_b)[c0 + i]; }
#pragma unroll 2
    for (int t = gwave; t < T; t += nwave) {
      const int s = t & 4095;
      float sh[3][8];
#pragma unroll
      for (int a = 0; a < 3; ++a) {
        const bf16_t* rp = hr + (size_t)t * 1856 + a * 512 + c0; float c[8], pv[8], nv[8]; unpack8(*(const u32x4*)rp, c);
        if (s > 0) unpack8(*(const GAS u32x4*)(rp - 1856), pv); else {
#pragma unroll
          for (int i = 0; i < 8; ++i) pv[i] = 0.f; }
        if (s < 4095) unpack8(*(const GAS u32x4*)(rp + 1856), nv); else {
#pragma unroll
          for (int i = 0; i < 8; ++i) nv[i] = 0.f; }
#pragma unroll
        for (int i = 0; i < 8; ++i) sh[a][i] = c[i] + mpv[a][i] * (pv[i] - c[i]) + mnv[a][i] * (nv[i] - c[i]);
      }
      float av[8], gv[8], yf[8], ybk[8];
      unpack8(*(const GAS u32x4*)(lo + (size_t)t * 2048 + 1024 + c0), av); unpack8(*(const GAS u32x4*)(lo + (size_t)t * 2048 + 1536 + c0), gv);
      unpack8(*(const GAS u32x4*)(yb + (size_t)t * 512 + c0), yf); unpack8(*(const GAS u32x4*)(yb + ((size_t)T + t) * 512 + c0), ybk);
      float y[8], sy = 0.f, sb = 0.f;
#pragma unroll
      for (int i = 0; i < 8; ++i) { y[i] = yf[i] + ybk[i]; sy += y[i]; const float km = sh[1][i] * (1.0f + (av[i] - 1.0f) * kav[i]); sb += sh[0][i] * km * rkv[i]; }
      sy = oct_sum(sy); sb = oct_sum(sb);
      const float mu = sy * (1.0f / 64.0f); float sv = 0.f;
#pragma unroll
      for (int i = 0; i < 8; ++i) { y[i] -= mu; sv += y[i] * y[i]; }
      sv = oct_sum(sv);
      const float rs = 1.0f / sqrtf(sv * (1.0f / 64.0f) + 64e-5f);
      float o[8];
#pragma unroll
      for (int i = 0; i < 8; ++i) o[i] = ((y[i] * rs) * lgv[i] + lbv[i] + sb * sh[2][i]) * gv[i];
      *(GAS u32x4*)(bout + (size_t)t * 512 + c0) = pack8(o);
    }
  }
    } else if (kind == 7 && (EN & 64)) {
  {
    const bf16_t* Q = (const bf16_t*)(ws + O_Q); const bf16_t* K = (const bf16_t*)(ws + O_K); const bf16_t* Vt = (const bf16_t*)(ws + O_VT); bf16_t* ao = (bf16_t*)(ws + O_AOUT);
    for (int unit = blockIdx.x; unit < NBATCH * 8 * 16; unit += gridDim.x) {
      const int qb = unit & 15, bh = unit >> 4, b = bh >> 3, h = bh & 7;
      attn_unit_pp<96, 64>(Q + ((size_t)bh * SEQ + qb * 256) * 96, 96, K + (size_t)bh * SEQ * 96, 96, Vt + (size_t)bh * 64 * SEQ, SEQ, SEQ, ao + ((size_t)b * SEQ + qb * 256) * 512 + h * 64, 512, lds, tid);
    }
  }
    } else if (kind == 8 && (EN & 128)) {
  {
    const bf16_t* cq = (const bf16_t*)(ws + O_CQ); const bf16_t* Kc = (const bf16_t*)(ws + O_KC); const bf16_t* VcT = (const bf16_t*)(ws + O_VCT); bf16_t* co = (bf16_t*)(ws + O_CO);
    for (int unit = blockIdx.x; unit < (T / 256) * 4; unit += gridDim.x) {
      const int h = unit & 3, rb = unit >> 2, b = rb >> 4;
      attn_unit<128, 128, false>(cq + (size_t)rb * 256 * 512 + h * 128, 512, Kc + (size_t)b * 256 * 512 + h * 128, 512, VcT + (size_t)(b * 4 + h) * 128 * 256, 256, 256, co + (size_t)rb * 256 * 512 + h * 128, 512, lds, tid);
    }
  }
    }
    if (sync && step != 25) { ++nbar; fast_barrier((unsigned*)(p.ws + O_PTAB + 512), nbar * gridDim.x, tid); }
  }
}

extern "C" void kernel_launch(void* const* d_in, const int* in_sizes, int n_in, void* d_out, int out_size, void* d_ws, size_t ws_size, hipStream_t stream) {
  static int grid_blocks = 0;
  if (!grid_blocks) {
    int dev = 0, cus = 0, per_cu = 0;
    (void)hipGetDevice(&dev);
    (void)hipDeviceGetAttribute(&cus, hipDeviceAttributeMultiprocessorCount, dev);
    (void)hipFuncSetAttribute((const void*)fwd_mega, hipFuncAttributeMaxDynamicSharedMemorySize, LDS_BYTES);
    (void)hipOccupancyMaxActiveBlocksPerMultiprocessor(&per_cu, fwd_mega, 512, LDS_BYTES);
    if (per_cu < 1) per_cu = 1;
    grid_blocks = cus * per_cu;
    if (grid_blocks > 256) grid_blocks = 256;
  }
  Params p{};
  const float** pp = (const float**)&p;
  for (int i = 0; i < 42; ++i) pp[i] = (const float*)d_in[i];
  p.out = (float*)d_out; p.ws = (unsigned char*)d_ws;
  void* args[] = {&p};
  hipError_t e = hipLaunchCooperativeKernel((void*)fwd_mega, dim3(grid_blocks), dim3(512), args, LDS_BYTES, stream);
  if (e != hipSuccess) fprintf(stderr, "cooperative launch failed: %s (grid %d)\n", hipGetErrorString(e), grid_blocks);
}
```

```cpp
#include <hip/hip_runtime.h>
#include <hip/hip_cooperative_groups.h>
#include <cstdio>
namespace cg = cooperative_groups;

#define LAS __attribute__((address_space(3)))
#define GAS __attribute__((address_space(1)))
#define ASSUME_GLOBAL(p) do { (p) = (unsigned char*)(__attribute__((address_space(1))) unsigned char*)(p); } while (0)
typedef unsigned short bf16_t;
typedef short bf16x8 __attribute__((ext_vector_type(8)));
typedef float f32x4 __attribute__((ext_vector_type(4)));
typedef float f32x2 __attribute__((ext_vector_type(2)));
typedef unsigned u32x4 __attribute__((ext_vector_type(4)));
typedef unsigned u32x2 __attribute__((ext_vector_type(2)));

constexpr int T = 81920, SEQ = 4096, NBATCH = 20, DM = 1024, DFF = 2816;
constexpr float ALPHA = 1.189207115002721f;
constexpr float LOG2E = 1.4426950408889634f;
constexpr float QSCALE = 0.10206207261596577f * LOG2E;
constexpr float CQSCALE = 0.08838834764831845f * LOG2E;
constexpr int LDS_BYTES = 142 * 1024;
#ifndef EN
#define EN 255
#endif
#ifndef LNX
#define LNX 0
#endif

constexpr size_t al256(size_t x) { return (x + 255) & ~(size_t)255; }
constexpr size_t O_WGU1 = 0;
constexpr size_t O_WD1 = O_WGU1 + 5632ull * 1024 * 2;
constexpr size_t O_WGU2 = O_WD1 + 1024ull * 2816 * 2;
constexpr size_t O_WD2 = O_WGU2 + 5632ull * 1024 * 2;
constexpr size_t O_WINQ = O_WD2 + 1024ull * 2816 * 2;
constexpr size_t O_WINR = O_WINQ + 768ull * 1024 * 2;
constexpr size_t O_WING = O_WINR + 2048ull * 1024 * 2;
constexpr size_t O_WUQ = O_WING + 2048ull * 1024 * 2;
constexpr size_t O_WUKV = O_WUQ + 768ull * 384 * 2;
constexpr size_t O_PMLA = O_WUKV + 1024ull * 256 * 2;
constexpr size_t O_PRWKV = O_PMLA + 1024ull * 512 * 2;
constexpr size_t O_WO = O_PRWKV + 1024ull * 512 * 2;
constexpr size_t O_WLORA = O_WO + 1024ull * 1024 * 2;
constexpr size_t O_WCQ = O_WLORA + 2048ull * 384 * 2;
constexpr size_t O_WCKV = O_WCQ + 512ull * 1024 * 2;
constexpr size_t O_WCO = O_WCKV + 1024ull * 1024 * 2;
constexpr size_t O_ROPE = O_WCO + 1024ull * 512 * 2;
constexpr size_t O_RSTD = O_ROPE + 4096ull * 32 * 4;
constexpr size_t O_MEMLN = O_RSTD + (size_t)T * 2 * 4;
constexpr size_t O_KC = O_MEMLN + 5120ull * 1024 * 2;
constexpr size_t O_VCT = O_KC + 5120ull * 512 * 2;
constexpr size_t O_PTAB = O_VCT + 5120ull * 512 * 2;
constexpr size_t O_XCH = O_PTAB + 1024;
constexpr size_t O_CNT = O_XCH + (size_t)T * 4 * 8;
constexpr size_t O_XB = O_CNT + 4ull * 320 * 256;
constexpr size_t O_ARENA = O_XB + (size_t)T * 1024 * 2;
constexpr size_t O_HR = O_ARENA;
constexpr size_t O_LOUT = O_HR + (size_t)T * 1856 * 2;
constexpr size_t O_LIN = O_LOUT + (size_t)T * 2048 * 2;
constexpr size_t O_Y = O_LIN + (size_t)T * 384 * 2;
constexpr size_t O_BOUT = O_Y + 2ull * T * 512 * 2;
constexpr size_t O_HQKV = O_BOUT + (size_t)T * 512 * 2;
constexpr size_t O_END = O_HQKV + (size_t)T * 768 * 2;
static_assert(O_END <= 1342177280ull, "workspace");
constexpr size_t O_GATES = O_ARENA;
constexpr size_t O_Q = O_GATES + (size_t)T * 2048 * 2;
constexpr size_t O_K = O_Q + (size_t)T * 768 * 2;
constexpr size_t O_VT = O_K + (size_t)T * 768 * 2;
constexpr size_t O_AOUT = O_VT + (size_t)T * 512 * 2;
static_assert(O_AOUT + (size_t)T * 512 * 2 <= O_BOUT, "overlap");
constexpr size_t O_MIX = O_Q;
static_assert(O_MIX + (size_t)T * 1024 * 2 <= O_AOUT, "overlap");
constexpr size_t O_CQ = O_ARENA;
constexpr size_t O_CO = O_CQ + (size_t)T * 512 * 2;
constexpr size_t O_HFF = O_ARENA;

struct Params {
  const float *x_p, *x_s, *mem_p, *mem_s;
  const float *ln1_g, *ln1_b, *ffn1_wgu, *ffn1_wd, *w_in, *b_gate, *q_norm_g, *w_uq, *kv_norm_g, *w_ukv, *p_mla, *mu_prev, *mu_next, *w0, *w_up, *a0, *a_up, *g_up,
      *k_k, *k_a, *r_k, *lnx_g, *lnx_b, *p_rwkv, *w_o, *ln2_g, *ln2_b, *mem_g, *mem_b, *w_cq, *w_ckv, *w_co, *ln3_g, *ln3_b, *ffn2_wgu, *ffn2_wd, *ln4_g, *ln4_b;
  float* out; unsigned char* ws;
};

enum { I_x_p, I_x_s, I_mem_p, I_mem_s, I_ln1_g, I_ln1_b, I_ffn1_wgu, I_ffn1_wd, I_w_in, I_b_gate, I_q_norm_g, I_w_uq, I_kv_norm_g, I_w_ukv, I_p_mla, I_mu_prev, I_mu_next, I_w0, I_w_up, I_a0, I_a_up, I_g_up, I_k_k, I_k_a, I_r_k, I_lnx_g, I_lnx_b, I_p_rwkv, I_w_o, I_ln2_g, I_ln2_b, I_mem_g, I_mem_b, I_w_cq, I_w_ckv, I_w_co, I_ln3_g, I_ln3_b, I_ffn2_wgu, I_ffn2_wd, I_ln4_g, I_ln4_b, I_out };
#define PT(name) (ptab[I_##name])
typedef const float* const* PTab;
__device__ __forceinline__ float bf2f(bf16_t b) { return __uint_as_float(((unsigned)b) << 16); }
__device__ __forceinline__ unsigned cvt_pk_bf16(float lo, float hi) { unsigned r; asm("v_cvt_pk_bf16_f32 %0, %1, %2" : "=v"(r) : "v"(lo), "v"(hi)); return r; }
__device__ __forceinline__ bf16_t f2bf(float f) { return (bf16_t)(cvt_pk_bf16(f, 0.f) & 0xffffu); }
__device__ __forceinline__ void unpack8(const u32x4 w, float* f) {
#pragma unroll
  for (int i = 0; i < 4; ++i) { f[2 * i] = __uint_as_float(w[i] << 16); f[2 * i + 1] = __uint_as_float(w[i] & 0xffff0000u); }
}
__device__ __forceinline__ u32x4 pack8(const float* f) { u32x4 w; w.x = cvt_pk_bf16(f[0], f[1]); w.y = cvt_pk_bf16(f[2], f[3]); w.z = cvt_pk_bf16(f[4], f[5]); w.w = cvt_pk_bf16(f[6], f[7]); return w; }
__device__ __forceinline__ float sigmoidf_(float x) { return 1.0f / (1.0f + __expf(-x)); }
template <int CTRL> __device__ __forceinline__ float dpp_f(float x) { return __builtin_bit_cast(float, __builtin_amdgcn_update_dpp(0, __builtin_bit_cast(int, x), CTRL, 0xf, 0xf, true)); }
__device__ __forceinline__ float quad_sum(float v) { v += dpp_f<0xB1>(v); v += dpp_f<0x4E>(v); return v; }
__device__ __forceinline__ float oct_sum(float v) { v += dpp_f<0xB1>(v); v += dpp_f<0x4E>(v); v += dpp_f<0x141>(v); return v; }
__device__ __forceinline__ float row16_sum(float v) { v = oct_sum(v); v += dpp_f<0x140>(v); return v; }

__device__ __forceinline__ float xrow16_max(float x) {
  auto s = __builtin_amdgcn_permlane16_swap(__float_as_uint(x), __float_as_uint(x), false, false);
  x = fmaxf(__uint_as_float(s[0]), __uint_as_float(s[1]));
  auto t = __builtin_amdgcn_permlane32_swap(__float_as_uint(x), __float_as_uint(x), false, false);
  return fmaxf(__uint_as_float(t[0]), __uint_as_float(t[1]));
}
__device__ __forceinline__ float xrow16_sum(float x) {
  auto s = __builtin_amdgcn_permlane16_swap(__float_as_uint(x), __float_as_uint(x), false, false);
  x = __uint_as_float(s[0]) + __uint_as_float(s[1]);
  auto t = __builtin_amdgcn_permlane32_swap(__float_as_uint(x), __float_as_uint(x), false, false);
  return __uint_as_float(t[0]) + __uint_as_float(t[1]);
}
__device__ __forceinline__ float wave_sum(float v) { return xrow16_sum(row16_sum(v)); }
constexpr int BM = 256, BK = 64, HALF = 128, HTB = HALF * BK * 2, STAGE_BYTES = 8 * HTB, NXCD = 8, WGM = 8;
__device__ __forceinline__ int lds_byte(int r, int c) { const int st = (r >> 4) * 2 + (c >> 5), rr = r & 15, cc = c & 31, ob = rr * 64 + cc * 2; return st * 1024 + (ob ^ (((ob >> 9) & 1) << 5)); }
__device__ __forceinline__ void stage_rc(int b, int& R, int& C) { const int st = b / 1024, sb = b % 1024, swz = sb ^ (((sb >> 9) & 1) << 5); R = (st >> 1) * 16 + swz / 64; C = (st & 1) * 32 + (swz % 64) / 2; }
__device__ __forceinline__ int perm32(int rho) { const int n = rho >> 4, i = rho & 15; return 8 * (i >> 2) + 4 * n + (i & 3); }
struct Unit { int pm, pn; };
struct Gemm { const bf16_t* A; const bf16_t* Bt; int M, N, K, lda, ldb; };
struct StaticOrder {
  int nM, nN, nwg, G, c;
  __device__ void init(int M, int N, int G_, int c_) { nM = M / BM; nN = N / BM; nwg = nM * nN; G = G_; c = c_; }
  __device__ bool next(int i, Unit& u) const {
    const long L = (long)i * G + c; if (L >= nwg) return false;
    int wgid = (int)L; { const int q = nwg / NXCD, r = nwg % NXCD, xcd = wgid % NXCD, off = wgid / NXCD; wgid = (xcd < r ? xcd * (q + 1) : r * (q + 1) + (xcd - r) * q) + off; }
    const int nig = WGM * nN, gid = wgid / nig, fm = gid * WGM, gsz = (nM - fm) < WGM ? (nM - fm) : WGM;
    u.pm = fm + ((wgid % nig) % gsz); u.pn = (wgid % nig) / gsz; return true;
  }
};

typedef f32x4 Acc[2][2][4][2];

struct EpiSwiglu {
  static constexpr bool PERM = true;
  bf16_t* H;
  __device__ __forceinline__ void operator()(const Acc& acc, const Unit& u, int wr, int wc, int fr, int fq) const {
    const int col0 = u.pn * 128 + wc * 32 + 8 * fq;
#pragma unroll
    for (int ai = 0; ai < 2; ++ai)
#pragma unroll
      for (int m = 0; m < 4; ++m) {
        const int row = u.pm * BM + ai * HALF + wr * 64 + m * 16 + fr;
        float o[8];
#pragma unroll
        for (int n = 0; n < 2; ++n)
#pragma unroll
          for (int j = 0; j < 4; ++j) { const float gte = acc[ai][0][m][n][j], up = acc[ai][1][m][n][j]; o[n * 4 + j] = gte * up / (1.0f + __expf(-gte)); }
        *(GAS u32x4*)(H + (size_t)row * DFF + col0) = pack8(o);
      }
  }
};

__device__ __forceinline__ f32x4 sig4(f32x4 v) { f32x4 o; o[0] = sigmoidf_(v[0]); o[1] = sigmoidf_(v[1]); o[2] = sigmoidf_(v[2]); o[3] = sigmoidf_(v[3]); return o; }
__device__ __forceinline__ float dec1(float x) { return -(0.6065306597126334f * LOG2E) / (1.0f + __expf(-x)); }
__device__ __forceinline__ f32x4 dec4(f32x4 v) { f32x4 o; o[0] = dec1(v[0]); o[1] = dec1(v[1]); o[2] = dec1(v[2]); o[3] = dec1(v[3]); return o; }
template <int ACT>
struct EpiBf16 {
  static constexpr bool PERM = true;
  bf16_t* O; int ldc; int ncols; float scale; const float* bias; const float* w0; const float* a0;
  __device__ __forceinline__ void operator()(const Acc& acc, const Unit& u, int wr, int wc, int fr, int fq) const {
#pragma unroll
    for (int bj = 0; bj < 2; ++bj) {
      const int c0 = u.pn * BM + bj * HALF + wc * 32 + 8 * fq;
      const bool active = c0 < ncols;
      f32x4 b0 = (f32x4){0.f, 0.f, 0.f, 0.f}, b1 = (f32x4){0.f, 0.f, 0.f, 0.f};
      if (ACT == 1) { b0 = *(const GAS f32x4*)(bias + c0); b1 = *(const GAS f32x4*)(bias + c0 + 4); }
      if (ACT == 2) { if (u.pn < 6) { const float* src = (u.pn < 4) ? (w0 + c0) : (a0 + (c0 - 1024)); b0 = *(const GAS f32x4*)(src); b1 = *(const GAS f32x4*)(src + 4); } }
#pragma unroll
      for (int ai = 0; ai < 2; ++ai)
#pragma unroll
        for (int m = 0; m < 4; ++m) {
          const int row = u.pm * BM + ai * HALF + wr * 64 + m * 16 + fr;
          f32x4 v0 = acc[ai][bj][m][0], v1 = acc[ai][bj][m][1];
          if (ACT == 0) { v0 *= scale; v1 *= scale; }
          if (ACT == 1) { v0 = sig4(v0 + b0); v1 = sig4(v1 + b1); }
          if (ACT == 2) { if (u.pn < 4) { v0 = dec4(v0 + b0); v1 = dec4(v1 + b1); } else if (u.pn < 6) { v0 = sig4(v0 + b0); v1 = sig4(v1 + b1); } }
          u32x4 w; w.x = cvt_pk_bf16(v0[0], v0[1]); w.y = cvt_pk_bf16(v0[2], v0[3]); w.z = cvt_pk_bf16(v1[0], v1[1]); w.w = cvt_pk_bf16(v1[2], v1[3]);
          if (active) *(GAS u32x4*)(O + (size_t)row * ldc + c0) = w;
        }
    }
  }
};

struct EpiTrunk {
  static constexpr bool PERM = false;
  const float* base_p; const float* base_s; float* out; float scale;
  __device__ __forceinline__ void operator()(const Acc& acc, const Unit& u, int wr, int wc, int fr, int fq) const {
    const int col0 = u.pn * BM + wc * 32 + 4 * fq;
#pragma unroll
    for (int ai = 0; ai < 2; ++ai)
#pragma unroll
      for (int m = 0; m < 4; ++m) {
        const int row = u.pm * BM + ai * HALF + wr * 64 + m * 16 + fr;
        const float* bp = (base_s && row >= 65536) ? base_s + (size_t)(row - 65536) * DM : base_p + (size_t)row * DM;
        float* op = out + (size_t)row * DM;
#pragma unroll
        for (int bj = 0; bj < 2; ++bj)
#pragma unroll
          for (int n = 0; n < 2; ++n) { const int c = col0 + bj * HALF + n * 16; const f32x4 bs = *(const GAS f32x4*)(bp + c); *(GAS f32x4*)(op + c) = bs * ALPHA + acc[ai][bj][m][n] * scale; }
        asm volatile("" ::: "memory");
      }
  }
};

struct EpiTrunkLN {
  const float* base_p; const float* base_s; float* out; bf16_t* xb; const float* lg; const float* lb; unsigned long long* X; unsigned* cnt; float scale; LAS unsigned char* lds;
  __device__ __forceinline__ void operator()(const Acc& acc, const Unit& u, int wr, int wc, int fr, int fq) const {
    LAS f32x2* P = (LAS f32x2*)(lds + 131072);
    LAS f32x2* St = (LAS f32x2*)(lds + 131072 + 8192);
    const int col0 = u.pn * BM + wc * 32 + 8 * fq; const int wid = wr * 4 + wc, lane = fq * 16 + fr;
    const float* ubase = (base_s && u.pm >= 256) ? base_s + (size_t)(u.pm - 256) * BM * DM : base_p + (size_t)u.pm * BM * DM;
    float* uout = out + (size_t)u.pm * BM * DM; bf16_t* uxb = xb ? xb + (size_t)u.pm * BM * DM : nullptr;
#define LN_LOADB(dst, aim_) do { _Pragma("unroll") for (int mm = 0; mm < 2; ++mm) _Pragma("unroll") for (int bj = 0; bj < 2; ++bj) _Pragma("unroll") for (int n = 0; n < 2; ++n) \
      dst[mm][bj][n] = *(const GAS f32x4*)(ubase + ((((aim_) >> 1) * HALF + wr * 64 + ((((aim_) & 1) * 2) + mm) * 16 + fr) * DM + col0 + bj * HALF + n * 4)); } while (0)
#define LN_SUMB(src, aim_) do { _Pragma("unroll") for (int mm = 0; mm < 2; ++mm) { const int ai = (aim_) >> 1, m = ((aim_) & 1) * 2 + mm; const int rl = ai * HALF + wr * 64 + m * 16 + fr; float sm = 0.f, sq = 0.f; \
      _Pragma("unroll") for (int bj = 0; bj < 2; ++bj) _Pragma("unroll") for (int n = 0; n < 2; ++n) { const f32x4 v = src[mm][bj][n] * ALPHA + acc[ai][bj][m][n] * scale; \
        sm += (v[0] + v[1]) + (v[2] + v[3]); sq += (v[0] * v[0] + v[1] * v[1]) + (v[2] * v[2] + v[3] * v[3]); } \
      sm = xrow16_sum(sm); sq = xrow16_sum(sq); if (fq == 0) P[rl * 4 + wc] = (f32x2){sm, sq}; } } while (0)
    {
      f32x4 bA[2][2][2], bB[2][2][2];
      LN_LOADB(bA, 0); LN_LOADB(bB, 1); asm volatile("" ::: "memory");
      LN_SUMB(bA, 0); LN_SUMB(bB, 1); asm volatile("" ::: "memory");
      LN_LOADB(bA, 2); LN_LOADB(bB, 3); asm volatile("" ::: "memory");
      LN_SUMB(bA, 2); LN_SUMB(bB, 3);
    }
    asm volatile("s_waitcnt lgkmcnt(0)" ::: "memory"); __builtin_amdgcn_s_barrier(); __builtin_amdgcn_s_barrier(); asm volatile("" ::: "memory");
    const int rl2 = wid * 32 + (lane & 31);
    if (lane < 32) {
      const f32x2 a = P[rl2 * 4 + 0], b = P[rl2 * 4 + 1], c = P[rl2 * 4 + 2], d = P[rl2 * 4 + 3];
      const float s4 = (a.x + b.x) + (c.x + d.x), q4 = (a.y + b.y) + (c.y + d.y);
      __hip_atomic_store(X + ((size_t)(u.pm * BM + rl2) * 4 + u.pn), ((unsigned long long)__float_as_uint(q4) << 32) | __float_as_uint(s4), __ATOMIC_RELAXED, __HIP_MEMORY_SCOPE_AGENT);
    }
    asm volatile("s_waitcnt vmcnt(0)" ::: "memory");
    if (lane == 0) __hip_atomic_fetch_add(cnt + 64 * u.pm, 1u, __ATOMIC_RELAXED, __HIP_MEMORY_SCOPE_AGENT);
    __builtin_amdgcn_s_barrier();
    f32x4 pA[2][2][2], pB[2][2][2];
    LN_LOADB(pA, 0); LN_LOADB(pB, 1);
    while ((unsigned)__builtin_amdgcn_readfirstlane((int)__hip_atomic_load(cnt + 64 * u.pm, __ATOMIC_RELAXED, __HIP_MEMORY_SCOPE_AGENT)) < 32u) __builtin_amdgcn_s_sleep(1);
    __builtin_amdgcn_fence(__ATOMIC_ACQUIRE, "agent");
    if (lane < 32) {
      const unsigned long long* sl = X + (size_t)(u.pm * BM + rl2) * 4; float S = 0.f, Q = 0.f;
#pragma unroll
      for (int t = 0; t < 4; ++t) { const unsigned long long w = __hip_atomic_load(sl + t, __ATOMIC_RELAXED, __HIP_MEMORY_SCOPE_AGENT); S += __uint_as_float((unsigned)w); Q += __uint_as_float((unsigned)(w >> 32)); }
      const float mean = S * (1.0f / 1024.0f); const float var = fmaxf(Q * (1.0f / 1024.0f) - mean * mean, 0.f);
      St[rl2] = (f32x2){mean, 1.0f / sqrtf(var + 1e-5f)};
    }
    asm volatile("s_waitcnt vmcnt(0) lgkmcnt(0)" ::: "memory"); __builtin_amdgcn_s_barrier(); __builtin_amdgcn_s_barrier(); asm volatile("" ::: "memory");
    float scale2 = scale; asm volatile("" : "+s"(scale2));
#define LN_APPLYB(src, aim_) do { _Pragma("unroll") for (int mm = 0; mm < 2; ++mm) { const int ai = (aim_) >> 1, m = ((aim_) & 1) * 2 + mm; const int rl = ai * HALF + wr * 64 + m * 16 + fr; const int off = rl * DM + col0; const f32x2 sr = St[rl]; \
      _Pragma("unroll") for (int bj = 0; bj < 2; ++bj) { f32x4 o2[2]; \
        _Pragma("unroll") for (int n = 0; n < 2; ++n) { const f32x4 v = src[mm][bj][n] * ALPHA + acc[ai][bj][m][n] * scale2; o2[n] = (v - sr.x) * sr.y * *(const GAS f32x4*)(lg + col0 + bj * HALF + n * 4) + *(const GAS f32x4*)(lb + col0 + bj * HALF + n * 4); \
          *(GAS f32x4*)(uout + (off + bj * HALF + n * 4)) = o2[n]; } \
        if (uxb) { u32x4 w; w.x = cvt_pk_bf16(o2[0][0], o2[0][1]); w.y = cvt_pk_bf16(o2[0][2], o2[0][3]); w.z = cvt_pk_bf16(o2[1][0], o2[1][1]); w.w = cvt_pk_bf16(o2[1][2], o2[1][3]); *(GAS u32x4*)(uxb + (off + bj * HALF)) = w; } } } } while (0)
    {
      asm volatile("" ::: "memory");
      LN_APPLYB(pA, 0); LN_APPLYB(pB, 1); asm volatile("" ::: "memory");
      LN_LOADB(pA, 2); LN_LOADB(pB, 3); asm volatile("" ::: "memory");
      LN_APPLYB(pA, 2); LN_APPLYB(pB, 3);
    }
#undef LN_LOADB
#undef LN_SUMB
#undef LN_APPLYB
  }
};

struct EpiQ {
  static constexpr bool PERM = true;
  bf16_t* Q; const float* rstd; const float* rope;
  __device__ __forceinline__ void operator()(const Acc& acc, const Unit& u, int wr, int wc, int fr, int fq) const {
    float rsv[2][4];
#pragma unroll
    for (int ai = 0; ai < 2; ++ai)
#pragma unroll
      for (int m = 0; m < 4; ++m) rsv[ai][m] = ((const GAS float*)rstd)[(size_t)(u.pm * BM + ai * HALF + wr * 64 + m * 16 + fr) * 2];
#pragma unroll
    for (int ai = 0; ai < 2; ++ai)
#pragma unroll
      for (int m = 0; m < 4; ++m) {
        const int row = u.pm * BM + ai * HALF + wr * 64 + m * 16 + fr; const int b = row >> 12, s = row & 4095;
        const float rs = rsv[ai][m] * QSCALE;
#pragma unroll
        for (int bj = 0; bj < 2; ++bj) {
          const int G = 8 * u.pn + 4 * bj + wc; const int h = G / 3, part = G - 3 * h;
          f32x4 v0 = acc[ai][bj][m][0] * rs, v1 = acc[ai][bj][m][1] * rs;
          if (part == 2) { const f32x4 c = *(const GAS f32x4*)(rope + s * 32 + 4 * fq), sn = *(const GAS f32x4*)(rope + s * 32 + 16 + 4 * fq);
            const f32x4 o0 = v0 * c - v1 * sn, o1 = v0 * sn + v1 * c; v0 = o0; v1 = o1; }
          u32x4 w; w.x = cvt_pk_bf16(v0[0], v0[1]); w.y = cvt_pk_bf16(v0[2], v0[3]); w.z = cvt_pk_bf16(v1[0], v1[1]); w.w = cvt_pk_bf16(v1[2], v1[3]);
          *(GAS u32x4*)(Q + ((size_t)(b * 8 + h) * SEQ + s) * 96 + part * 32 + 8 * fq) = w;
        }
      }
  }
};

struct EpiKV {
  static constexpr bool PERM = true;
  bf16_t* K; bf16_t* Vt; const float* rstd;
  __device__ __forceinline__ void operator()(const Acc& acc, const Unit& u, int wr, int wc, int fr, int fq) const {
    float rsv[2][4];
#pragma unroll
    for (int ai = 0; ai < 2; ++ai)
#pragma unroll
      for (int m = 0; m < 4; ++m) rsv[ai][m] = ((const GAS float*)rstd)[(size_t)(u.pm * BM + ai * HALF + wr * 64 + m * 16 + fr) * 2 + 1];
#pragma unroll
    for (int ai = 0; ai < 2; ++ai)
#pragma unroll
      for (int m = 0; m < 4; ++m) {
        const int row = u.pm * BM + ai * HALF + wr * 64 + m * 16 + fr; const int b = row >> 12, s = row & 4095;
        const float rs = rsv[ai][m];
#pragma unroll
        for (int bj = 0; bj < 2; ++bj) {
          const int G = 8 * u.pn + 4 * bj + wc; const int h = G >> 2, part = G & 3;
          const f32x4 v0 = acc[ai][bj][m][0] * rs, v1 = acc[ai][bj][m][1] * rs;
          if (part < 2) { u32x4 w; w.x = cvt_pk_bf16(v0[0], v0[1]); w.y = cvt_pk_bf16(v0[2], v0[3]); w.z = cvt_pk_bf16(v1[0], v1[1]); w.w = cvt_pk_bf16(v1[2], v1[3]);
            *(GAS u32x4*)(K + ((size_t)(b * 8 + h) * SEQ + s) * 96 + part * 32 + 8 * fq) = w; }
          else { GAS bf16_t* vp = (GAS bf16_t*)Vt + ((size_t)(b * 8 + h) * 64 + (part - 2) * 32 + 8 * fq) * SEQ + s;
#pragma unroll
            for (int j = 0; j < 4; ++j) { vp[(size_t)j * SEQ] = f2bf(v0[j]); vp[(size_t)(4 + j) * SEQ] = f2bf(v1[j]); } }
        }
      }
  }
};

struct EpiCKV {
  static constexpr bool PERM = true;
  bf16_t* Kc; bf16_t* VcT;
  __device__ __forceinline__ void operator()(const Acc& acc, const Unit& u, int wr, int wc, int fr, int fq) const {
#pragma unroll
    for (int ai = 0; ai < 2; ++ai)
#pragma unroll
      for (int m = 0; m < 4; ++m) {
        const int row = u.pm * BM + ai * HALF + wr * 64 + m * 16 + fr; const int b = row >> 8, key = row & 255;
#pragma unroll
        for (int bj = 0; bj < 2; ++bj) {
          const int c0 = u.pn * BM + bj * HALF + wc * 32 + 8 * fq;
          const f32x4 v0 = acc[ai][bj][m][0], v1 = acc[ai][bj][m][1];
          if (c0 < 512) { u32x4 w; w.x = cvt_pk_bf16(v0[0], v0[1]); w.y = cvt_pk_bf16(v0[2], v0[3]); w.z = cvt_pk_bf16(v1[0], v1[1]); w.w = cvt_pk_bf16(v1[2], v1[3]);
            *(GAS u32x4*)(Kc + (size_t)row * 512 + c0) = w; }
          else { const int cc = c0 - 512; GAS bf16_t* vp = (GAS bf16_t*)VcT + ((size_t)(b * 4 + (cc >> 7)) * 128 + (cc & 127)) * 256 + key;
#pragma unroll
            for (int j = 0; j < 4; ++j) { vp[j * 256] = f2bf(v0[j]); vp[(4 + j) * 256] = f2bf(v1[j]); } }
        }
      }
  }
};

template <int SECOND>
struct EpiMix {
  static constexpr bool PERM = true;
  bf16_t* mix; const bf16_t* gates; int goff;
  __device__ __forceinline__ void operator()(const Acc& acc, const Unit& u, int wr, int wc, int fr, int fq) const {
#pragma unroll
    for (int ai = 0; ai < 2; ++ai) {
      u32x4 gw[4][2], mw[4][2];
#pragma unroll
      for (int m = 0; m < 4; ++m)
#pragma unroll
        for (int bj = 0; bj < 2; ++bj) {
          const int row = u.pm * BM + ai * HALF + wr * 64 + m * 16 + fr; const int c0 = u.pn * BM + bj * HALF + wc * 32 + 8 * fq;
          gw[m][bj] = *(const GAS u32x4*)(gates + (size_t)row * 2048 + goff + c0);
          if (SECOND) mw[m][bj] = *(const GAS u32x4*)(mix + (size_t)row * DM + c0);
        }
#pragma unroll
      for (int m = 0; m < 4; ++m)
#pragma unroll
        for (int bj = 0; bj < 2; ++bj) {
          const int row = u.pm * BM + ai * HALF + wr * 64 + m * 16 + fr; const int c0 = u.pn * BM + bj * HALF + wc * 32 + 8 * fq;
          float gt[8], o[8]; unpack8(gw[m][bj], gt);
          if (SECOND) unpack8(mw[m][bj], o);
#pragma unroll
          for (int n = 0; n < 2; ++n)
#pragma unroll
            for (int j = 0; j < 4; ++j) { const float v = gt[n * 4 + j] * acc[ai][bj][m][n][j]; o[n * 4 + j] = SECOND ? o[n * 4 + j] + v : v; }
          *(GAS u32x4*)(mix + (size_t)row * DM + c0) = pack8(o);
        }
      asm volatile("" ::: "memory");
    }
  }
};

struct Epi {
  int mode; bf16_t* O; bf16_t* O2; const bf16_t* bfp; const float* f0; const float* f1; float* outf; int ldc, ncols, goff; float scale; const float* g0; const float* g1; unsigned char* wsx; LAS unsigned char* lds;
  __device__ __forceinline__ bool perm() const { return mode != 4; }
  __device__ __forceinline__ void operator()(Acc& acc, const Unit& u, int wr, int wc, int fr, int fq) const {
    switch (mode) {
      case 0: EpiBf16<0>{O, ldc, ncols, scale, nullptr, nullptr, nullptr}(acc, u, wr, wc, fr, fq); break;
      case 1: EpiBf16<1>{O, ldc, ncols, 1.0f, f0, nullptr, nullptr}(acc, u, wr, wc, fr, fq); break;
      case 2: EpiBf16<2>{O, ldc, ncols, 1.0f, nullptr, f0, f1}(acc, u, wr, wc, fr, fq); break;
      case 3: EpiSwiglu{O}(acc, u, wr, wc, fr, fq); break;
      case 4: EpiTrunkLN{f0, f1, outf, O, g0, g1, (unsigned long long*)(wsx + O_XCH), (unsigned*)(wsx + O_CNT) + (size_t)ldc * 320 * 64, scale, lds}(acc, u, wr, wc, fr, fq); break;
      case 5: EpiQ{O, f0, f1}(acc, u, wr, wc, fr, fq); break;
      case 6: EpiKV{O, O2, f0}(acc, u, wr, wc, fr, fq); break;
      case 7: EpiCKV{O, O2}(acc, u, wr, wc, fr, fq); break;
      case 8: EpiMix<0>{O, bfp, goff}(acc, u, wr, wc, fr, fq); break;
      default: EpiMix<1>{O, bfp, goff}(acc, u, wr, wc, fr, fq); break;
    }
  }
};

__device__ __forceinline__ Gemm get_gemm(int step, PTab ptab, unsigned char* ws) {
  const bf16_t* xb = (const bf16_t*)(ws + O_XB);
  switch (step) {
    case 1: return Gemm{xb, (const bf16_t*)(ws + O_WGU1), T, 5632, 1024, 1024, 1024};
    case 2: return Gemm{(const bf16_t*)(ws + O_MEMLN), (const bf16_t*)(ws + O_WCKV), 5120, 1024, 1024, 1024, 1024};
    case 3: return Gemm{(const bf16_t*)(ws + O_HFF), (const bf16_t*)(ws + O_WD1), T, 1024, 2816, 2816, 2816};
    case 5: return Gemm{xb, (const bf16_t*)(ws + O_WINR), T, 2048, 1024, 1024, 1024};
    case 6: return Gemm{xb, (const bf16_t*)(ws + O_WINQ), T, 768, 1024, 1024, 1024};
    case 8: return Gemm{(const bf16_t*)(ws + O_LIN), (const bf16_t*)(ws + O_WLORA), T, 2048, 384, 384, 384};
    case 11: return Gemm{xb, (const bf16_t*)(ws + O_WING), T, 2048, 1024, 1024, 1024};
    case 12: return Gemm{(const bf16_t*)(ws + O_HQKV), (const bf16_t*)(ws + O_WUQ), T, 768, 384, 768, 384};
    case 13: return Gemm{(const bf16_t*)(ws + O_HQKV) + 384, (const bf16_t*)(ws + O_WUKV), T, 1024, 256, 768, 256};
    case 15: return Gemm{(const bf16_t*)(ws + O_AOUT), (const bf16_t*)(ws + O_PMLA), T, 1024, 512, 512, 512};
    case 16: return Gemm{(const bf16_t*)(ws + O_BOUT), (const bf16_t*)(ws + O_PRWKV), T, 1024, 512, 512, 512};
    case 17: return Gemm{(const bf16_t*)(ws + O_MIX), (const bf16_t*)(ws + O_WO), T, 1024, 1024, 1024, 1024};
    case 19: return Gemm{xb, (const bf16_t*)(ws + O_WCQ), T, 512, 1024, 1024, 1024};
    case 21: return Gemm{(const bf16_t*)(ws + O_CO), (const bf16_t*)(ws + O_WCO), T, 1024, 512, 512, 512};
    case 23: return Gemm{xb, (const bf16_t*)(ws + O_WGU2), T, 5632, 1024, 1024, 1024};
    case 24: return Gemm{(const bf16_t*)(ws + O_HFF), (const bf16_t*)(ws + O_WD2), T, 1024, 2816, 2816, 2816};
    default: return Gemm{nullptr, nullptr, 0, 0, 0, 0, 0};
  }
}
__device__ __forceinline__ Epi get_epi(int step, PTab ptab, unsigned char* ws, LAS unsigned char* lds) {
  const float* rope = (const float*)(ws + O_ROPE); const float* rstd = (const float*)(ws + O_RSTD);
  switch (step) {
    case 1: return Epi{3, (bf16_t*)(ws + O_HFF), nullptr, nullptr, nullptr, nullptr, nullptr, 0, 0, 0, 1.0f};
    case 2: return Epi{7, (bf16_t*)(ws + O_KC), (bf16_t*)(ws + O_VCT), nullptr, nullptr, nullptr, nullptr, 0, 0, 0, 1.0f};
    case 3: return Epi{4, (bf16_t*)(ws + O_XB), nullptr, nullptr, PT(x_p), PT(x_s), ((float*)PT(out)), 0, 0, 0, 0.5f, PT(ln1_g), PT(ln1_b), ws, lds};
    case 5: return Epi{0, (bf16_t*)(ws + O_HR), nullptr, nullptr, nullptr, nullptr, nullptr, 1856, 1856, 0, 1.0f};
    case 6: return Epi{0, (bf16_t*)(ws + O_HQKV), nullptr, nullptr, nullptr, nullptr, nullptr, 768, 768, 0, 1.0f};
    case 8: return Epi{2, (bf16_t*)(ws + O_LOUT), nullptr, nullptr, PT(w0), PT(a0), nullptr, 2048, 2048, 0, 1.0f};
    case 11: return Epi{1, (bf16_t*)(ws + O_GATES), nullptr, nullptr, PT(b_gate), nullptr, nullptr, 2048, 2048, 0, 1.0f};
    case 12: return Epi{5, (bf16_t*)(ws + O_Q), nullptr, nullptr, rstd, rope, nullptr, 0, 0, 0, 1.0f};
    case 13: return Epi{6, (bf16_t*)(ws + O_K), (bf16_t*)(ws + O_VT), nullptr, rstd, nullptr, nullptr, 0, 0, 0, 1.0f};
    case 15: return Epi{8, (bf16_t*)(ws + O_MIX), nullptr, (const bf16_t*)(ws + O_GATES), nullptr, nullptr, nullptr, 0, 0, 0, 1.0f};
    case 16: return Epi{9, (bf16_t*)(ws + O_MIX), nullptr, (const bf16_t*)(ws + O_GATES), nullptr, nullptr, nullptr, 0, 0, 1024, 1.0f};
    case 17: return Epi{4, (bf16_t*)(ws + O_XB), nullptr, nullptr, ((float*)PT(out)), nullptr, ((float*)PT(out)), 1, 0, 0, 1.0f, PT(ln2_g), PT(ln2_b), ws, lds};
    case 19: return Epi{0, (bf16_t*)(ws + O_CQ), nullptr, nullptr, nullptr, nullptr, nullptr, 512, 512, 0, CQSCALE};
    case 21: return Epi{4, (bf16_t*)(ws + O_XB), nullptr, nullptr, ((float*)PT(out)), nullptr, ((float*)PT(out)), 2, 0, 0, 1.0f, PT(ln3_g), PT(ln3_b), ws, lds};
    case 23: return Epi{3, (bf16_t*)(ws + O_HFF), nullptr, nullptr, nullptr, nullptr, nullptr, 0, 0, 0, 1.0f};
    case 24: return Epi{4, nullptr, nullptr, nullptr, ((float*)PT(out)), nullptr, ((float*)PT(out)), 3, 0, 0, 0.5f, PT(ln4_g), PT(ln4_b), ws, lds};
    default: return Epi{0, nullptr, nullptr, nullptr, nullptr, nullptr, nullptr, 0, 0, 0, 1.0f};
  }
}

__device__ __forceinline__ void gemm_phase(LAS unsigned char* lds, const int step, PTab ptab, unsigned char* ws, const int tid) {
  const Gemm g = get_gemm(step, ptab, ws); const bool permB = true;
  StaticOrder S; S.init(g.M, g.N, (int)gridDim.x, (int)blockIdx.x);
  const int wid = __builtin_amdgcn_readfirstlane(tid >> 6), lane = tid & 63, wr = wid >> 2, wc = wid & 3, fr = lane & 15, fq = lane >> 4;
  const int K = g.K, nt = K / BK;
  unsigned voffA[2], voffB[2]; int aoff, boff;
#define PG8_LANE_SETUP() do { int tid_l = tid; asm volatile("" : "+v"(tid_l)); const int lane_l = tid_l & 63, fr_l = lane_l & 15, fq_l = lane_l >> 4; \
    _Pragma("unroll") for (int i = 0; i < 2; ++i) { int R, C; stage_rc(tid_l * 16 + i * 8192, R, C); const int Rb = permB ? ((R & ~31) + perm32(R & 31)) : R; \
      voffA[i] = (unsigned)(R * g.lda + C) * 2u; voffB[i] = (unsigned)(Rb * g.ldb + C) * 2u; } \
    aoff = lds_byte(wr * 64 + fr_l, fq_l * 8); boff = lds_byte(wc * 32 + fr_l, fq_l * 8); } while (0)
  PG8_LANE_SETUP();
  const size_t kstep = (size_t)(BK * 2);
  const size_t hstepA = (size_t)HALF * g.lda * 2, hstepB = (size_t)HALF * g.ldb * 2;
  const size_t tstepA = 2 * hstepA, tstepB = 2 * hstepB;
  const unsigned ldsw = (unsigned)wid * 1024u;
#define PG8_SA(b, h) (((b) * 2 + (h)) * HTB)
#define PG8_SB(b, h) ((4 + (b) * 2 + (h)) * HTB)
#define PG8_STAGE(bufoff, gbase, voff) do { _Pragma("unroll") for (int _i = 0; _i < 2; ++_i) \
    __builtin_amdgcn_global_load_lds((const unsigned*)((const char*)(gbase) + (voff)[_i]), (LAS unsigned*)(lds + (bufoff) + ldsw + _i * 8192), 16, 0, 0); } while (0)
#define PG8_LDA(dst, b, h) do { _Pragma("unroll") for (int m = 0; m < 4; ++m) _Pragma("unroll") for (int k = 0; k < 2; ++k) dst[m][k] = *(const LAS bf16x8*)(lds + PG8_SA(b, h) + aoff + m * 2048 + k * 1024); } while (0)
#define PG8_LDB(dst, b, h) do { _Pragma("unroll") for (int n = 0; n < 2; ++n) _Pragma("unroll") for (int k = 0; k < 2; ++k) dst[n][k] = *(const LAS bf16x8*)(lds + PG8_SB(b, h) + boff + n * 2048 + k * 1024); } while (0)
#define PG8_MMA(ai, bj, At, Bt) do { __builtin_amdgcn_s_setprio(1); _Pragma("unroll") for (int m = 0; m < 4; ++m) _Pragma("unroll") for (int n = 0; n < 2; ++n) _Pragma("unroll") for (int k = 0; k < 2; ++k) \
    acc[ai][bj][m][n] = __builtin_amdgcn_mfma_f32_16x16x32_bf16(Bt[n][k], At[m][k], acc[ai][bj][m][n], 0, 0, 0); __builtin_amdgcn_s_setprio(0); } while (0)
#define PG8_WAIT_V(n) asm volatile("s_waitcnt vmcnt(" #n ")" ::: "memory")
#define PG8_WAIT_L(n) asm volatile("s_waitcnt lgkmcnt(" #n ")" ::: "memory")
#define PG8_BAR __builtin_amdgcn_s_barrier()
#define PG8_SCHED __builtin_amdgcn_sched_barrier(0)
  Unit cur, nxt; int ui = 0;
  const bool revpm = (step == 3 || step == 17 || step == 21 || step == 24);
  if (!S.next(0, cur)) return;
  if (revpm) cur.pm = S.nM - 1 - cur.pm;
  f32x4 acc[2][2][4][2];
#pragma unroll
  for (int a = 0; a < 2; ++a)
#pragma unroll
    for (int b = 0; b < 2; ++b)
#pragma unroll
      for (int m = 0; m < 4; ++m)
#pragma unroll
        for (int n = 0; n < 2; ++n) acc[a][b][m][n] = (f32x4){0.f, 0.f, 0.f, 0.f};
  bf16x8 At[4][2], B0[2][2], B1[2][2];
  const char* cA = (const char*)g.A + (size_t)cur.pm * tstepA; const char* cB = (const char*)g.Bt + (size_t)cur.pn * tstepB;
  PG8_STAGE(PG8_SB(0, 0), cB, voffB); PG8_STAGE(PG8_SA(0, 0), cA, voffA); PG8_STAGE(PG8_SB(0, 1), cB + hstepB, voffB); PG8_STAGE(PG8_SA(0, 1), cA + hstepA, voffA);
  if (wr == 1) PG8_BAR;
  PG8_WAIT_V(4); PG8_BAR;
  PG8_STAGE(PG8_SB(1, 0), cB + kstep, voffB); PG8_STAGE(PG8_SA(1, 0), cA + kstep, voffA); PG8_STAGE(PG8_SB(1, 1), cB + hstepB + kstep, voffB);
  PG8_WAIT_V(6); PG8_BAR;
  for (;;) {
    const bool has_next = S.next(ui + 1, nxt);
    if (revpm && has_next) nxt.pm = S.nM - 1 - nxt.pm;
    const char* nA = has_next ? (const char*)g.A + (size_t)nxt.pm * tstepA : cA; const char* nB = has_next ? (const char*)g.Bt + (size_t)nxt.pn * tstepB : cB;
    for (int t = 0; t < nt; t += 2) {
      const bool last = (t == nt - 2);
      const char* a1 = cA + (size_t)(t + 1) * kstep;
      const char* a2 = last ? nA : cA + (size_t)(t + 2) * kstep; const char* b2 = last ? nB : cB + (size_t)(t + 2) * kstep;
      const char* a3 = a2 + kstep; const char* b3 = b2 + kstep;
      PG8_LDB(B0, 0, 0); PG8_SCHED; PG8_LDA(At, 0, 0); PG8_STAGE(PG8_SA(1, 1), a1 + hstepA, voffA);
      PG8_WAIT_L(8); PG8_BAR; PG8_WAIT_L(0); PG8_MMA(0, 0, At, B0); PG8_BAR; PG8_SCHED;
      PG8_LDB(B1, 0, 1); PG8_STAGE(PG8_SB(0, 0), b2, voffB);
      PG8_BAR; PG8_WAIT_L(0); PG8_MMA(0, 1, At, B1); PG8_BAR;
      PG8_LDA(At, 0, 1); PG8_STAGE(PG8_SA(0, 0), a2, voffA);
      PG8_BAR; PG8_WAIT_L(0); PG8_MMA(1, 0, At, B0); PG8_BAR; PG8_SCHED;
      PG8_STAGE(PG8_SB(0, 1), b2 + hstepB, voffB);
      PG8_WAIT_V(6); PG8_BAR; PG8_MMA(1, 1, At, B1); PG8_BAR;
      PG8_LDB(B0, 1, 0); PG8_SCHED; PG8_LDA(At, 1, 0); PG8_STAGE(PG8_SA(0, 1), a2 + hstepA, voffA);
      PG8_WAIT_L(8); PG8_BAR; PG8_WAIT_L(0); PG8_MMA(0, 0, At, B0); PG8_BAR; PG8_SCHED;
      PG8_LDB(B1, 1, 1); PG8_STAGE(PG8_SB(1, 0), b3, voffB);
      PG8_BAR; PG8_WAIT_L(0); PG8_MMA(0, 1, At, B1); PG8_BAR;
      PG8_LDA(At, 1, 1); PG8_STAGE(PG8_SA(1, 0), a3, voffA);
      PG8_BAR; PG8_WAIT_L(0); PG8_MMA(1, 0, At, B0); PG8_BAR; PG8_SCHED;
      PG8_STAGE(PG8_SB(1, 1), b3 + hstepB, voffB);
      PG8_WAIT_V(6); PG8_BAR; PG8_MMA(1, 1, At, B1); PG8_BAR;
    }
    { int st2 = step; asm volatile("" : "+s"(st2)); int wr2 = wr, wc2 = wc, fr2 = fr, fq2 = fq; asm volatile("" : "+s"(wr2), "+s"(wc2)); asm volatile("" : "+v"(fr2), "+v"(fq2));
      unsigned char* ws2 = ws; asm volatile("" : "+s"(ws2)); const Epi E = get_epi(st2, (PTab)(ws2 + O_PTAB), ws2, lds); E(acc, cur, wr2, wc2, fr2, fq2); }
    if (!has_next) break;
#pragma unroll
    for (int a = 0; a < 2; ++a)
#pragma unroll
      for (int b = 0; b < 2; ++b)
#pragma unroll
        for (int m = 0; m < 4; ++m)
#pragma unroll
          for (int n = 0; n < 2; ++n) acc[a][b][m][n] = (f32x4){0.f, 0.f, 0.f, 0.f};
    cur = nxt; cA = nA; cB = nB; ++ui;
    PG8_LANE_SETUP();
  }
  PG8_WAIT_V(0);
  if (wr == 0) PG8_BAR;
  PG8_BAR;
#undef PG8_LANE_SETUP
#undef PG8_SA
#undef PG8_SB
#undef PG8_STAGE
#undef PG8_LDA
#undef PG8_LDB
#undef PG8_MMA
#undef PG8_WAIT_V
#undef PG8_WAIT_L
#undef PG8_BAR
#undef PG8_SCHED
}


template <int DQK, int DV, bool PF>
__device__ __forceinline__ void attn_unit(const bf16_t* q, int ldq, const bf16_t* k, int ldk, const bf16_t* vt, int ldv, int nkeys, bf16_t* o, int ldo, LAS unsigned char* lds, const int tid) {
  constexpr int KS = DQK / 32, DVB = DV / 16, KROW = DQK * 2 + 16, VROW = 144, KT_B = 64 * KROW, VT_B = DV * VROW, BUF_B = KT_B + VT_B;
  constexpr int KCPR = DQK / 8, KCH = 64 * KCPR, VCH = DV * 8, KPT = (KCH + 511) / 512, VPT = (VCH + 511) / 512;
  const int wid = tid >> 6, lane = tid & 63, l15 = lane & 15, quad = lane >> 4;
  bf16x8 qf[2][KS];
#pragma unroll
  for (int qb = 0; qb < 2; ++qb)
#pragma unroll
    for (int ks = 0; ks < KS; ++ks) qf[qb][ks] = *(const GAS bf16x8*)(q + (size_t)(wid * 32 + qb * 16 + l15) * ldq + ks * 32 + quad * 8);
  f32x4 oacc[DVB][2];
#pragma unroll
  for (int d = 0; d < DVB; ++d) { oacc[d][0] = (f32x4){0.f, 0.f, 0.f, 0.f}; oacc[d][1] = (f32x4){0.f, 0.f, 0.f, 0.f}; }
  float mrun[2] = {-INFINITY, -INFINITY}, lrun[2] = {0.f, 0.f};
  u32x4 kst[KPT], vst[VPT];
#define ATT_GLOAD(tile) do { _Pragma("unroll") for (int i = 0; i < KPT; ++i) { const int ch = tid + i * 512; if (ch < KCH) { const int r = ch / KCPR, c = ch - r * KCPR; kst[i] = *(const GAS u32x4*)(k + (size_t)((tile) * 64 + r) * ldk + c * 8); } } \
    _Pragma("unroll") for (int i = 0; i < VPT; ++i) { const int ch = tid + i * 512; if (ch < VCH) { const int r = ch >> 3, c = ch & 7; vst[i] = *(const GAS u32x4*)(vt + (size_t)r * ldv + (tile) * 64 + c * 8); } } } while (0)
#define ATT_LSTORE(buf) do { _Pragma("unroll") for (int i = 0; i < KPT; ++i) { const int ch = tid + i * 512; if (ch < KCH) { const int r = ch / KCPR, c = ch - r * KCPR; *(LAS u32x4*)(lds + (buf) * BUF_B + r * KROW + c * 16) = kst[i]; } } \
    _Pragma("unroll") for (int i = 0; i < VPT; ++i) { const int ch = tid + i * 512; if (ch < VCH) { const int r = ch >> 3, c = ch & 7; *(LAS u32x4*)(lds + (buf) * BUF_B + KT_B + r * VROW + c * 16) = vst[i]; } } } while (0)
  const int ntiles = nkeys / 64;
  if (PF) { ATT_GLOAD(0); ATT_LSTORE(0); __syncthreads(); }
  for (int t = 0; t < ntiles; ++t) {
    const int buf = PF ? (t & 1) : 0;
    if (PF) { if (t + 1 < ntiles) ATT_GLOAD(t + 1); } else { ATT_GLOAD(t); ATT_LSTORE(0); __syncthreads(); }
    f32x4 sacc[4][2];
#pragma unroll
    for (int kb = 0; kb < 4; ++kb) { sacc[kb][0] = (f32x4){0.f, 0.f, 0.f, 0.f}; sacc[kb][1] = (f32x4){0.f, 0.f, 0.f, 0.f}; }
#pragma unroll
    for (int ks = 0; ks < KS; ++ks) {
      bf16x8 kf[4];
#pragma unroll
      for (int kb = 0; kb < 4; ++kb) kf[kb] = *(const LAS bf16x8*)(lds + buf * BUF_B + (kb * 16 + l15) * KROW + ks * 64 + quad * 16);
#pragma unroll
      for (int kb = 0; kb < 4; ++kb)
#pragma unroll
        for (int qb = 0; qb < 2; ++qb) sacc[kb][qb] = __builtin_amdgcn_mfma_f32_16x16x32_bf16(kf[kb], qf[qb][ks], sacc[kb][qb], 0, 0, 0);
    }
    bf16x8 pf[2][2];
#pragma unroll
    for (int qb = 0; qb < 2; ++qb) {
      float mx = sacc[0][qb][0];
#pragma unroll
      for (int kb = 0; kb < 4; ++kb)
#pragma unroll
        for (int j = 0; j < 4; ++j) mx = fmaxf(mx, sacc[kb][qb][j]);
      mx = xrow16_max(mx);
      const float mnew = fmaxf(mrun[qb], mx); const float alpha = __builtin_amdgcn_exp2f(mrun[qb] - mnew); mrun[qb] = mnew;
      float ps = 0.f;
#pragma unroll
      for (int kb = 0; kb < 4; ++kb)
#pragma unroll
        for (int j = 0; j < 4; ++j) { const float pv = __builtin_amdgcn_exp2f(sacc[kb][qb][j] - mnew); sacc[kb][qb][j] = pv; ps += pv; }
      ps = xrow16_sum(ps);
      lrun[qb] = lrun[qb] * alpha + ps;
#pragma unroll
      for (int d = 0; d < DVB; ++d) oacc[d][qb] *= alpha;
#pragma unroll
      for (int ks2 = 0; ks2 < 2; ++ks2) { u32x4 w; w.x = cvt_pk_bf16(sacc[2 * ks2][qb][0], sacc[2 * ks2][qb][1]); w.y = cvt_pk_bf16(sacc[2 * ks2][qb][2], sacc[2 * ks2][qb][3]);
        w.z = cvt_pk_bf16(sacc[2 * ks2 + 1][qb][0], sacc[2 * ks2 + 1][qb][1]); w.w = cvt_pk_bf16(sacc[2 * ks2 + 1][qb][2], sacc[2 * ks2 + 1][qb][3]); pf[qb][ks2] = __builtin_bit_cast(bf16x8, w); }
    }
#pragma unroll
    for (int ks2 = 0; ks2 < 2; ++ks2)
#pragma unroll
      for (int d = 0; d < DVB; ++d) {
        const LAS unsigned char* vp = lds + buf * BUF_B + KT_B + (d * 16 + l15) * VROW + ks2 * 64 + quad * 8;
        const u32x2 lo = *(const LAS u32x2*)vp, hi = *(const LAS u32x2*)(vp + 32);
        u32x4 w; w.x = lo.x; w.y = lo.y; w.z = hi.x; w.w = hi.y; const bf16x8 vf = __builtin_bit_cast(bf16x8, w);
#pragma unroll
        for (int qb = 0; qb < 2; ++qb) oacc[d][qb] = __builtin_amdgcn_mfma_f32_16x16x32_bf16(vf, pf[qb][ks2], oacc[d][qb], 0, 0, 0);
      }
    if (PF) { if (t + 1 < ntiles) ATT_LSTORE(buf ^ 1); }
    __syncthreads();
  }
#undef ATT_GLOAD
#undef ATT_LSTORE
#pragma unroll
  for (int qb = 0; qb < 2; ++qb) {
    const float inv = 1.0f / lrun[qb]; const int row = wid * 32 + qb * 16 + l15;
#pragma unroll
    for (int d = 0; d < DVB; ++d) { const f32x4 v = oacc[d][qb] * inv; u32x2 w; w.x = cvt_pk_bf16(v[0], v[1]); w.y = cvt_pk_bf16(v[2], v[3]); *(GAS u32x2*)(o + (size_t)row * ldo + d * 16 + quad * 4) = w; }
  }
}

template <int DQK, int DV>
__device__ __forceinline__ void attn_unit_pp(const bf16_t* q, int ldq, const bf16_t* k, int ldk, const bf16_t* vt, int ldv, int nkeys, bf16_t* o, int ldo, LAS unsigned char* lds, const int tid) {
  constexpr int KS = DQK / 32, DVB = DV / 16, KROW = DQK * 2 + 16, VROW = 144, KT_B = 64 * KROW, VT_B = DV * VROW, BUF_B = KT_B + VT_B;
  constexpr int KCPR = DQK / 8, KCH = 64 * KCPR, VCH = DV * 8, KPT = (KCH + 511) / 512, VPT = (VCH + 511) / 512;
  const int wid = tid >> 6, lane = tid & 63, l15 = lane & 15, quad = lane >> 4; const int grp = __builtin_amdgcn_readfirstlane(wid >> 2);
  bf16x8 qf[2][KS];
#pragma unroll
  for (int qb = 0; qb < 2; ++qb)
#pragma unroll
    for (int ks = 0; ks < KS; ++ks) qf[qb][ks] = *(const GAS bf16x8*)(q + (size_t)(wid * 32 + qb * 16 + l15) * ldq + ks * 32 + quad * 8);
  f32x4 oacc[DVB][2];
#pragma unroll
  for (int d = 0; d < DVB; ++d) { oacc[d][0] = (f32x4){0.f, 0.f, 0.f, 0.f}; oacc[d][1] = (f32x4){0.f, 0.f, 0.f, 0.f}; }
  float mref[2] = {0.f, 0.f};
  f32x4 lacc[2] = {(f32x4){0.f, 0.f, 0.f, 0.f}, (f32x4){0.f, 0.f, 0.f, 0.f}};
  const bf16x8 vones = (l15 == 0) ? (bf16x8){0x3F80, 0x3F80, 0x3F80, 0x3F80, 0x3F80, 0x3F80, 0x3F80, 0x3F80} : (bf16x8){0, 0, 0, 0, 0, 0, 0, 0};
  u32x4 kstA[KPT], vstA[VPT], kstB[KPT], vstB[VPT];
#define ATT_GLOAD(kst, vst, tile) do { _Pragma("unroll") for (int i = 0; i < KPT; ++i) { const int ch = tid + i * 512; if (ch < KCH) { const int r = ch / KCPR, c = ch - r * KCPR; kst[i] = *(const GAS u32x4*)(k + (size_t)((tile) * 64 + r) * ldk + c * 8); } } \
    _Pragma("unroll") for (int i = 0; i < VPT; ++i) { const int ch = tid + i * 512; if (ch < VCH) { const int r = ch >> 3, c = ch & 7; vst[i] = *(const GAS u32x4*)(vt + (size_t)r * ldv + (tile) * 64 + c * 8); } } } while (0)
#define ATT_LSTORE(kst, vst, bufoff) do { _Pragma("unroll") for (int i = 0; i < KPT; ++i) { const int ch = tid + i * 512; if (ch < KCH) { const int r = ch / KCPR, c = ch - r * KCPR; *(LAS u32x4*)(lds + (bufoff) + r * KROW + c * 16) = kst[i]; } } \
    _Pragma("unroll") for (int i = 0; i < VPT; ++i) { const int ch = tid + i * 512; if (ch < VCH) { const int r = ch >> 3, c = ch & 7; *(LAS u32x4*)(lds + (bufoff) + KT_B + r * VROW + c * 16) = vst[i]; } } } while (0)
#define ATT_PV(bufoff) do { _Pragma("unroll") for (int ks2 = 0; ks2 < 2; ++ks2) _Pragma("unroll") for (int d = 0; d < DVB; ++d) { \
      const LAS unsigned char* vp = lds + (bufoff) + KT_B + (d * 16 + l15) * VROW + ks2 * 64 + quad * 8; const u32x2 lo = *(const LAS u32x2*)vp, hi = *(const LAS u32x2*)(vp + 32); \
      u32x4 w; w.x = lo.x; w.y = lo.y; w.z = hi.x; w.w = hi.y; const bf16x8 vf = __builtin_bit_cast(bf16x8, w); \
      _Pragma("unroll") for (int qb = 0; qb < 2; ++qb) oacc[d][qb] = __builtin_amdgcn_mfma_f32_16x16x32_bf16(vf, pf[qb][ks2], oacc[d][qb], 0, 0, 0); } \
    _Pragma("unroll") for (int ks2 = 0; ks2 < 2; ++ks2) _Pragma("unroll") for (int qb = 0; qb < 2; ++qb) lacc[qb] = __builtin_amdgcn_mfma_f32_16x16x32_bf16(vones, pf[qb][ks2], lacc[qb], 0, 0, 0); } while (0)
#define ATT_BAR() do { asm volatile("s_waitcnt lgkmcnt(0)" ::: "memory"); __builtin_amdgcn_s_barrier(); asm volatile("" ::: "memory"); } while (0)
  const int ntiles = nkeys / 64;
  ATT_GLOAD(kstA, vstA, 0); ATT_LSTORE(kstA, vstA, 0); __syncthreads();
  ATT_GLOAD(kstB, vstB, 1); ATT_GLOAD(kstA, vstA, 2);
  if (grp == 1) ATT_BAR();
  bf16x8 pf[2][2];
#pragma unroll
  for (int qb = 0; qb < 2; ++qb) { pf[qb][0] = (bf16x8){0, 0, 0, 0, 0, 0, 0, 0}; pf[qb][1] = (bf16x8){0, 0, 0, 0, 0, 0, 0, 0}; }
  int bcur = 0, bprev = 2 * BUF_B, bnext = BUF_B;
  for (int t0 = 0; t0 < ntiles; t0 += 2) {
    { const int t = t0;
    f32x4 sacc[4][2];
#pragma unroll
    for (int kb = 0; kb < 4; ++kb) { sacc[kb][0] = (f32x4){-mref[0], -mref[0], -mref[0], -mref[0]}; sacc[kb][1] = (f32x4){-mref[1], -mref[1], -mref[1], -mref[1]}; }
#pragma unroll
    for (int ks = 0; ks < KS; ++ks) {
      bf16x8 kf[4];
#pragma unroll
      for (int kb = 0; kb < 4; ++kb) kf[kb] = *(const LAS bf16x8*)(lds + bcur + (kb * 16 + l15) * KROW + ks * 64 + quad * 16);
#pragma unroll
      for (int kb = 0; kb < 4; ++kb)
#pragma unroll
        for (int qb = 0; qb < 2; ++qb) sacc[kb][qb] = __builtin_amdgcn_mfma_f32_16x16x32_bf16(kf[kb], qf[qb][ks], sacc[kb][qb], 0, 0, 0);
    }
    if (t > 0) ATT_PV(bprev);
    if (t + 1 < ntiles) ATT_LSTORE(kstB, vstB, bnext);
    ATT_BAR();
    if (t + 3 < ntiles) ATT_GLOAD(kstB, vstB, t + 3);
    float mxq[2];
#pragma unroll
    for (int qb = 0; qb < 2; ++qb) {
      float mx = sacc[0][qb][0];
#pragma unroll
      for (int kb = 0; kb < 4; ++kb)
#pragma unroll
        for (int j = 0; j < 4; ++j) mx = fmaxf(mx, sacc[kb][qb][j]);
      mxq[qb] = xrow16_max(mx);
    }
    if (t == 0 || __any(fmaxf(mxq[0], mxq[1]) > 8.0f)) {
#pragma unroll
      for (int qb = 0; qb < 2; ++qb) {
        const float shift = (t == 0) ? mxq[qb] : fmaxf(mxq[qb], 0.f); const float alpha = (t == 0) ? 0.f : __builtin_amdgcn_exp2f(-shift);
        mref[qb] += shift;
#pragma unroll
        for (int kb = 0; kb < 4; ++kb)
#pragma unroll
          for (int j = 0; j < 4; ++j) sacc[kb][qb][j] -= shift;
#pragma unroll
        for (int d = 0; d < DVB; ++d) oacc[d][qb] *= alpha;
        lacc[qb] *= alpha;
      }
    }
#pragma unroll
    for (int qb = 0; qb < 2; ++qb) {
#pragma unroll
      for (int kb = 0; kb < 4; ++kb)
#pragma unroll
        for (int j = 0; j < 4; ++j) sacc[kb][qb][j] = __builtin_amdgcn_exp2f(sacc[kb][qb][j]);
#pragma unroll
      for (int ks2 = 0; ks2 < 2; ++ks2) { u32x4 w; w.x = cvt_pk_bf16(sacc[2 * ks2][qb][0], sacc[2 * ks2][qb][1]); w.y = cvt_pk_bf16(sacc[2 * ks2][qb][2], sacc[2 * ks2][qb][3]);
        w.z = cvt_pk_bf16(sacc[2 * ks2 + 1][qb][0], sacc[2 * ks2 + 1][qb][1]); w.w = cvt_pk_bf16(sacc[2 * ks2 + 1][qb][2], sacc[2 * ks2 + 1][qb][3]); pf[qb][ks2] = __builtin_bit_cast(bf16x8, w); }
    }
    ATT_BAR();
    { const int tmp = bprev; bprev = bcur; bcur = bnext; bnext = tmp; }
    }
    { const int t = t0 + 1;
    f32x4 sacc[4][2];
#pragma unroll
    for (int kb = 0; kb < 4; ++kb) { sacc[kb][0] = (f32x4){-mref[0], -mref[0], -mref[0], -mref[0]}; sacc[kb][1] = (f32x4){-mref[1], -mref[1], -mref[1], -mref[1]}; }
#pragma unroll
    for (int ks = 0; ks < KS; ++ks) {
      bf16x8 kf[4];
#pragma unroll
      for (int kb = 0; kb < 4; ++kb) kf[kb] = *(const LAS bf16x8*)(lds + bcur + (kb * 16 + l15) * KROW + ks * 64 + quad * 16);
#pragma unroll
      for (int kb = 0; kb < 4; ++kb)
#pragma unroll
        for (int qb = 0; qb < 2; ++qb) sacc[kb][qb] = __builtin_amdgcn_mfma_f32_16x16x32_bf16(kf[kb], qf[qb][ks], sacc[kb][qb], 0, 0, 0);
    }
    if (t > 0) ATT_PV(bprev);
    if (t + 1 < ntiles) ATT_LSTORE(kstA, vstA, bnext);
    ATT_BAR();
    if (t + 3 < ntiles) ATT_GLOAD(kstA, vstA, t + 3);
    float mxq[2];
#pragma unroll
    for (int qb = 0; qb < 2; ++qb) {
      float mx = sacc[0][qb][0];
#pragma unroll
      for (int kb = 0; kb < 4; ++kb)
#pragma unroll
        for (int j = 0; j < 4; ++j) mx = fmaxf(mx, sacc[kb][qb][j]);
      mxq[qb] = xrow16_max(mx);
    }
    if (t == 0 || __any(fmaxf(mxq[0], mxq[1]) > 8.0f)) {
#pragma unroll
      for (int qb = 0; qb < 2; ++qb) {
        const float shift = (t == 0) ? mxq[qb] : fmaxf(mxq[qb], 0.f); const float alpha = (t == 0) ? 0.f : __builtin_amdgcn_exp2f(-shift);
        mref[qb] += shift;
#pragma unroll
        for (int kb = 0; kb < 4; ++kb)
#pragma unroll
          for (int j = 0; j < 4; ++j) sacc[kb][qb][j] -= shift;
#pragma unroll
        for (int d = 0; d < DVB; ++d) oacc[d][qb] *= alpha;
        lacc[qb] *= alpha;
      }
    }
#pragma unroll
    for (int qb = 0; qb < 2; ++qb) {
#pragma unroll
      for (int kb = 0; kb < 4; ++kb)
#pragma unroll
        for (int j = 0; j < 4; ++j) sacc[kb][qb][j] = __builtin_amdgcn_exp2f(sacc[kb][qb][j]);
#pragma unroll
      for (int ks2 = 0; ks2 < 2; ++ks2) { u32x4 w; w.x = cvt_pk_bf16(sacc[2 * ks2][qb][0], sacc[2 * ks2][qb][1]); w.y = cvt_pk_bf16(sacc[2 * ks2][qb][2], sacc[2 * ks2][qb][3]);
        w.z = cvt_pk_bf16(sacc[2 * ks2 + 1][qb][0], sacc[2 * ks2 + 1][qb][1]); w.w = cvt_pk_bf16(sacc[2 * ks2 + 1][qb][2], sacc[2 * ks2 + 1][qb][3]); pf[qb][ks2] = __builtin_bit_cast(bf16x8, w); }
    }
    ATT_BAR();
    { const int tmp = bprev; bprev = bcur; bcur = bnext; bnext = tmp; }
    }
  }
  ATT_PV(bprev);
  if (grp == 0) ATT_BAR();
  __syncthreads();
#undef ATT_GLOAD
#undef ATT_LSTORE
#undef ATT_PV
#undef ATT_BAR
#pragma unroll
  for (int qb = 0; qb < 2; ++qb) {
    const float inv = 1.0f / __builtin_bit_cast(float, __builtin_amdgcn_ds_bpermute(l15 * 4, __builtin_bit_cast(int, lacc[qb][0]))); const int row = wid * 32 + qb * 16 + l15;
#pragma unroll
    for (int d = 0; d < DVB; ++d) { const f32x4 v = oacc[d][qb] * inv; u32x2 w; w.x = cvt_pk_bf16(v[0], v[1]); w.y = cvt_pk_bf16(v[2], v[3]); *(GAS u32x2*)(o + (size_t)row * ldo + d * 16 + quad * 4) = w; }
  }
}

struct WDesc { const float* src; bf16_t* dst; const float* ks; int K, N, ld, mode; };
__device__ __forceinline__ int w_cmap(int mode, int n) {
  switch (mode) {
    case 1: { const int pn = n >> 8, i = n & 255; return i < 128 ? pn * 128 + i : DFF + pn * 128 + (i - 128); }
    case 2: return n < 672 ? n : -1;
    case 3: return n < 1856 ? 672 + n : -1;
    case 4: return 2528 + n;
    case 5: { const int h = n / 96, pp = n - h * 96; if (pp < 64) return n; const int p = pp - 64; return h * 96 + 64 + (p & 3) + 4 * (p >> 3) + 16 * ((p >> 2) & 1); }
    default: return n;
  }
}
__device__ __forceinline__ float prep_fetch(const WDesc& d, int k, int n, const Params& p) {
  float v = 0.f;
  if (d.mode == 7) {
    const int blk = n >> 9, nl = n & 511;
    if (blk == 0) { if (k < 64) v = p.w_up[(size_t)k * 512 + nl]; }
    else if (blk == 1) { if (k >= 64 && k < 128) v = p.w_up[(size_t)(64 + (k - 64)) * 512 + nl]; }
    else if (blk == 2) { if (k >= 128 && k < 192) v = p.a_up[(size_t)(k - 128) * 512 + nl]; }
    else { if (k >= 192 && k < 320) v = p.g_up[(size_t)(k - 192) * 512 + nl]; }
  } else {
    const int c = w_cmap(d.mode, n);
    if (c >= 0) { v = d.src[(size_t)k * d.ld + c]; if (d.ks) v *= d.ks[k]; }
  }
  return v;
}
__device__ __forceinline__ void prep_tile2(const WDesc& d, int tk0, int tn0, bool has1, int tk1, int tn1, const Params& p, LAS float* tl) {
  const int tid = threadIdx.x; LAS float* tl1 = tl + 64 * 65;
  {
    const int nn = tid & 63, kq = tid >> 6; float v0[8], v1[8];
#pragma unroll
    for (int i = 0; i < 8; ++i) v0[i] = prep_fetch(d, tk0 * 64 + kq * 8 + i, tn0 * 64 + nn, p);
#pragma unroll
    for (int i = 0; i < 8; ++i) v1[i] = has1 ? prep_fetch(d, tk1 * 64 + kq * 8 + i, tn1 * 64 + nn, p) : 0.f;
#pragma unroll
    for (int i = 0; i < 8; ++i) { tl[(kq * 8 + i) * 65 + nn] = v0[i]; tl1[(kq * 8 + i) * 65 + nn] = v1[i]; }
  }
  __syncthreads();
  {
    const int n = tid >> 3, kc = (tid & 7) * 8; float f[8];
#pragma unroll
    for (int i = 0; i < 8; ++i) f[i] = tl[(kc + i) * 65 + n];
    *(u32x4*)(d.dst + (size_t)(tn0 * 64 + n) * d.K + tk0 * 64 + kc) = pack8(f);
    if (has1) {
#pragma unroll
      for (int i = 0; i < 8; ++i) f[i] = tl1[(kc + i) * 65 + n];
      *(u32x4*)(d.dst + (size_t)(tn1 * 64 + n) * d.K + tk1 * 64 + kc) = pack8(f);
    }
  }
  __syncthreads();
}

__device__ __forceinline__ void ln_phase(float* trunk, const float* g, const float* b, bf16_t* xb, bool write_f32, const int tid) {
  const int lane = tid & 63, wid = tid >> 6;
  f32x4 gv[4], bv[4];
#pragma unroll
  for (int i = 0; i < 4; ++i) { gv[i] = *(const f32x4*)(g + i * 256 + lane * 4); bv[i] = *(const f32x4*)(b + i * 256 + lane * 4); }
  for (int row = blockIdx.x * 8 + wid; row < T; row += gridDim.x * 8) {
    float* rp = trunk + (size_t)row * DM; f32x4 v[4]; float s = 0.f;
#pragma unroll
    for (int i = 0; i < 4; ++i) { v[i] = *(const f32x4*)(rp + i * 256 + lane * 4); s += (v[i][0] + v[i][1]) + (v[i][2] + v[i][3]); }
    const float mean = wave_sum(s) * (1.0f / 1024.0f); float q = 0.f;
#pragma unroll
    for (int i = 0; i < 4; ++i) { v[i] -= mean; q += (v[i][0] * v[i][0] + v[i][1] * v[i][1]) + (v[i][2] * v[i][2] + v[i][3] * v[i][3]); }
    const float rstd = 1.0f / sqrtf(wave_sum(q) * (1.0f / 1024.0f) + 1e-5f);
#pragma unroll
    for (int i = 0; i < 4; ++i) { const f32x4 o = v[i] * rstd * gv[i] + bv[i];
      if (write_f32) *(f32x4*)(rp + i * 256 + lane * 4) = o;
      if (xb) { u32x2 w; w.x = cvt_pk_bf16(o[0], o[1]); w.y = cvt_pk_bf16(o[2], o[3]); *(u32x2*)(xb + (size_t)row * DM + i * 256 + lane * 4) = w; } }
  }
}

__device__ __forceinline__ void fast_barrier(unsigned* bar, unsigned target, int tid) {
  asm volatile("s_waitcnt vmcnt(0)" ::: "memory");
  __syncthreads();
  if (tid == 0) {
    __builtin_amdgcn_fence(__ATOMIC_RELEASE, "agent");
    asm volatile("s_waitcnt vmcnt(0)" ::: "memory");
    __hip_atomic_fetch_add(bar, 1u, __ATOMIC_RELAXED, __HIP_MEMORY_SCOPE_AGENT);
    while (__hip_atomic_load(bar, __ATOMIC_RELAXED, __HIP_MEMORY_SCOPE_AGENT) < target) __builtin_amdgcn_s_sleep(1);
    __builtin_amdgcn_fence(__ATOMIC_ACQUIRE, "agent");
    asm volatile("s_waitcnt vmcnt(0)" ::: "memory");
  }
  __syncthreads();
}

__global__ void __launch_bounds__(512, 2) fwd_mega(Params p) {
  extern __shared__ __attribute__((aligned(16))) unsigned char smem[];
  LAS unsigned char* lds = (LAS unsigned char*)smem;
  cg::grid_group grid = cg::this_grid();
  if (blockIdx.x == 0 && threadIdx.x == 64) __hip_atomic_store((unsigned*)(p.ws + O_PTAB + 512), 0u, __ATOMIC_RELAXED, __HIP_MEMORY_SCOPE_AGENT);
  for (int i = blockIdx.x * 512 + threadIdx.x; i < 4 * 320 * 64; i += gridDim.x * 512) ((unsigned*)(p.ws + O_CNT))[i] = 0u;
  const int wave_s = __builtin_amdgcn_readfirstlane((int)(threadIdx.x >> 6));
  unsigned nbar = 0;
  if (blockIdx.x == 0 && threadIdx.x < 43) {
    const float* v = (const float*)p.out;
    switch (threadIdx.x) {
      case 0: v = p.x_p; break;
      case 1: v = p.x_s; break;
      case 2: v = p.mem_p; break;
      case 3: v = p.mem_s; break;
      case 4: v = p.ln1_g; break;
      case 5: v = p.ln1_b; break;
      case 6: v = p.ffn1_wgu; break;
      case 7: v = p.ffn1_wd; break;
      case 8: v = p.w_in; break;
      case 9: v = p.b_gate; break;
      case 10: v = p.q_norm_g; break;
      case 11: v = p.w_uq; break;
      case 12: v = p.kv_norm_g; break;
      case 13: v = p.w_ukv; break;
      case 14: v = p.p_mla; break;
      case 15: v = p.mu_prev; break;
      case 16: v = p.mu_next; break;
      case 17: v = p.w0; break;
      case 18: v = p.w_up; break;
      case 19: v = p.a0; break;
      case 20: v = p.a_up; break;
      case 21: v = p.g_up; break;
      case 22: v = p.k_k; break;
      case 23: v = p.k_a; break;
      case 24: v = p.r_k; break;
      case 25: v = p.lnx_g; break;
      case 26: v = p.lnx_b; break;
      case 27: v = p.p_rwkv; break;
      case 28: v = p.w_o; break;
      case 29: v = p.ln2_g; break;
      case 30: v = p.ln2_b; break;
      case 31: v = p.mem_g; break;
      case 32: v = p.mem_b; break;
      case 33: v = p.w_cq; break;
      case 34: v = p.w_ckv; break;
      case 35: v = p.w_co; break;
      case 36: v = p.ln3_g; break;
      case 37: v = p.ln3_b; break;
      case 38: v = p.ffn2_wgu; break;
      case 39: v = p.ffn2_wd; break;
      case 40: v = p.ln4_g; break;
      case 41: v = p.ln4_b; break;
      default: break;
    }
    ((const float**)(p.ws + O_PTAB))[threadIdx.x] = v;
  }
  if (EN & 4) {
    unsigned char* ws = p.ws; const int tid = threadIdx.x, lane = tid & 63, wid = tid >> 6; const int gwave = blockIdx.x * 8 + wid, nwave = gridDim.x * 8;
    bf16_t* xb = (bf16_t*)(ws + O_XB); float* rope = (float*)(ws + O_ROPE);
  {
    int base = 0;
#define PREP_W(SRC, OFF, KS, KK, NN, LD, MODE) do { const WDesc d{SRC, (bf16_t*)(ws + OFF), KS, KK, NN, LD, MODE}; const int ntk = (KK) / 64, ntile = ntk * ((NN) / 64); \
      int first = ((int)blockIdx.x - base) % (int)gridDim.x; if (first < 0) first += gridDim.x; \
      for (int t = first; t < ntile; t += 2 * gridDim.x) { const int t1 = t + gridDim.x; const bool h1 = t1 < ntile; prep_tile2(d, t % ntk, t / ntk, h1, h1 ? t1 % ntk : 0, h1 ? t1 / ntk : 0, p, (LAS float*)lds); } \
      base = (base + ntile) % (int)gridDim.x; } while (0)
    PREP_W(p.ffn1_wgu, O_WGU1, nullptr, 1024, 5632, 5632, 1);
    PREP_W(p.ffn1_wd, O_WD1, nullptr, 2816, 1024, 1024, 0);
    PREP_W(p.ffn2_wgu, O_WGU2, nullptr, 1024, 5632, 5632, 1);
    PREP_W(p.ffn2_wd, O_WD2, nullptr, 2816, 1024, 1024, 0);
    PREP_W(p.w_in, O_WINQ, nullptr, 1024, 768, 4576, 2);
    PREP_W(p.w_in, O_WINR, nullptr, 1024, 2048, 4576, 3);
    PREP_W(p.w_in, O_WING, nullptr, 1024, 2048, 4576, 4);
    PREP_W(p.w_uq, O_WUQ, p.q_norm_g, 384, 768, 768, 5);
    PREP_W(p.w_ukv, O_WUKV, p.kv_norm_g, 256, 1024, 1024, 0);
    PREP_W(p.p_mla, O_PMLA, nullptr, 512, 1024, 1024, 0);
    PREP_W(p.p_rwkv, O_PRWKV, nullptr, 512, 1024, 1024, 0);
    PREP_W(p.w_o, O_WO, nullptr, 1024, 1024, 1024, 0);
    PREP_W(nullptr, O_WLORA, nullptr, 384, 2048, 0, 7);
    PREP_W(p.w_cq, O_WCQ, nullptr, 1024, 512, 512, 0);
    PREP_W(p.w_ckv, O_WCKV, nullptr, 1024, 1024, 1024, 0);
    PREP_W(p.w_co, O_WCO, nullptr, 512, 1024, 1024, 0);
#undef PREP_W
    for (size_t i = (size_t)blockIdx.x * 512 + tid; i < (size_t)T * DM / 8; i += (size_t)gridDim.x * 512) {
      const size_t e = i * 8; const float* src = (e < 65536ull * DM) ? p.x_p + e : p.x_s + (e - 65536ull * DM);
      const f32x4 a = *(const f32x4*)src, b = *(const f32x4*)(src + 4); const float f[8] = {a[0], a[1], a[2], a[3], b[0], b[1], b[2], b[3]};
      *(u32x4*)(xb + e) = pack8(f);
    }
    {
      bf16_t* memln = (bf16_t*)(ws + O_MEMLN);
      for (int row = gwave; row < 5120; row += nwave) {
        const float* rp = (row < 4096) ? p.mem_p + (size_t)row * DM : p.mem_s + (size_t)(row - 4096) * DM; f32x4 v[4]; float s = 0.f;
#pragma unroll
        for (int i = 0; i < 4; ++i) { v[i] = *(const f32x4*)(rp + i * 256 + lane * 4); s += (v[i][0] + v[i][1]) + (v[i][2] + v[i][3]); }
        const float mean = wave_sum(s) * (1.0f / 1024.0f); float q = 0.f;
#pragma unroll
        for (int i = 0; i < 4; ++i) { v[i] -= mean; q += (v[i][0] * v[i][0] + v[i][1] * v[i][1]) + (v[i][2] * v[i][2] + v[i][3] * v[i][3]); }
        const float rs = 1.0f / sqrtf(wave_sum(q) * (1.0f / 1024.0f) + 1e-5f);
#pragma unroll
        for (int i = 0; i < 4; ++i) { const f32x4 o = v[i] * rs * *(const f32x4*)(p.mem_g + i * 256 + lane * 4) + *(const f32x4*)(p.mem_b + i * 256 + lane * 4);
          u32x2 w; w.x = cvt_pk_bf16(o[0], o[1]); w.y = cvt_pk_bf16(o[2], o[3]); *(u32x2*)(memln + (size_t)row * DM + i * 256 + lane * 4) = w; }
      }
    }
    for (int i = blockIdx.x * 512 + tid; i < 4096 * 16; i += gridDim.x * 512) {
      const int s = i >> 4, j = i & 15; const float inv = 1.0f / powf(10000.0f, (float)(2 * j) / 32.0f); const float ang = (float)s * inv;
      rope[s * 32 + j] = cosf(ang); rope[s * 32 + 16 + j] = sinf(ang);
    }
  }
  }
  grid.sync();
#pragma nounroll
  for (int step = 1; step < 26; ++step) {
    unsigned char* ws = p.ws; asm volatile("" : "+s"(ws));
    unsigned zero_l = 0u; asm volatile("" : "+s"(zero_l));
    int tid = wave_s * 64 + (int)__builtin_amdgcn_mbcnt_hi(~0u, __builtin_amdgcn_mbcnt_lo(~0u, zero_l)); asm volatile("" : "+v"(tid));
    const int lane = tid & 63, wid = tid >> 6;
    const int gwave = blockIdx.x * 8 + wid, nwave = gridDim.x * 8;
    bf16_t* xb = (bf16_t*)(ws + O_XB);
    float* rope = (float*)(ws + O_ROPE);
    float* rstd = (float*)(ws + O_RSTD);
    PTab ptab = (PTab)(ws + O_PTAB);
    int kind = 0; bool sync = true; const float* lng = nullptr; const float* lnb = nullptr; bf16_t* lnxb = xb;
    switch (step) {
      case 1: kind = 1; sync = false; break;
      case 2: kind = 1; break;
      case 3: kind = 1; break;
      case 4: kind = 0; sync = false; break;
      case 5: kind = 1; sync = false; break;
      case 6: kind = 1; break;
      case 7: kind = 4; break;
      case 8: kind = 1; break;
      case 9: kind = 5; break;
      case 10: kind = 6; break;
      case 11: kind = 1; sync = false; break;
      case 12: kind = 1; sync = false; break;
      case 13: kind = 1; break;
      case 14: kind = 7; break;
      case 15: kind = 1; sync = false; break;
      case 16: kind = 1; break;
      case 17: kind = 1; break;
      case 18: kind = 0; sync = false; break;
      case 19: kind = 1; break;
      case 20: kind = 8; break;
      case 21: kind = 1; break;
      case 22: kind = 0; sync = false; break;
      case 23: kind = 1; break;
      case 24: kind = 1; break;
      default: kind = 0; sync = false; break;
    }
    if (step == 11 && (EN & 8)) {
      const bf16_t* __restrict__ hqkv = (const bf16_t*)(ws + O_HQKV); bf16_t* __restrict__ Kb = (bf16_t*)(ws + O_K);
      for (int it = blockIdx.x * 512 + tid; it < T * 4; it += gridDim.x * 512) {
        const int t = it >> 2, q = it & 3, s = t & 4095, b = t >> 12;
        const u32x2 w1 = *(const GAS u32x2*)(hqkv + (size_t)t * 768 + 640 + 4 * q), w2 = *(const GAS u32x2*)(hqkv + (size_t)t * 768 + 656 + 4 * q);
        const f32x4 c = *(const GAS f32x4*)(rope + s * 32 + 4 * q), sn = *(const GAS f32x4*)(rope + s * 32 + 16 + 4 * q);
        const f32x4 x1 = (f32x4){__uint_as_float(w1.x << 16), __uint_as_float(w1.x & 0xffff0000u), __uint_as_float(w1.y << 16), __uint_as_float(w1.y & 0xffff0000u)};
        const f32x4 x2 = (f32x4){__uint_as_float(w2.x << 16), __uint_as_float(w2.x & 0xffff0000u), __uint_as_float(w2.y << 16), __uint_as_float(w2.y & 0xffff0000u)};
        const f32x4 o1 = x1 * c - x2 * sn, o2 = x1 * sn + x2 * c;
        u32x4 w; w.x = cvt_pk_bf16(o1[0], o1[1]); w.y = cvt_pk_bf16(o1[2], o1[3]); w.z = cvt_pk_bf16(o2[0], o2[1]); w.w = cvt_pk_bf16(o2[2], o2[3]);
#pragma unroll
        for (int h = 0; h < 8; ++h) *(GAS u32x4*)(Kb + ((size_t)(b * 8 + h) * SEQ + s) * 96 + 64 + 8 * q) = w;
      }
    }
    if (kind == 1) { if (EN & 1) gemm_phase(lds, step, ptab, ws, tid); }
    else if (kind == 2) { if (EN & 2) ln_phase(((float*)PT(out)), lng, lnb, lnxb, true, tid); }
    else if (kind == 4 && (EN & 8)) {
  {
    const bf16_t* __restrict__ hr = (const bf16_t*)(ws + O_HR); const bf16_t* __restrict__ hqkv = (const bf16_t*)(ws + O_HQKV); bf16_t* __restrict__ lin = (bf16_t*)(ws + O_LIN);
    const float* __restrict__ mup = PT(mu_prev) + 1536; const float* __restrict__ mun = PT(mu_next) + 1536;
#pragma unroll 2
    for (int it = blockIdx.x * 512 + tid; it < T * 48; it += gridDim.x * 512) {
      const int t = it / 48, g = it - t * 48; u32x4 ow = (u32x4){0u, 0u, 0u, 0u};
      if (g < 40) {
        const int s = t & 4095; const bf16_t* hp = hr + (size_t)t * 1856 + 1536 + g * 8;
        float c[8], pv[8], nv[8], o[8]; unpack8(*(const u32x4*)hp, c);
        unpack8((s > 0) ? *(const GAS u32x4*)(hp - 1856) : (u32x4){0u, 0u, 0u, 0u}, pv); unpack8((s < 4095) ? *(const GAS u32x4*)(hp + 1856) : (u32x4){0u, 0u, 0u, 0u}, nv);
        const f32x4 mp0 = *(const GAS f32x4*)(mup + g * 8), mp1 = *(const GAS f32x4*)(mup + g * 8 + 4), mn0 = *(const GAS f32x4*)(mun + g * 8), mn1 = *(const GAS f32x4*)(mun + g * 8 + 4);
#pragma unroll
        for (int i = 0; i < 8; ++i) { const float m1 = i < 4 ? mp0[i & 3] : mp1[i & 3], m2 = i < 4 ? mn0[i & 3] : mn1[i & 3]; float v = c[i] + m1 * (pv[i] - c[i]) + m2 * (nv[i] - c[i]);
          if (g < 16) v = 1.0f - 2.0f / (1.0f + __expf(2.0f * v)); else if (g >= 24) v = sigmoidf_(v);
          o[i] = v; }
        ow = pack8(o);
      }
      *(GAS u32x4*)(lin + (size_t)t * 384 + g * 8) = ow;
    }
    for (int t4 = gwave; t4 < T / 4; t4 += nwave) {
      const int t = t4 * 4 + (lane >> 4), l16 = lane & 15; float sq = 0.f, skv = 0.f;
#pragma unroll
      for (int j = 0; j < 5; ++j) { const int k = j * 16 + l16; float f[8]; unpack8(*(const GAS u32x4*)(hqkv + (size_t)t * 768 + k * 8), f); float ss = 0.f;
#pragma unroll
        for (int i = 0; i < 8; ++i) ss += f[i] * f[i];
        if (k < 48) sq += ss; else skv += ss; }
      sq = row16_sum(sq); skv = row16_sum(skv);
      if (l16 == 0) { rstd[(size_t)t * 2] = 1.0f / sqrtf(sq * (1.0f / 384.0f) + 1e-6f); rstd[(size_t)t * 2 + 1] = 1.0f / sqrtf(skv * (1.0f / 256.0f) + 1e-6f); }
    }
  }
    } else if (kind == 5 && (EN & 16)) {
  {
    const bf16_t* hr = (const bf16_t*)(ws + O_HR); const bf16_t* lo = (const bf16_t*)(ws + O_LOUT); bf16_t* yb = (bf16_t*)(ws + O_Y);
    const int dir = tid >> 8, td = tid & 255;
    LAS float* Wl = (LAS float*)(lds + dir * 57344); LAS float* Al = Wl + 2048; LAS float* Bl = Wl + 4096; LAS float* Kl = Wl + 6144; LAS float* Rl = Wl + 8192; LAS float* Vl = Wl + 10240; LAS float* Yl = Wl + 12288;
    const int ptt = td >> 3, pc8 = td & 7;
    const int rq = td >> 3, cgp = td & 7;
    LAS float* Cst = (LAS float*)(lds + 2 * 57344 + 12288);
    LAS float* ybase = (cgp == 0) ? (Yl + 2 * rq) : ((LAS float*)(lds + 2 * 57344) + 2 * tid);
    for (int unit = blockIdx.x; unit < NBATCH * 8; unit += gridDim.x) {
      const int b = unit >> 3, h = unit & 7;
      {
        const int arr = tid >> 6, c = tid & 63;
        const float* src = arr < 3 ? PT(mu_prev) + arr * 512 + h * 64 + c : arr < 6 ? PT(mu_next) + (arr - 3) * 512 + h * 64 + c : arr == 6 ? PT(k_k) + h * 64 + c : PT(k_a) + h * 64 + c;
        Cst[arr * 64 + c] = *src;
      }
      __syncthreads();
      const bf16_t* hrb = hr + (size_t)b * SEQ * 1856 + h * 64 + pc8 * 8; const bf16_t* lob = lo + (size_t)b * SEQ * 2048 + h * 64 + pc8 * 8;
      f32x2 S[2][4];
#pragma unroll
      for (int r = 0; r < 2; ++r)
#pragma unroll
        for (int j = 0; j < 4; ++j) S[r][j] = (f32x2){0.f, 0.f};
      u32x4 ld_c[3], ld_p[3], ld_n[3], ld_w, ld_a;
#define SCAN_LOAD(nch) do { const int t0_ = dir ? SEQ - 32 * ((nch) + 1) : 32 * (nch); const int t_ = t0_ + ptt; const bf16_t* rp_ = hrb + (size_t)t_ * 1856; \
        _Pragma("unroll") for (int a_ = 0; a_ < 3; ++a_) { ld_c[a_] = *(const GAS u32x4*)(rp_ + a_ * 512); ld_p[a_] = (t_ > 0) ? *(const GAS u32x4*)(rp_ + a_ * 512 - 1856) : (u32x4){0u, 0u, 0u, 0u}; ld_n[a_] = (t_ < SEQ - 1) ? *(const GAS u32x4*)(rp_ + a_ * 512 + 1856) : (u32x4){0u, 0u, 0u, 0u}; } \
        ld_w = *(const GAS u32x4*)(lob + (size_t)t_ * 2048 + dir * 512); ld_a = *(const GAS u32x4*)(lob + (size_t)t_ * 2048 + 1024); } while (0)
      SCAN_LOAD(0);
      for (int nch = 0; nch < SEQ / 32; ++nch) {
        {
          float sh[3][8];
#pragma unroll
          for (int a = 0; a < 3; ++a) {
            float c[8], pv[8], nv[8]; unpack8(ld_c[a], c); unpack8(ld_p[a], pv); unpack8(ld_n[a], nv);
            const LAS float* mpp = Cst + a * 64 + pc8 * 8; const LAS float* mnp = Cst + (3 + a) * 64 + pc8 * 8;
#pragma unroll
            for (int i = 0; i < 8; ++i) sh[a][i] = c[i] + mpp[i] * (pv[i] - c[i]) + mnp[i] * (nv[i] - c[i]);
          }
          float lw[8], av[8]; unpack8(ld_w, lw); unpack8(ld_a, av);
          float kk[8], ss = 0.f;
#pragma unroll
          for (int i = 0; i < 8; ++i) { kk[i] = sh[1][i] * Cst[6 * 64 + pc8 * 8 + i]; ss += kk[i] * kk[i]; }
          ss = oct_sum(ss);
          const float inrm = 1.0f / fmaxf(sqrtf(ss), 1e-12f);
          float ow[8], oa[8], ob[8], ok[8];
#pragma unroll
          for (int i = 0; i < 8; ++i) { const float kn = kk[i] * inrm; ow[i] = __builtin_amdgcn_exp2f(lw[i]); oa[i] = -kn; ob[i] = kn * av[i]; ok[i] = sh[1][i] * (1.0f + (av[i] - 1.0f) * Cst[7 * 64 + pc8 * 8 + i]); }
          const int o = (dir ? 31 - ptt : ptt) * 64 + pc8 * 8;
          *(LAS f32x4*)(Wl + o) = (f32x4){ow[0], ow[1], ow[2], ow[3]}; *(LAS f32x4*)(Wl + o + 4) = (f32x4){ow[4], ow[5], ow[6], ow[7]};
          *(LAS f32x4*)(Al + o) = (f32x4){oa[0], oa[1], oa[2], oa[3]}; *(LAS f32x4*)(Al + o + 4) = (f32x4){oa[4], oa[5], oa[6], oa[7]};
          *(LAS f32x4*)(Bl + o) = (f32x4){ob[0], ob[1], ob[2], ob[3]}; *(LAS f32x4*)(Bl + o + 4) = (f32x4){ob[4], ob[5], ob[6], ob[7]};
          *(LAS f32x4*)(Kl + o) = (f32x4){ok[0], ok[1], ok[2], ok[3]}; *(LAS f32x4*)(Kl + o + 4) = (f32x4){ok[4], ok[5], ok[6], ok[7]};
          *(LAS f32x4*)(Rl + o) = (f32x4){sh[0][0], sh[0][1], sh[0][2], sh[0][3]}; *(LAS f32x4*)(Rl + o + 4) = (f32x4){sh[0][4], sh[0][5], sh[0][6], sh[0][7]};
          *(LAS f32x4*)(Vl + o) = (f32x4){sh[2][0], sh[2][1], sh[2][2], sh[2][3]}; *(LAS f32x4*)(Vl + o + 4) = (f32x4){sh[2][4], sh[2][5], sh[2][6], sh[2][7]};
        }
        __syncthreads();
        if (nch + 1 < SEQ / 32) SCAN_LOAD(nch + 1);
        {
          f32x4 opA[11], opB[11];
#define SC_LOAD(dst, st_) do { const int tt_ = (st_); const int o_ = tt_ * 64 + cgp * 8; \
            dst[0] = *(const LAS f32x4*)(Wl + o_); dst[1] = *(const LAS f32x4*)(Wl + o_ + 4); dst[2] = *(const LAS f32x4*)(Al + o_); dst[3] = *(const LAS f32x4*)(Al + o_ + 4); \
            dst[4] = *(const LAS f32x4*)(Bl + o_); dst[5] = *(const LAS f32x4*)(Bl + o_ + 4); dst[6] = *(const LAS f32x4*)(Kl + o_); dst[7] = *(const LAS f32x4*)(Kl + o_ + 4); \
            dst[8] = *(const LAS f32x4*)(Rl + o_); dst[9] = *(const LAS f32x4*)(Rl + o_ + 4); { const f32x2 v2_ = *(const LAS f32x2*)(Vl + tt_ * 64 + 2 * rq); dst[10] = (f32x4){v2_.x, v2_.y, 0.f, 0.f}; } } while (0)
#define SC_STEP(op, st_) do { const int tt_ = (st_); \
            f32x2 wv[4], av[4], bv[4], kv[4], rv[4]; \
            _Pragma("unroll") for (int i = 0; i < 2; ++i) { wv[2 * i] = (f32x2){op[i][0], op[i][1]}; wv[2 * i + 1] = (f32x2){op[i][2], op[i][3]}; av[2 * i] = (f32x2){op[2 + i][0], op[2 + i][1]}; av[2 * i + 1] = (f32x2){op[2 + i][2], op[2 + i][3]}; \
              bv[2 * i] = (f32x2){op[4 + i][0], op[4 + i][1]}; bv[2 * i + 1] = (f32x2){op[4 + i][2], op[4 + i][3]}; kv[2 * i] = (f32x2){op[6 + i][0], op[6 + i][1]}; kv[2 * i + 1] = (f32x2){op[6 + i][2], op[6 + i][3]}; \
              rv[2 * i] = (f32x2){op[8 + i][0], op[8 + i][1]}; rv[2 * i + 1] = (f32x2){op[8 + i][2], op[8 + i][3]}; } \
            float yo[2]; \
            _Pragma("unroll") for (int r = 0; r < 2; ++r) { \
              f32x2 c = S[r][0] * av[0]; c += S[r][1] * av[1]; c += S[r][2] * av[2]; c += S[r][3] * av[3]; \
              float sa = c.x + c.y; sa += dpp_f<0xB1>(sa); sa += dpp_f<0x4E>(sa); sa += dpp_f<0x141>(sa); \
              const f32x2 sav = (f32x2){sa, sa}, vv = (f32x2){op[10][r], op[10][r]}; \
              f32x2 y = (f32x2){0.f, 0.f}; \
              _Pragma("unroll") for (int j = 0; j < 4; ++j) { const f32x2 n = S[r][j] * wv[j] + (bv[j] * sav + kv[j] * vv); S[r][j] = n; y += n * rv[j]; } \
              float ys = y.x + y.y; ys += dpp_f<0xB1>(ys); ys += dpp_f<0x4E>(ys); ys += dpp_f<0x141>(ys); yo[r] = ys; } \
            *(LAS f32x2*)(ybase + tt_ * 64) = (f32x2){yo[0], yo[1]}; } while (0)
          SC_LOAD(opA, 0);
#pragma unroll 1
          for (int st = 0; st < 32; st += 8) {
#pragma unroll
            for (int u = 0; u < 8; u += 2) {
              asm volatile("" :: "v"(opA[10][0])); __builtin_amdgcn_sched_barrier(0);
              SC_LOAD(opB, st + u + 1); __builtin_amdgcn_sched_barrier(0);
              SC_STEP(opA, st + u); __builtin_amdgcn_sched_barrier(0);
              asm volatile("" :: "v"(opB[10][0])); __builtin_amdgcn_sched_barrier(0);
              SC_LOAD(opA, (st + u + 2) & 31); __builtin_amdgcn_sched_barrier(0);
              SC_STEP(opB, st + u + 1); __builtin_amdgcn_sched_barrier(0);
            }
          }
#undef SC_LOAD
#undef SC_STEP
        }
        __syncthreads();
        {
          const int t0 = dir ? SEQ - 32 * (nch + 1) : 32 * nch; const int ys = (dir ? 31 - ptt : ptt) * 64 + pc8 * 8; const f32x4 y0 = *(const LAS f32x4*)(Yl + ys), y1 = *(const LAS f32x4*)(Yl + ys + 4);
          const float f[8] = {y0[0], y0[1], y0[2], y0[3], y1[0], y1[1], y1[2], y1[3]};
          *(GAS u32x4*)(yb + ((size_t)dir * T + (size_t)b * SEQ + t0 + ptt) * 512 + h * 64 + pc8 * 8) = pack8(f);
        }
      }
#undef SCAN_LOAD
      __syncthreads();
    }
  }
    } else if (kind == 6 && (EN & 32)) {
  {
    const bf16_t* __restrict__ hr = (const bf16_t*)(ws + O_HR); const bf16_t* __restrict__ lo = (const bf16_t*)(ws + O_LOUT); const bf16_t* __restrict__ yb = (const bf16_t*)(ws + O_Y); bf16_t* __restrict__ bout = (bf16_t*)(ws + O_BOUT);
    const int c0 = lane * 8;
    float mpv[3][8], mnv[3][8], kav[8], rkv[8], lgv[8], lbv[8];
#pragma unroll
    for (int i = 0; i < 8; ++i) {
#pragma unroll
      for (int a = 0; a < 3; ++a) { mpv[a][i] = PT(mu_prev)[a * 512 + c0 + i]; mnv[a][i] = PT(mu_next)[a * 512 + c0 + i]; }
      kav[i] = PT(k_a)[c0 + i]; rkv[i] = PT(r_k)[c0 + i]; lgv[i] = PT(lnx_g)[c0 + i]; lbv[i] = PT(lnx_b)[c0 + i]; }
#pragma unroll 2
    for (int t = gwave; t < T; t += nwave) {
      const int s = t & 4095;
      float sh[3][8];
#pragma unroll
      for (int a = 0; a < 3; ++a) {
        const bf16_t* rp = hr + (size_t)t * 1856 + a * 512 + c0; float c[8], pv[8], nv[8]; unpack8(*(const u32x4*)rp, c);
        if (s > 0) unpack8(*(const GAS u32x4*)(rp - 1856), pv); else {
#pragma unroll
          for (int i = 0; i < 8; ++i) pv[i] = 0.f; }
        if (s < 4095) unpack8(*(const GAS u32x4*)(rp + 1856), nv); else {
#pragma unroll
          for (int i = 0; i < 8; ++i) nv[i] = 0.f; }
#pragma unroll
        for (int i = 0; i < 8; ++i) sh[a][i] = c[i] + mpv[a][i] * (pv[i] - c[i]) + mnv[a][i] * (nv[i] - c[i]);
      }
      float av[8], gv[8], yf[8], ybk[8];
      unpack8(*(const GAS u32x4*)(lo + (size_t)t * 2048 + 1024 + c0), av); unpack8(*(const GAS u32x4*)(lo + (size_t)t * 2048 + 1536 + c0), gv);
      unpack8(*(const GAS u32x4*)(yb + (size_t)t * 512 + c0), yf); unpack8(*(const GAS u32x4*)(yb + ((size_t)T + t) * 512 + c0), ybk);
      float y[8], sy = 0.f, sb = 0.f;
#pragma unroll
      for (int i = 0; i < 8; ++i) { y[i] = yf[i] + ybk[i]; sy += y[i]; const float km = sh[1][i] * (1.0f + (av[i] - 1.0f) * kav[i]); sb += sh[0][i] * km * rkv[i]; }
      sy = oct_sum(sy); sb = oct_sum(sb);
      const float mu = sy * (1.0f / 64.0f); float sv = 0.f;
#pragma unroll
      for (int i = 0; i < 8; ++i) { y[i] -= mu; sv += y[i] * y[i]; }
      sv = oct_sum(sv);
      const float rs = 1.0f / sqrtf(sv * (1.0f / 64.0f) + 64e-5f);
      float o[8];
#pragma unroll
      for (int i = 0; i < 8; ++i) o[i] = ((y[i] * rs) * lgv[i] + lbv[i] + sb * sh[2][i]) * gv[i];
      *(GAS u32x4*)(bout + (size_t)t * 512 + c0) = pack8(o);
    }
  }
    } else if (kind == 7 && (EN & 64)) {
  {
    const bf16_t* Q = (const bf16_t*)(ws + O_Q); const bf16_t* K = (const bf16_t*)(ws + O_K); const bf16_t* Vt = (const bf16_t*)(ws + O_VT); bf16_t* ao = (bf16_t*)(ws + O_AOUT);
    for (int unit = blockIdx.x; unit < NBATCH * 8 * 16; unit += gridDim.x) {
      const int qb = unit & 15, bh = unit >> 4, b = bh >> 3, h = bh & 7;
      attn_unit_pp<96, 64>(Q + ((size_t)bh * SEQ + qb * 256) * 96, 96, K + (size_t)bh * SEQ * 96, 96, Vt + (size_t)bh * 64 * SEQ, SEQ, SEQ, ao + ((size_t)b * SEQ + qb * 256) * 512 + h * 64, 512, lds, tid);
    }
  }
    } else if (kind == 8 && (EN & 128)) {
  {
    const bf16_t* cq = (const bf16_t*)(ws + O_CQ); const bf16_t* Kc = (const bf16_t*)(ws + O_KC); const bf16_t* VcT = (const bf16_t*)(ws + O_VCT); bf16_t* co = (bf16_t*)(ws + O_CO);
    for (int unit = blockIdx.x; unit < (T / 256) * 4; unit += gridDim.x) {
      const int h = unit & 3, rb = unit >> 2, b = rb >> 4;
      attn_unit<128, 128, false>(cq + (size_t)rb * 256 * 512 + h * 128, 512, Kc + (size_t)b * 256 * 512 + h * 128, 512, VcT + (size_t)(b * 4 + h) * 128 * 256, 256, 256, co + (size_t)rb * 256 * 512 + h * 128, 512, lds, tid);
    }
  }
    }
    if (sync && step != 25) { ++nbar; fast_barrier((unsigned*)(p.ws + O_PTAB + 512), nbar * gridDim.x, tid); }
  }
}

extern "C" void kernel_launch(void* const* d_in, const int* in_sizes, int n_in, void* d_out, int out_size, void* d_ws, size_t ws_size, hipStream_t stream) {
  static int grid_blocks = 0;
  if (!grid_blocks) {
    int dev = 0, cus = 0, per_cu = 0;
    (void)hipGetDevice(&dev);
    (void)hipDeviceGetAttribute(&cus, hipDeviceAttributeMultiprocessorCount, dev);
    (void)hipFuncSetAttribute((const void*)fwd_mega, hipFuncAttributeMaxDynamicSharedMemorySize, LDS_BYTES);
    (void)hipOccupancyMaxActiveBlocksPerMultiprocessor(&per_cu, fwd_mega, 512, LDS_BYTES);
    if (per_cu < 1) per_cu = 1;
    grid_blocks = cus * per_cu;
    if (grid_blocks > 256) grid_blocks = 256;
  }
  Params p{};
  const float** pp = (const float**)&p;
  for (int i = 0; i < 42; ++i) pp[i] = (const float*)d_in[i];
  p.out = (float*)d_out; p.ws = (unsigned char*)d_ws;
  void* args[] = {&p};
  hipError_t e = hipLaunchCooperativeKernel((void*)fwd_mega, dim3(grid_blocks), dim3(512), args, LDS_BYTES, stream);
  if (e != hipSuccess) fprintf(stderr, "cooperative launch failed: %s (grid %d)\n", hipGetErrorString(e), grid_blocks);
}
```
